# Optimizing an MI355X kernel written in HIP

```python
import functools
import jax, jax.numpy as jnp
from jax import lax
import numpy as np

D_MODEL = 2048
BATCH = 4
SEQ = 4096
DEPTH = 2

N_MIXERS = 2
Q_BLOCK = 128
EPS = 1e-6
MLA_HEADS = 16
MLA_Q_LORA = 512
MLA_KV_LORA = 512
MLA_NOPE = 128
MLA_ROPE = 64
MLA_V = 128
ROPE_THETA = 10000.0
FOX_HEADS = 16
FOX_HEAD_DIM = 128
N_GROUPS = 8
EXPERTS_PER_GROUP = 8
N_EXPERTS = N_GROUPS * EXPERTS_PER_GROUP
TOP_K = 2
D_EXPERT = 512
ROUTE_BLOCK = 128

kernel_name = "hybrid_mla_fox_hier_moe"


def rms_norm(x, gain):
    xf = x.astype(jnp.float32)
    y = xf * lax.rsqrt(jnp.mean(xf * xf, axis=-1, keepdims=True) + EPS)
    return (y * gain.astype(jnp.float32)).astype(x.dtype)


def apply_rope(x, positions):
    half = x.shape[-1] // 2
    freqs = ROPE_THETA ** (-jnp.arange(half, dtype=jnp.float32) / half)
    ang = positions.astype(jnp.float32)[..., None] * freqs
    cos = jnp.cos(ang)[:, :, None, :]
    sin = jnp.sin(ang)[:, :, None, :]
    x1 = x[..., :half].astype(jnp.float32)
    x2 = x[..., half:].astype(jnp.float32)
    out = jnp.concatenate([x1 * cos - x2 * sin, x2 * cos + x1 * sin], axis=-1)
    return out.astype(x.dtype)


def causal_block_attention(q, k, v, scale, log_decay=None):
    B, S, H, Dk = q.shape
    Dv = v.shape[-1]
    nb = S // Q_BLOCK
    q_blocks = q.reshape(B, nb, Q_BLOCK, H, Dk).transpose(1, 0, 2, 3, 4)
    k_pos = jnp.arange(S)
    xs = (jnp.arange(nb), q_blocks)
    if log_decay is not None:
        xs = xs + (log_decay.reshape(B, H, nb, Q_BLOCK).transpose(2, 0, 1, 3),)

    def one_block(blk):
        i, q_i = blk[0], blk[1]
        s = jnp.einsum("bqhd,bkhd->bhqk", q_i, k, preferred_element_type=jnp.float32) * scale
        if log_decay is not None:
            s = s + (blk[2][..., :, None] - log_decay[:, :, None, :])
        q_pos = i * Q_BLOCK + jnp.arange(Q_BLOCK)
        s = jnp.where(q_pos[:, None] >= k_pos[None, :], s, -jnp.inf)
        p = jax.nn.softmax(s, axis=-1)
        return jnp.einsum("bhqk,bkhd->bqhd", p.astype(v.dtype), v)

    out = lax.map(one_block, xs)
    return out.transpose(1, 0, 2, 3, 4).reshape(B, S, H * Dv)


def mla_mixer(h, positions, w_in, q_lat_norm, kv_lat_norm, w_uq, w_ukv, qk_gain, w_o):
    B, S, _ = h.shape
    z = h @ w_in
    c_q = z[..., :MLA_Q_LORA]
    c_kv = z[..., MLA_Q_LORA:MLA_Q_LORA + MLA_KV_LORA]
    k_rope = z[..., MLA_Q_LORA + MLA_KV_LORA:][:, :, None, :]
    q = (rms_norm(c_q, q_lat_norm) @ w_uq).reshape(B, S, MLA_HEADS, MLA_NOPE + MLA_ROPE)
    kv = (rms_norm(c_kv, kv_lat_norm) @ w_ukv).reshape(B, S, MLA_HEADS, MLA_NOPE + MLA_V)
    q_nope = rms_norm(q[..., :MLA_NOPE], qk_gain[0, :MLA_NOPE])
    q_rope = apply_rope(rms_norm(q[..., MLA_NOPE:], qk_gain[0, MLA_NOPE:]), positions)
    k_nope = rms_norm(kv[..., :MLA_NOPE], qk_gain[1, :MLA_NOPE])
    k_rope = apply_rope(rms_norm(k_rope, qk_gain[1, MLA_NOPE:]), positions)
    v = kv[..., MLA_NOPE:]
    q_full = jnp.concatenate([q_nope, q_rope], axis=-1)
    k_full = jnp.concatenate([k_nope, jnp.broadcast_to(k_rope, (B, S, MLA_HEADS, MLA_ROPE))], axis=-1)
    o = causal_block_attention(q_full, k_full, v, 1.0 / math_sqrt(MLA_NOPE + MLA_ROPE))
    return o @ w_o


def math_sqrt(n):
    return float(np.sqrt(n))


def fox_mixer(h, w_in, forget_bias, qk_gain, w_o):
    B, S, _ = h.shape
    HD = FOX_HEADS * FOX_HEAD_DIM
    z = h @ w_in
    q = rms_norm(z[..., :HD].reshape(B, S, FOX_HEADS, FOX_HEAD_DIM), qk_gain[0])
    k = rms_norm(z[..., HD:2 * HD].reshape(B, S, FOX_HEADS, FOX_HEAD_DIM), qk_gain[1])
    v = z[..., 2 * HD:3 * HD].reshape(B, S, FOX_HEADS, FOX_HEAD_DIM)
    f_logit = z[..., 3 * HD:3 * HD + FOX_HEADS]
    gate = z[..., 3 * HD + FOX_HEADS:]
    log_f = jax.nn.log_sigmoid(f_logit.astype(jnp.float32) + forget_bias.astype(jnp.float32))
    c = jnp.cumsum(log_f, axis=1).transpose(0, 2, 1)
    o = causal_block_attention(q, k, v, 1.0 / math_sqrt(FOX_HEAD_DIM), log_decay=c)
    o = o * jax.nn.sigmoid(gate)
    return o @ w_o


def routed_experts(t, e_idx, gate, w_gate_up, w_down):
    T, D = t.shape
    n_assign = T * TOP_K
    e_flat = e_idx.reshape(-1)
    tok_flat = jnp.repeat(jnp.arange(T), TOP_K)
    g_flat = gate.reshape(-1)
    order = jnp.argsort(e_flat)
    e_sorted, tok_sorted, g_sorted = e_flat[order], tok_flat[order], g_flat[order]
    counts = jnp.zeros((N_EXPERTS,), jnp.int32).at[e_flat].add(1)
    start = jnp.cumsum(counts) - counts
    padded = (counts + ROUTE_BLOCK - 1) // ROUTE_BLOCK * ROUTE_BLOCK
    pend = jnp.cumsum(padded)
    pstart = pend - padded
    dest = pstart[e_sorted] + (jnp.arange(n_assign) - start[e_sorted])
    n_blocks = (n_assign + N_EXPERTS * (ROUTE_BLOCK - 1) + ROUTE_BLOCK - 1) // ROUTE_BLOCK
    buf = jnp.zeros((n_blocks * ROUTE_BLOCK, D), t.dtype).at[dest].set(t[tok_sorted])
    block_e = jnp.minimum(
        jnp.searchsorted(pend, jnp.arange(n_blocks) * ROUTE_BLOCK, side="right"), N_EXPERTS - 1)

    def expert_block(blk):
        xb, e = blk
        gu = xb @ w_gate_up[e]
        return (jax.nn.silu(gu[:, :D_EXPERT]) * gu[:, D_EXPERT:]) @ w_down[e]

    y = lax.map(expert_block, (buf.reshape(n_blocks, ROUTE_BLOCK, D), block_e))
    y = y.reshape(n_blocks * ROUTE_BLOCK, D)[dest]
    return jax.ops.segment_sum(y * g_sorted[:, None], tok_sorted, num_segments=T)


def hier_moe(h, w_router_group, b_router_group, w_router_expert, b_router_expert, w_gate_up, w_down):
    B, S, D = h.shape
    T = B * S
    t = h.reshape(T, D)
    g_logits = (t @ w_router_group).astype(jnp.float32) + b_router_group.astype(jnp.float32)
    p_group = jax.nn.softmax(g_logits, axis=-1)
    _, grp = lax.top_k(g_logits, 1)
    p_g = jnp.take_along_axis(p_group, grp, axis=-1)
    e_logits = ((t @ w_router_expert).astype(jnp.float32)
                + b_router_expert.astype(jnp.float32)).reshape(T, N_GROUPS, EXPERTS_PER_GROUP)
    e_in = jnp.take_along_axis(e_logits, grp[:, :, None], axis=1)[:, 0]
    p_e = jax.nn.softmax(e_in, axis=-1)
    top_p, top_i = lax.top_k(p_e, TOP_K)
    gate = p_g * top_p / jnp.sum(top_p, axis=-1, keepdims=True)
    e_idx = grp * EXPERTS_PER_GROUP + top_i
    y = routed_experts(t, e_idx, gate.astype(t.dtype), w_gate_up, w_down)
    return y.reshape(B, S, D)


def setup_inputs(seed: int = 0) -> dict:
    key = jax.random.key(seed)
    ks = iter(jax.random.split(key, 40))
    D = D_MODEL

    def dense(shape, fan_in):
        return jax.random.normal(next(ks), shape, jnp.float32) * fan_in ** -0.5

    def gain(shape):
        return 1.0 + 0.1 * jax.random.normal(next(ks), shape, jnp.float32)

    def small(shape):
        return 0.01 * jax.random.normal(next(ks), shape, jnp.float32)

    def moe_params(prefix):
        return {
            prefix + "norm_ffn": gain((D,)),
            prefix + "router_group": dense((D, N_GROUPS), D),
            prefix + "router_group_bias": small((N_GROUPS,)),
            prefix + "router_expert": dense((D, N_EXPERTS), D),
            prefix + "router_expert_bias": small((N_EXPERTS,)),
            prefix + "w_gate_up": dense((N_EXPERTS, D, 2 * D_EXPERT), D),
            prefix + "w_down": dense((N_EXPERTS, D_EXPERT, D), D_EXPERT),
        }

    x = jax.random.normal(next(ks), (BATCH, SEQ, D), jnp.float32)
    offsets = jax.random.randint(next(ks), (BATCH, 1), 0, 1024, dtype=jnp.int32)
    positions = offsets + jnp.arange(SEQ, dtype=jnp.int32)[None, :]
    inp = {"x": x, "positions": positions}
    inp["l0_norm_mix"] = gain((D,))
    inp["l0_mla_w_in"] = dense((D, MLA_Q_LORA + MLA_KV_LORA + MLA_ROPE), D)
    inp["l0_mla_q_lat_norm"] = gain((MLA_Q_LORA,))
    inp["l0_mla_kv_lat_norm"] = gain((MLA_KV_LORA,))
    inp["l0_mla_w_uq"] = dense((MLA_Q_LORA, MLA_HEADS * (MLA_NOPE + MLA_ROPE)), MLA_Q_LORA)
    inp["l0_mla_w_ukv"] = dense((MLA_KV_LORA, MLA_HEADS * (MLA_NOPE + MLA_V)), MLA_KV_LORA)
    inp["l0_mla_qk_gain"] = gain((2, MLA_NOPE + MLA_ROPE))
    inp["l0_mla_w_o"] = dense((MLA_HEADS * MLA_V, D), MLA_HEADS * MLA_V)
    inp.update(moe_params("l0_"))
    HD = FOX_HEADS * FOX_HEAD_DIM
    inp["l1_norm_mix"] = gain((D,))
    inp["l1_fox_w_in"] = dense((D, 3 * HD + FOX_HEADS + HD), D)
    inp["l1_fox_forget_bias"] = jax.random.uniform(next(ks), (FOX_HEADS,), jnp.float32, 1.0, 5.0)
    inp["l1_fox_qk_gain"] = gain((2, FOX_HEAD_DIM))
    inp["l1_fox_w_o"] = dense((HD, D), HD)
    inp.update(moe_params("l1_"))
    return inp


def reference(x, positions,
              l0_norm_mix, l0_mla_w_in, l0_mla_q_lat_norm, l0_mla_kv_lat_norm, l0_mla_w_uq,
              l0_mla_w_ukv, l0_mla_qk_gain, l0_mla_w_o,
              l0_norm_ffn, l0_router_group, l0_router_group_bias, l0_router_expert,
              l0_router_expert_bias, l0_w_gate_up, l0_w_down,
              l1_norm_mix, l1_fox_w_in, l1_fox_forget_bias, l1_fox_qk_gain, l1_fox_w_o,
              l1_norm_ffn, l1_router_group, l1_router_group_bias, l1_router_expert,
              l1_router_expert_bias, l1_w_gate_up, l1_w_down):
    mixers = [
        functools.partial(mla_mixer, positions=positions, w_in=l0_mla_w_in,
                          q_lat_norm=l0_mla_q_lat_norm, kv_lat_norm=l0_mla_kv_lat_norm,
                          w_uq=l0_mla_w_uq, w_ukv=l0_mla_w_ukv, qk_gain=l0_mla_qk_gain,
                          w_o=l0_mla_w_o),
        functools.partial(fox_mixer, w_in=l1_fox_w_in, forget_bias=l1_fox_forget_bias,
                          qk_gain=l1_fox_qk_gain, w_o=l1_fox_w_o),
    ]
    layers = [
        (l0_norm_mix, l0_norm_ffn, (l0_router_group, l0_router_group_bias, l0_router_expert,
                                     l0_router_expert_bias, l0_w_gate_up, l0_w_down)),
        (l1_norm_mix, l1_norm_ffn, (l1_router_group, l1_router_group_bias, l1_router_expert,
                                     l1_router_expert_bias, l1_w_gate_up, l1_w_down)),
    ]
    h = x
    for i in range(DEPTH):
        norm_mix, norm_ffn, moe_w = layers[i]
        h = h + mixers[i % N_MIXERS](rms_norm(h, norm_mix))
        h = h + hier_moe(rms_norm(h, norm_ffn), *moe_w)
    return h
```

```cpp
#include <hip/hip_runtime.h>
#include <cstdio>
#include <cstdint>
#ifndef CV_MODE
#define CV_MODE 0
#endif

#define LAS __attribute__((address_space(3)))
typedef unsigned short bf16;
typedef short bf16x8 __attribute__((ext_vector_type(8)));
typedef float f32x4 __attribute__((ext_vector_type(4)));
typedef unsigned u32x4 __attribute__((ext_vector_type(4)));
typedef unsigned u32x2 __attribute__((ext_vector_type(2)));

constexpr int T = 16384, DM = 2048, NB = 4, SEQ = 4096, NH = 16;
constexpr int NEXP = 64, DEXP = 512;
constexpr float EPS = 1e-6f;
constexpr int NTHREADS = 512, NWAVES = 8;

constexpr size_t MiB = 1u << 20;
constexpr size_t WS_CTL = 0, CTL_BYTES = 1 * MiB;
constexpr size_t WS_W_IN0T = 1 * MiB;
constexpr size_t WS_W_UQT = WS_W_IN0T + 5 * MiB;
constexpr size_t WS_W_UKVT = WS_W_UQT + 3 * MiB;
constexpr size_t WS_W_O0T = WS_W_UKVT + 4 * MiB;
constexpr size_t WS_W_IN1T = WS_W_O0T + 8 * MiB;
constexpr size_t WS_W_O1T = WS_W_IN1T + 33 * MiB;
constexpr size_t WS_W_GUT = WS_W_O1T + 8 * MiB;
constexpr size_t WS_W_DT = WS_W_GUT + 256 * MiB;
constexpr size_t WS_HN = WS_W_DT + 128 * MiB;
constexpr size_t WS_Z = WS_HN + 64 * MiB;
constexpr size_t WS_CQN = WS_Z + 256 * MiB;
constexpr size_t WS_CKVN = WS_CQN + 16 * MiB;
constexpr size_t WS_KR = WS_CKVN + 16 * MiB;
constexpr size_t WS_Q = WS_KR + 2 * MiB;
constexpr size_t WS_K = WS_Q + 96 * MiB;
constexpr size_t WS_V = WS_K + 96 * MiB;
constexpr size_t WS_O = WS_V + 64 * MiB;
constexpr size_t WS_H1 = WS_O + 64 * MiB;
constexpr size_t WS_RL = WS_H1 + 128 * MiB;
constexpr size_t WS_SSQ = WS_RL, WS_RSL = WS_RL + 2 * MiB;
constexpr size_t WS_TOK = WS_RL + 8 * MiB;
constexpr size_t WS_GATE = WS_TOK + 4 * MiB;
constexpr size_t WS_TSLOT = WS_GATE + 4 * MiB;
constexpr size_t WS_ACT = WS_TSLOT + 1 * MiB;
constexpr size_t WS_YS = WS_ACT + 48 * MiB;
constexpr size_t WS_FLOG = WS_YS + 192 * MiB;
constexpr size_t WS_C = WS_FLOG + 1 * MiB;
constexpr size_t WS_QL = WS_C + 1 * MiB;
constexpr size_t WS_KVL = WS_QL + 96 * MiB;
constexpr size_t WS_SK = WS_KVL + 128 * MiB;
constexpr size_t WS_PK = WS_SK + 4 * MiB;
constexpr size_t WS_PF = WS_PK + 16 * MiB;
constexpr size_t WS_PR = WS_PF + 4 * MiB;
constexpr size_t WS_END = WS_PR + 20 * MiB;
constexpr int CW_CNT0 = 1024, CW_CNT1 = 2048;
constexpr int CW_BAR = 4096;
constexpr int LDS_BARW = 155 * 1024, LDS_TS = LDS_BARW + 64, LDS_CN = LDS_BARW + 64 + 272, LDS_TE = LDS_BARW + 64 + 272 + 256, LDS_XS = LDS_BARW + 64 + 272 + 256 + 192, LDS_BYTES = 156 * 1024;

__device__ __forceinline__ float bf2f(unsigned b) { return __uint_as_float(b << 16); }
__device__ __forceinline__ unsigned f2bf(float f) { unsigned u = __float_as_uint(f); return (u + 0x7fffu + ((u >> 16) & 1u)) >> 16; }
__device__ __forceinline__ unsigned pk2(float lo, float hi) { unsigned r; asm("v_cvt_pk_bf16_f32 %0, %1, %2" : "=v"(r) : "v"(lo), "v"(hi)); return r; }
__device__ __forceinline__ float wave_sum(float v) {
#pragma unroll
    for (int o = 1; o < 64; o <<= 1) v += __shfl_xor(v, o);
    return v;
}
__device__ __forceinline__ float wave_max(float v) {
#pragma unroll
    for (int o = 1; o < 64; o <<= 1) v = fmaxf(v, __shfl_xor(v, o));
    return v;
}
__device__ __forceinline__ int otid() { int t = threadIdx.x; asm volatile("" : "+v"(t)); return t; }
__device__ __forceinline__ int obid() { int t = blockIdx.x; asm volatile("" : "+s"(t)); return t; }
__device__ __forceinline__ int ogrid() { int t = gridDim.x; asm volatile("" : "+s"(t)); return t; }
__device__ __forceinline__ float rsq(float x) { return 1.0f / sqrtf(x); }
__device__ __forceinline__ float rope64(float xn, int lane, float pos) {
    const float partner = __shfl_xor(xn, 32);
    const int i = lane & 31;
    const float freq = exp2f(-(float)i * (13.287712379549449f / 32.0f));
    const float ang = pos * freq;
    float rev = ang * 0.15915494309189535f; rev -= floorf(rev);
    const float s = __builtin_amdgcn_sinf(rev), c = __builtin_amdgcn_cosf(rev);
    return lane < 32 ? xn * c - partner * s : xn * c + partner * s;
}

enum { B_N_F32 = 0, B_N_BF16 = 1, B_T_BF16 = 2 };
template <int BMODE, class AP, class BP, class EP>
__device__ __forceinline__ void sg_tile(LAS unsigned char* lds, const AP& ap, const BP& bp, const EP& ep, int kbeg, int kend) {
    const int tid = otid(), wave = tid >> 6, lane = tid & 63, fr = lane & 15, fq = lane >> 4, wm = wave >> 2, wn = wave & 3;
    LAS bf16* sA = (LAS bf16*)lds; LAS bf16* sB = sA + 128 * 40;
    const bf16* pa = ap.row(tid >> 2) + (tid & 3) * 8;
    const int chunk = tid & 15, kk = tid >> 4;
    const bf16* pbt = nullptr; const float* pbf = nullptr; const bf16* pbh = nullptr; int ldb = 0;
    if constexpr (BMODE == B_T_BF16) { pbt = bp.row(tid >> 2); if (pbt) pbt += (tid & 3) * 8; }
    else if constexpr (BMODE == B_N_F32) { pbf = bp.col8(chunk, ldb); }
    else { pbh = bp.col8(chunk, ldb); }
    f32x4 acc[4][2];
#pragma unroll
    for (int mi = 0; mi < 4; ++mi)
#pragma unroll
        for (int ni = 0; ni < 2; ++ni) acc[mi][ni] = (f32x4){0.f, 0.f, 0.f, 0.f};
    for (int k0 = kbeg; k0 < kend; k0 += 32) {
        const u32x4 ra = *(const u32x4*)(pa + k0);
        u32x4 rb = (u32x4){0u, 0u, 0u, 0u};
        if constexpr (BMODE == B_T_BF16) { if (pbt) rb = *(const u32x4*)(pbt + k0); }
        else if constexpr (BMODE == B_N_F32) {
            if (pbf) { const float* p = pbf + (size_t)(k0 + kk) * ldb; const f32x4 x = *(const f32x4*)p, y = *(const f32x4*)(p + 4);
                rb = (u32x4){pk2(x[0], x[1]), pk2(x[2], x[3]), pk2(y[0], y[1]), pk2(y[2], y[3])}; }
        } else { if (pbh) rb = *(const u32x4*)(pbh + (size_t)(k0 + kk) * ldb); }
        __syncthreads();
        *(LAS u32x4*)(sA + (tid >> 2) * 40 + (tid & 3) * 8) = ra;
        if constexpr (BMODE == B_T_BF16) { *(LAS u32x4*)(sB + (tid >> 2) * 40 + (tid & 3) * 8) = rb; }
        else {
#pragma unroll
            for (int j = 0; j < 8; ++j) sB[(chunk * 8 + j) * 40 + kk] = (bf16)((rb[j >> 1] >> ((j & 1) * 16)) & 0xffffu);
        }
        __syncthreads();
        bf16x8 a[4], b[2];
#pragma unroll
        for (int mi = 0; mi < 4; ++mi) a[mi] = *(const LAS bf16x8*)(sA + (wm * 64 + mi * 16 + fr) * 40 + fq * 8);
#pragma unroll
        for (int ni = 0; ni < 2; ++ni) b[ni] = *(const LAS bf16x8*)(sB + (wn * 32 + ni * 16 + fr) * 40 + fq * 8);
#pragma unroll
        for (int mi = 0; mi < 4; ++mi)
#pragma unroll
            for (int ni = 0; ni < 2; ++ni) acc[mi][ni] = __builtin_amdgcn_mfma_f32_16x16x32_bf16(b[ni], a[mi], acc[mi][ni], 0, 0, 0);
    }
#pragma unroll
    for (int mi = 0; mi < 4; ++mi) ep(wm * 64 + mi * 16 + fr, wn * 32 + 4 * fq, acc[mi][0], acc[mi][1]);
}

struct APlain { const bf16* A; size_t lda; __device__ __forceinline__ const bf16* row(int r) const { return A + (size_t)r * lda; } };
struct BPlainF32 { const float* B; int ldb_, ncols; int n0;
    __device__ __forceinline__ const float* col8(int chunk, int& ldb) const { ldb = ldb_; const int c = n0 + chunk * 8; return c < ncols ? B + c : nullptr; } };
struct BPlainBf16 { const bf16* B; int ldb_;
    __device__ __forceinline__ const bf16* col8(int chunk, int& ldb) const { ldb = ldb_; return B + chunk * 8; } };
struct BRowsT { const bf16* Bt; size_t ld; __device__ __forceinline__ const bf16* row(int r) const { return Bt + (size_t)r * ld; } };

__device__ __forceinline__ void store4bf(bf16* p, f32x4 v) { *(u32x2*)p = (u32x2){pk2(v[0], v[1]), pk2(v[2], v[3])}; }
__device__ __forceinline__ void store8bf(bf16* p, f32x4 a, f32x4 b) { *(u32x4*)p = (u32x4){pk2(a[0], a[1]), pk2(a[2], a[3]), pk2(b[0], b[1]), pk2(b[2], b[3])}; }

struct EpBf16 { bf16* C; size_t ldc; int n0, N;
    __device__ __forceinline__ void operator()(int rl, int cl, f32x4 v0, f32x4 v1) const {
        bf16* p = C + (size_t)rl * ldc; const int c = n0 + cl;
        if (c < N) store4bf(p + c, v0);
        if (c + 16 < N) store4bf(p + c + 16, v1); } };
struct EpResF32 { const float* R; float* C; int n0;
    __device__ __forceinline__ void operator()(int rl, int cl, f32x4 v0, f32x4 v1) const {
        const size_t o = (size_t)rl * DM + n0 + cl;
        *(f32x4*)(C + o) = *(const f32x4*)(R + o) + v0; *(f32x4*)(C + o + 16) = *(const f32x4*)(R + o + 16) + v1; } };


#define XB_TMO      128
#define XB_XCNT(j)  (256  + 64 * (j))
#define XB_XSUB(j)  (1280 + 64 * (j))
#define XB_XGEN(j)  (2304 + 64 * (j))
#define XB_TOP      3328
#define XB_TOPGEN   3392
#define XCD_BAR_WORDS 3456
#define XB_SPIN_CAP (1u << 18)

__device__ __forceinline__ unsigned xb_ld(unsigned* p)              { return __hip_atomic_load(p, __ATOMIC_RELAXED, __HIP_MEMORY_SCOPE_AGENT); }
__device__ __forceinline__ unsigned xb_add(unsigned* p, unsigned v) { return __hip_atomic_fetch_add(p, v, __ATOMIC_RELAXED, __HIP_MEMORY_SCOPE_AGENT); }
__device__ __forceinline__ unsigned xb_xcc_id() { return (unsigned)__builtin_amdgcn_s_getreg((3 << 11) | 20) & 0xFu; }
#define XB_SPIN(cond, bar) do { unsigned _sp = 0; while (cond) { __builtin_amdgcn_s_sleep(1); \
    if ((++_sp & 255u) == 0u) { if (xb_ld(&(bar)[XB_TMO])) break; if (_sp > XB_SPIN_CAP) { atomicAdd(&(bar)[XB_TMO], 1u); break; } } } } while (0)

struct XcdBarrier {
    unsigned* bar; unsigned x;
    volatile LAS unsigned* st;
};

__device__ __forceinline__ XcdBarrier xcd_barrier_post(unsigned* bar, volatile LAS unsigned* st) {
    XcdBarrier b; b.bar = bar; b.x = xb_xcc_id(); b.st = st;
    if (threadIdx.x == 0) (void)xb_add(&bar[XB_XCNT(b.x)], 1u);
    return b;
}
__device__ __forceinline__ void xcd_barrier_complete(unsigned* bar, unsigned x, unsigned& nloc, unsigned& nx) {
    const unsigned G = gridDim.x * gridDim.y * gridDim.z;
    unsigned sum, cnt, mine, sp = 0u;
    for (;;) {
        sum = 0u; cnt = 0u; mine = 0u;
#pragma unroll
        for (unsigned j = 0; j < 16; ++j) { const unsigned c = xb_ld(&bar[XB_XCNT(j)]); sum += c; cnt += (c > 0u) ? 1u : 0u; mine = (j == x) ? c : mine; }
        if (sum == G) break;
        __builtin_amdgcn_s_sleep(1);
        if ((++sp & 255u) == 0u) { if (xb_ld(&bar[XB_TMO])) break; if (sp > XB_SPIN_CAP) { atomicAdd(&bar[XB_TMO], 1u); break; } }
    }
    nloc = mine > 0u ? mine : 1u; nx = cnt > 0u ? cnt : 1u;
}

__device__ __forceinline__ void xcd_barrier(const XcdBarrier& b) {
    asm volatile("s_waitcnt vmcnt(0)" ::: "memory");
    __syncthreads();
    if (threadIdx.x == 0) {
        unsigned* bar = b.bar;
        __builtin_amdgcn_s_waitcnt(0);
        unsigned nloc = b.st[0], nx = b.st[1];
        if (nloc == 0u) { xcd_barrier_complete(bar, b.x, nloc, nx); b.st[0] = nloc; b.st[1] = nx; }
        const unsigned old = xb_add(&bar[XB_XSUB(b.x)], 1u);
        const unsigned gen = old / nloc;
        if (old + 1u == (gen + 1u) * nloc) {
            __builtin_amdgcn_fence(__ATOMIC_RELEASE, "agent");
            asm volatile("s_waitcnt vmcnt(0)" ::: "memory");
            const unsigned og = xb_add(&bar[XB_TOP], 1u);
            const unsigned tg = og / nx;
            if (og + 1u == (tg + 1u) * nx) xb_add(&bar[XB_TOPGEN], 1u);
            else XB_SPIN(xb_ld(&bar[XB_TOPGEN]) == tg, bar);
            __builtin_amdgcn_fence(__ATOMIC_ACQUIRE, "agent");
            xb_add(&bar[XB_XGEN(b.x)], 1u);
            asm volatile("s_waitcnt vmcnt(0)" ::: "memory");
        } else {
            XB_SPIN(xb_ld(&bar[XB_XGEN(b.x)]) == gen, bar);
            __builtin_amdgcn_fence(__ATOMIC_ACQUIRE, "agent");
            asm volatile("s_waitcnt vmcnt(0)" ::: "memory");
        }
    }
    __syncthreads();
}

namespace fg {
constexpr int BM = 256, BK = 64, HALF = 128, HTB = HALF * BK * 2, STAGE_BYTES = 8 * HTB;
__host__ __device__ __forceinline__ int lds_byte(int r, int c) { const int st = (r >> 4) * 2 + (c >> 5), rr = r & 15, cc = c & 31, ob = rr * 64 + cc * 2; return st * 1024 + (ob ^ (((ob >> 9) & 1) << 5)); }
__host__ __device__ __forceinline__ void stage_rc(int b, int& R, int& C) { const int st = b / 1024, sb = b % 1024, swz = sb ^ (((sb >> 9) & 1) << 5); R = (st >> 1) * 16 + swz / 64; C = (st & 1) * 32 + (swz % 64) / 2; }

template <bool GATHER, class Unit, class Epi, class Sched>
__device__ __forceinline__ void gemm_phase(LAS unsigned char* lds, const int K, const Sched& S, const Epi& E) {
    const int tid = otid(), wid = __builtin_amdgcn_readfirstlane(tid >> 6), lane = tid & 63, wr = wid >> 2, wc = wid & 3, fr = lane & 15, fq = lane >> 4;
    const int nt = K / BK;
    int R0, C0, R1, C1; stage_rc(tid * 16, R0, C0); stage_rc(tid * 16 + 8192, R1, C1);
    const int Rb0 = (R0 & ~31) + 8 * ((R0 & 15) >> 2) + 4 * ((R0 >> 4) & 1) + (R0 & 3), Rb1 = (R1 & ~31) + 8 * ((R1 & 15) >> 2) + 4 * ((R1 >> 4) & 1) + (R1 & 3);
    const unsigned voffB0 = (unsigned)(Rb0 * K + C0) * 2u, voffB1 = (unsigned)(Rb1 * K + C1) * 2u;
    const size_t kstep = (size_t)(BK * 2);
    const size_t hstepB = (size_t)HALF * K * 2;
    const unsigned ldsw = (unsigned)wid * 1024u;
    const int aoff = lds_byte(wr * 64 + fr, fq * 8), boff = lds_byte(wc * 32 + fr, fq * 8);
#define FG_SA(b, h) (((b) * 2 + (h)) * HTB)
#define FG_SB(b, h) ((4 + (b) * 2 + (h)) * HTB)
#define FG_STAGE(bufoff, gbase, v0, v1) do { \
        __builtin_amdgcn_global_load_lds((const unsigned*)((const char*)(gbase) + (v0)), (LAS unsigned*)(lds + (bufoff) + ldsw), 16, 0, 0); \
        __builtin_amdgcn_global_load_lds((const unsigned*)((const char*)(gbase) + (v1)), (LAS unsigned*)(lds + (bufoff) + ldsw + 8192), 16, 0, 0); } while (0)
#define FG_LDA(dst, b, h) do { _Pragma("unroll") for (int m = 0; m < 4; ++m) _Pragma("unroll") for (int k = 0; k < 2; ++k) dst[m][k] = *(const LAS bf16x8*)(lds + FG_SA(b, h) + aoff + m * 2048 + k * 1024); } while (0)
#define FG_LDB(dst, b, h) do { _Pragma("unroll") for (int n = 0; n < 2; ++n) _Pragma("unroll") for (int k = 0; k < 2; ++k) dst[n][k] = *(const LAS bf16x8*)(lds + FG_SB(b, h) + boff + n * 2048 + k * 1024); } while (0)
#define FG_MMA(ai, bj, At, Bt) do { __builtin_amdgcn_s_setprio(1); _Pragma("unroll") for (int m = 0; m < 4; ++m) _Pragma("unroll") for (int n = 0; n < 2; ++n) _Pragma("unroll") for (int k = 0; k < 2; ++k) \
        acc[ai][bj][m][n] = __builtin_amdgcn_mfma_f32_16x16x32_bf16(Bt[n][k], At[m][k], acc[ai][bj][m][n], 0, 0, 0); __builtin_amdgcn_s_setprio(0); } while (0)
#define FG_WAIT_V(n) asm volatile("s_waitcnt vmcnt(" #n ")" ::: "memory")
#define FG_WAIT_L(n) asm volatile("s_waitcnt lgkmcnt(" #n ")" ::: "memory")
#define FG_BAR __builtin_amdgcn_s_barrier()
#define FG_SCHED __builtin_amdgcn_sched_barrier(0)
    Unit cur, nxt; int ui = 0;
    if (!S.next(0, cur)) return;
    f32x4 acc[2][2][4][2];
#pragma unroll
    for (int a = 0; a < 2; ++a)
#pragma unroll
        for (int b = 0; b < 2; ++b)
#pragma unroll
            for (int m = 0; m < 4; ++m)
#pragma unroll
                for (int n = 0; n < 2; ++n) acc[a][b][m][n] = (f32x4){0.f, 0.f, 0.f, 0.f};
    bf16x8 At[4][2], B0[2][2], B1[2][2];
    const char* cA = S.a_base(cur); const char* cB = S.b_base(cur);
    unsigned vA00 = S.a_voff(cur, R0, C0), vA01 = S.a_voff(cur, R1, C1), vA10 = S.a_voff(cur, HALF + R0, C0), vA11 = S.a_voff(cur, HALF + R1, C1);
    unsigned vN00 = vA00, vN01 = vA01, vN10 = vA10, vN11 = vA11;
    bool hi_on = !S.lo_only(cur);
    FG_STAGE(FG_SB(0, 0), cB, voffB0, voffB1); FG_STAGE(FG_SB(0, 1), cB + hstepB, voffB0, voffB1); FG_STAGE(FG_SA(0, 0), cA, vA00, vA01); FG_STAGE(FG_SA(0, 1), cA, vA10, vA11);
    if (wr == 1) FG_BAR;
    FG_WAIT_V(2); FG_BAR;
    FG_STAGE(FG_SB(1, 0), cB + kstep, voffB0, voffB1); FG_STAGE(FG_SA(1, 0), cA + kstep, vA00, vA01); FG_STAGE(FG_SB(1, 1), cB + hstepB + kstep, voffB0, voffB1);
    FG_WAIT_V(6); FG_BAR;
    for (;;) {
        const bool has_next = S.next(ui + 1, nxt);
        const char* nA = has_next ? S.a_base(nxt) : cA; const char* nB = has_next ? S.b_base(nxt) : cB;
        if (GATHER) { if (has_next) { vN00 = S.a_voff(nxt, R0, C0); vN01 = S.a_voff(nxt, R1, C1); vN10 = S.a_voff(nxt, HALF + R0, C0); vN11 = S.a_voff(nxt, HALF + R1, C1); }
                      else { vN00 = vA00; vN01 = vA01; vN10 = vA10; vN11 = vA11; } }
        for (int t = 0; t < nt; t += 2) {
            const bool last = (t == nt - 2);
            const char* a1 = cA + (size_t)(t + 1) * kstep;
            const char* a2 = last ? nA : cA + (size_t)(t + 2) * kstep; const char* b2 = last ? nB : cB + (size_t)(t + 2) * kstep;
            const char* a3 = a2 + kstep; const char* b3 = b2 + kstep;
            const unsigned x00 = (GATHER && last) ? vN00 : vA00, x01 = (GATHER && last) ? vN01 : vA01, x10 = (GATHER && last) ? vN10 : vA10, x11 = (GATHER && last) ? vN11 : vA11;
            FG_LDB(B0, 0, 0); FG_LDB(B1, 0, 1); FG_SCHED; FG_LDA(At, 0, 0); FG_STAGE(FG_SA(1, 1), a1, vA10, vA11);
            FG_WAIT_V(8); FG_WAIT_L(0); FG_BAR; FG_MMA(0, 0, At, B0); FG_MMA(0, 1, At, B1); FG_BAR; FG_SCHED;
            FG_LDA(At, 0, 1); FG_STAGE(FG_SB(0, 0), b2, voffB0, voffB1); FG_STAGE(FG_SB(0, 1), b2 + hstepB, voffB0, voffB1); FG_STAGE(FG_SA(0, 0), a2, x00, x01);
            FG_WAIT_V(8); FG_WAIT_L(0); FG_BAR; if (hi_on) { FG_MMA(1, 0, At, B0); FG_MMA(1, 1, At, B1); } FG_BAR; FG_SCHED;
            FG_LDB(B0, 1, 0); FG_LDB(B1, 1, 1); FG_SCHED; FG_LDA(At, 1, 0); FG_STAGE(FG_SA(0, 1), a2, x10, x11);
            FG_WAIT_V(8); FG_WAIT_L(0); FG_BAR; FG_MMA(0, 0, At, B0); FG_MMA(0, 1, At, B1); FG_BAR; FG_SCHED;
            FG_LDA(At, 1, 1); FG_STAGE(FG_SB(1, 0), b3, voffB0, voffB1); FG_STAGE(FG_SB(1, 1), b3 + hstepB, voffB0, voffB1); FG_STAGE(FG_SA(1, 0), a3, x00, x01);
            FG_WAIT_V(8); FG_WAIT_L(0); FG_BAR; if (hi_on) { FG_MMA(1, 0, At, B0); FG_MMA(1, 1, At, B1); } FG_BAR; FG_SCHED;
        }
        if (wr == 0) FG_BAR;
        { int tz = threadIdx.x; asm volatile("" : "+v"(tz));
          const int lz = tz & 63; E(acc, cur, (tz >> 6) >> 2, (tz >> 6) & 3, lz & 15, lz >> 4); }
        if (!has_next) break;
#pragma unroll
        for (int a = 0; a < 2; ++a)
#pragma unroll
            for (int b = 0; b < 2; ++b)
#pragma unroll
                for (int m = 0; m < 4; ++m)
#pragma unroll
                    for (int n = 0; n < 2; ++n) acc[a][b][m][n] = (f32x4){0.f, 0.f, 0.f, 0.f};
        cur = nxt; cA = nA; cB = nB; ++ui; hi_on = !S.lo_only(cur);
        if (GATHER) { vA00 = vN00; vA01 = vN01; vA10 = vN10; vA11 = vN11; }
        if (wr == 1) FG_BAR;
    }
    FG_WAIT_V(0);
    FG_BAR;
#undef FG_SA
#undef FG_SB
#undef FG_STAGE
#undef FG_LDA
#undef FG_LDB
#undef FG_MMA
#undef FG_WAIT_V
#undef FG_WAIT_L
#undef FG_BAR
#undef FG_SCHED
}

struct DUnit { int p, pm, pn, par; };
struct DenseSched {
    const bf16* A0; const bf16* B0; int nN0; const bf16* A1; const bf16* B1; int nN1; int K, G, c;
    static constexpr int nM = T / 256, NXCD = 8, WGM = 8;
    __device__ __forceinline__ bool next(int i, DUnit& u) const {
        long L = (long)i * G + c; const int nwg0 = nM * nN0, nwg1 = nM * nN1;
        int nN, nwg; if (L < nwg0) { u.p = 0; nN = nN0; nwg = nwg0; } else { L -= nwg0; if (L >= nwg1) return false; u.p = 1; nN = nN1; nwg = nwg1; }
        int wgid = (int)L; { const int q = nwg / NXCD, r = nwg % NXCD, xcd = wgid % NXCD, off = wgid / NXCD; wgid = (xcd < r ? xcd * (q + 1) : r * (q + 1) + (xcd - r) * q) + off; }
        const int nig = WGM * nN, gid = wgid / nig, fm = gid * WGM, gsz = (nM - fm) < WGM ? (nM - fm) : WGM;
        u.pm = fm + ((wgid % nig) % gsz); u.pn = (wgid % nig) / gsz; u.par = i & 1; return true;
    }
    __device__ __forceinline__ const char* a_base(const DUnit& u) const { return (const char*)(u.p ? A1 : A0) + (size_t)u.pm * 256 * K * 2; }
    __device__ __forceinline__ const char* b_base(const DUnit& u) const { return (const char*)(u.p ? B1 : B0) + (size_t)u.pn * 256 * K * 2; }
    __device__ __forceinline__ unsigned a_voff(const DUnit&, int row, int col) const { return (unsigned)(row * K + col) * 2u; }
    __device__ __forceinline__ bool lo_only(const DUnit&) const { return false; }
};
struct SkUnit { int pm, ks; };
struct SkinnySched {
    const char* A; const char* B; int G, c;
    __device__ __forceinline__ bool next(int i, SkUnit& u) const { const int L = i * G + c; if (L >= (T / 256) * 4) return false; u.pm = L >> 2; u.ks = L & 3; return true; }
    __device__ __forceinline__ const char* a_base(const SkUnit& u) const { return A + ((size_t)u.pm * 256 * DM + u.ks * 512) * 2; }
    __device__ __forceinline__ const char* b_base(const SkUnit& u) const { return B + (size_t)u.ks * 256 * 512 * 2; }
    __device__ __forceinline__ unsigned a_voff(const SkUnit&, int row, int col) const { return (unsigned)(row * DM + col) * 2u; }
    __device__ __forceinline__ bool lo_only(const SkUnit&) const { return false; }
};
#define FG_FOREACH(acc, BODY) do { _Pragma("unroll") for (int ai = 0; ai < 2; ++ai) _Pragma("unroll") for (int m = 0; m < 4; ++m) { const int row = ai * 128 + wr * 64 + m * 16 + fr; \
        _Pragma("unroll") for (int bj = 0; bj < 2; ++bj) { const int col = bj * 128 + wc * 32 + 8 * fq; const f32x4 v0 = acc[ai][bj][m][0], v1 = acc[ai][bj][m][1]; BODY } } } while (0)
}

template <class RowMap>
__device__ __forceinline__ void transpose_item(const float* W, int K, int N, bf16* WT, const RowMap& rowmap, LAS float* scr, int item, int lane) {
    const int nblk = (N + 31) / 32, kb = item / nblk, nb = item % nblk, k0 = 64 * kb, n0 = 32 * nb; const bool cv = n0 + (lane & 31) < N;
#pragma unroll 8
    for (int i = 0; i < 32; ++i) { const int kk = 2 * i + (lane >> 5); scr[kk * 33 + (lane & 31)] = cv ? W[(size_t)(k0 + kk) * N + n0 + (lane & 31)] : 0.f; }
    asm volatile("s_waitcnt lgkmcnt(0)" ::: "memory");
    const int c = lane & 7;
#pragma unroll
    for (int j = 0; j < 4; ++j) { const int n = (lane >> 3) + 8 * j; const LAS float* sp = scr + (8 * c) * 33 + n;
        u32x4 o; o.x = pk2(sp[0 * 33], sp[1 * 33]); o.y = pk2(sp[2 * 33], sp[3 * 33]); o.z = pk2(sp[4 * 33], sp[5 * 33]); o.w = pk2(sp[6 * 33], sp[7 * 33]);
        const int dr = rowmap(n0 + n);
        if (dr >= 0) *(u32x4*)(WT + (size_t)dr * K + k0 + 8 * c) = o; }
    asm volatile("s_waitcnt lgkmcnt(0)" ::: "memory");
}
__device__ __forceinline__ void zero_rows(bf16* WT, int K, int r0, int r1, int gw, int ngw, int lane) {
    const size_t n8 = (size_t)(r1 - r0) * K / 8; u32x4* p = (u32x4*)(WT + (size_t)r0 * K);
    for (size_t i = (size_t)gw * 64 + lane; i < n8; i += (size_t)ngw * 64) p[i] = (u32x4){0u, 0u, 0u, 0u};
}

struct Args { const void* in[29]; float* out; unsigned char* ws; };
__device__ __forceinline__ int hide(int i) { asm volatile("" : "+s"(i)); return i; }
__device__ __forceinline__ const void* arg_ptr(int i) {
    typedef const void* cvp;
    const __attribute__((address_space(4))) cvp* ka = (const __attribute__((address_space(4))) cvp*)__builtin_amdgcn_kernarg_segment_ptr();
    return ka[hide(i)];
}
#define INF(i) ((const float*)arg_ptr(i))
#define PH_BEGIN unsigned char* ws = (unsigned char*)arg_ptr(30); \
    const int tid = otid(), lane = tid & 63, wave = tid >> 6, G = ogrid(), bx = obid(), gw = bx * NWAVES + wave, ngw = G * NWAVES; (void)lane; (void)gw; (void)ngw; (void)ws
#define WSP(TYPE, OFF) ((TYPE*)(ws + (OFF)))

__device__ __forceinline__ void unpack8(u32x4 w, float (&x)[8]) {
#pragma unroll
    for (int j = 0; j < 4; ++j) { x[2 * j] = bf2f(w[j] & 0xffffu); x[2 * j + 1] = bf2f(w[j] >> 16); }
}
__device__ __forceinline__ f32x4 bf4(u32x2 w) { return (f32x4){bf2f(w[0] & 0xffffu), bf2f(w[0] >> 16), bf2f(w[1] & 0xffffu), bf2f(w[1] >> 16)}; }

__device__ __forceinline__ void moe_prefix(LAS unsigned char* lds, const unsigned* cnt) {
    LAS int* s_ts = (LAS int*)(lds + LDS_TS); LAS int* s_cn = (LAS int*)(lds + LDS_CN);
    LAS unsigned char* s_te = lds + LDS_TE;
    LAS int* s_xs = (LAS int*)(lds + LDS_XS);
    if (otid() == 0) { int acc = 0; for (int e = 0; e < NEXP; ++e) { const int c = (int)cnt[e]; s_ts[e] = acc; s_cn[e] = c; const int nt = (c + 255) >> 8; for (int i = 0; i < nt; ++i) s_te[acc + i] = (unsigned char)e; acc += nt; } s_ts[NEXP] = acc;
        const int x = obid() & 7; int a2 = 0; for (int k = 0; k < 8; ++k) { s_xs[k] = a2; a2 += (s_cn[x + 8 * k] + 255) >> 8; } s_xs[8] = a2; }
    __syncthreads();
}

__device__ __forceinline__ void ph_convert_dense(LAS unsigned char* lds) {
    PH_BEGIN;
    LAS float* scr = (LAS float*)(lds + wave * 8448);
    const float* w_in0 = INF(3); const float* w_uq = INF(6); const float* w_ukv = INF(7); const float* w_o0 = INF(9); const float* w_in1 = INF(18); const float* w_o1 = INF(21);
    bf16* W_IN0T = WSP(bf16, WS_W_IN0T); bf16* W_UQT = WSP(bf16, WS_W_UQT); bf16* W_UKVT = WSP(bf16, WS_W_UKVT); bf16* W_O0T = WSP(bf16, WS_W_O0T); bf16* W_IN1T = WSP(bf16, WS_W_IN1T); bf16* W_O1T = WSP(bf16, WS_W_O1T);
    constexpr int I0 = 32 * 34, I1 = 8 * 96, I2 = 8 * 128, I3 = 32 * 64, I4 = 32 * 257, I5 = 32 * 64;
    auto ident = [](int n) { return n; };
    auto map0 = [](int n) { return n < 1024 ? n : -1; };
    auto map1 = [](int n) { return n < 6144 ? n : (n < 6160 ? -1 : (n < 8208 ? n - 16 : -1)); };
    for (int it = gw; it < I0 + I1 + I2 + I3 + I4 + I5; it += ngw) {
        int r = it;
        if (r < I0) { transpose_item(w_in0, DM, 1088, W_IN0T, map0, scr, r, lane); continue; } r -= I0;
        if (r < I1) { transpose_item(w_uq, 512, 3072, W_UQT, ident, scr, r, lane); continue; } r -= I1;
        if (r < I2) { transpose_item(w_ukv, 512, 4096, W_UKVT, ident, scr, r, lane); continue; } r -= I2;
        if (r < I3) { transpose_item(w_o0, DM, DM, W_O0T, ident, scr, r, lane); continue; } r -= I3;
        if (r < I4) { transpose_item(w_in1, DM, 8208, W_IN1T, map1, scr, r, lane); continue; } r -= I4;
        transpose_item(w_o1, DM, DM, W_O1T, ident, scr, r, lane);
    }
    { bf16* SK = WSP(bf16, WS_SK); const float* w_rg0 = INF(11); const float* w_re0 = INF(13); const float* w_rg1 = INF(23); const float* w_re1 = INF(25);
      for (int idx = bx * NTHREADS + tid; idx < 4 * 256 * 256; idx += G * NTHREADS) {
          const int set = idx >> 16, n = (idx >> 8) & 255, k = (idx & 255) * 8, ks = k >> 9;
          float v[8];
#pragma unroll
          for (int i = 0; i < 8; ++i) { float x = 0.f;
              if (set == 0) { if (n < 64) x = w_in0[(size_t)(k + i) * 1088 + 1024 + n]; }
              else if (set == 1) { if (n < 16) x = w_in1[(size_t)(k + i) * 8208 + 6144 + n]; }
              else { const float* wg = set == 2 ? w_rg0 : w_rg1; const float* we = set == 2 ? w_re0 : w_re1; if (n < 8) x = wg[(k + i) * 8 + n]; else if (n < 72) x = we[(k + i) * 64 + n - 8]; }
              v[i] = x; }
          *(u32x4*)(SK + (size_t)set * (4 * 256 * 512) + ((size_t)ks * 256 + n) * 512 + (k & 511)) = (u32x4){pk2(v[0], v[1]), pk2(v[2], v[3]), pk2(v[4], v[5]), pk2(v[6], v[7])}; } }
}
template <int layer>
__device__ __forceinline__ void ph_convert_moe(LAS unsigned char* lds) {
    PH_BEGIN;
    LAS float* scr = (LAS float*)(lds + wave * 8448);
    const float* w_gu = INF(layer == 0 ? 15 : 27); const float* w_dn = INF(layer == 0 ? 16 : 28);
    bf16* W_GUT = WSP(bf16, WS_W_GUT); bf16* W_DT = WSP(bf16, WS_W_DT);
    auto gumap = [](int n) { const int which = n >> 9, f = n & 511; return (f >> 7) * 256 + ((f >> 6) & 1) * 128 + ((f >> 4) & 3) * 32 + ((f >> 2) & 3) * 8 + which * 4 + (f & 3); };
    auto ident = [](int n) { return n; };
    constexpr int IG = 32 * 32, ID = 8 * 64;
    for (int it = gw; it < NEXP * (IG + ID); it += ngw) {
        if (it < NEXP * IG) { const int e = it / IG, r = it % IG; transpose_item(w_gu + (size_t)e * DM * 1024, DM, 1024, W_GUT + (size_t)e * 1024 * DM, gumap, scr, r, lane); }
        else { const int v = it - NEXP * IG, e = v / ID, r = v % ID; transpose_item(w_dn + (size_t)e * DEXP * DM, DEXP, DM, W_DT + (size_t)e * DM * DEXP, ident, scr, r, lane); }
    }
}

template <int MODE>
__device__ __forceinline__ void norm_rows(LAS unsigned char* lds, float* in, const float* gain, const unsigned* cnt) {
    PH_BEGIN;
    bf16* HN = WSP(bf16, WS_HN); const bf16* YS = WSP(bf16, WS_YS); const int* TSLOT = WSP(int, WS_TSLOT); bf16* H1b = WSP(bf16, WS_H1);
    if (MODE != 0) moe_prefix(lds, cnt);
    const LAS int* s_ts = (const LAS int*)(lds + LDS_TS);
    for (int m = gw; m < T; m += ngw) {
        f32x4* xr = (f32x4*)(in + (size_t)m * DM) + lane; bf16* hb = H1b + (size_t)m * DM + 4 * lane;
        f32x4 v[8]; float ss = 0.f;
        const bf16* y0 = nullptr; const bf16* y1 = nullptr;
        if (MODE != 0) { const int s0 = TSLOT[2 * m], s1 = TSLOT[2 * m + 1];
            y0 = YS + ((size_t)s_ts[s0 >> 16] * 256 + (s0 & 0xffff)) * DM + 4 * lane; y1 = YS + ((size_t)s_ts[s1 >> 16] * 256 + (s1 & 0xffff)) * DM + 4 * lane; }
#pragma unroll
        for (int j = 0; j < 8; ++j) {
            if (MODE == 0) v[j] = xr[64 * j];
            else { v[j] = bf4(*(const u32x2*)(hb + 256 * j)) + bf4(*(const u32x2*)(y0 + 256 * j)) + bf4(*(const u32x2*)(y1 + 256 * j));
                if (MODE == 1) store4bf(hb + 256 * j, v[j]); else xr[64 * j] = v[j]; }
            ss += (v[j][0] * v[j][0] + v[j][1] * v[j][1]) + (v[j][2] * v[j][2] + v[j][3] * v[j][3]); }
        if (MODE != 2) {
            ss = wave_sum(ss);
            const float r = rsq(ss * (1.0f / DM) + EPS);
#pragma unroll
            for (int j = 0; j < 8; ++j) { const f32x4 g = ((const f32x4*)gain)[lane + 64 * j];
                store4bf(HN + (size_t)m * DM + 4 * lane + 256 * j, (f32x4){v[j][0] * r * g[0], v[j][1] * r * g[1], v[j][2] * r * g[2], v[j][3] * r * g[3]}); }
        }
    }
}

template <int NC>
__device__ __forceinline__ void skinny_gemm(LAS unsigned char* lds, const bf16* HN, const bf16* SKset, float* P, int G, int bx) {
    fg::SkinnySched S{(const char*)HN, (const char*)SKset, G, bx};
    auto E = [=](const f32x4 (&acc)[2][2][4][2], const fg::SkUnit& u, int wr, int wc, int fr, int fq) {
        float* Pt = P + ((size_t)u.ks * T + (size_t)u.pm * 256) * NC;
        FG_FOREACH(acc, { if (col < NC) { *(f32x4*)(Pt + (size_t)row * NC + col) = v0; *(f32x4*)(Pt + (size_t)row * NC + col + 4) = v1; } }); };
    fg::gemm_phase<false, fg::SkUnit>(lds, 512, S, E);
}
constexpr int LDS_EPI_TAB = 131072;
template <int HMASK>
__device__ __forceinline__ void epi_head_rstd(LAS unsigned char* lds, const f32x4 (&acc)[2][2][4][2], int par, int wr, int wc, int fr, int fq, float (&rstd)[2][4][2]) {
    LAS float* tab = (LAS float*)(lds + LDS_EPI_TAB) + par * 2048;
#pragma unroll
    for (int ai = 0; ai < 2; ++ai)
#pragma unroll
        for (int m = 0; m < 4; ++m) { const int row = ai * 128 + wr * 64 + m * 16 + fr;
#pragma unroll
            for (int bj = 0; bj < 2; ++bj) if (HMASK & (1 << bj)) { const f32x4 a = acc[ai][bj][m][0], b = acc[ai][bj][m][1];
                float ss = (a[0] * a[0] + a[1] * a[1]) + (a[2] * a[2] + a[3] * a[3]) + (b[0] * b[0] + b[1] * b[1]) + (b[2] * b[2] + b[3] * b[3]);
                ss += __shfl_xor(ss, 16); ss += __shfl_xor(ss, 32);
                if (fq == 0) tab[(row * 2 + bj) * 4 + wc] = ss; } }
    asm volatile("s_waitcnt lgkmcnt(0)" ::: "memory"); __builtin_amdgcn_s_barrier(); asm volatile("" ::: "memory");
#pragma unroll
    for (int ai = 0; ai < 2; ++ai)
#pragma unroll
        for (int m = 0; m < 4; ++m) { const int row = ai * 128 + wr * 64 + m * 16 + fr;
#pragma unroll
            for (int bj = 0; bj < 2; ++bj) { rstd[ai][m][bj] = 1.f;
                if (HMASK & (1 << bj)) { const f32x4 t = *(const LAS f32x4*)(tab + (row * 2 + bj) * 4); rstd[ai][m][bj] = rsq(((t[0] + t[1]) + (t[2] + t[3])) * (1.0f / 128) + EPS); } } }
}
template <int layer>
__device__ __forceinline__ void ph_gemm_z(LAS unsigned char* lds) {
    PH_BEGIN;
    bf16* HN = WSP(bf16, WS_HN); bf16* Z = WSP(bf16, WS_Z);
    if (layer == 0) {
        fg::DenseSched S{HN, WSP(bf16, WS_W_IN0T), 4, nullptr, nullptr, 0, DM, G, bx};
        auto E = [=](const f32x4 (&acc)[2][2][4][2], const fg::DUnit& u, int wr, int wc, int fr, int fq) {
            bf16* Zt = Z + (size_t)u.pm * 256 * 1024 + u.pn * 256;
            FG_FOREACH(acc, { store8bf(Zt + (size_t)row * 1024 + col, v0, v1); }); };
        fg::gemm_phase<false, fg::DUnit>(lds, DM, S, E);
        skinny_gemm<64>(lds, HN, WSP(bf16, WS_SK), WSP(float, WS_PK), G, bx);
    } else {
        fg::DenseSched S{HN, WSP(bf16, WS_W_IN1T), 32, nullptr, nullptr, 0, DM, G, bx};
        const float* gk = INF(20) + 128;
        auto E = [=](const f32x4 (&acc)[2][2][4][2], const fg::DUnit& u, int wr, int wc, int fr, int fq) {
            bf16* Zt = Z + (size_t)u.pm * 256 * 8192 + u.pn * 256;
            if (u.pn < 8 || u.pn >= 16) { FG_FOREACH(acc, { store8bf(Zt + (size_t)row * 8192 + col, v0, v1); }); }
            else {
                float rstd[2][4][2]; epi_head_rstd<3>(lds, acc, u.par, wr, wc, fr, fq, rstd);
                const f32x4 g0 = *(const f32x4*)(gk + wc * 32 + 8 * fq), g1 = *(const f32x4*)(gk + wc * 32 + 8 * fq + 4);
#pragma unroll
                for (int ai = 0; ai < 2; ++ai)
#pragma unroll
                    for (int m = 0; m < 4; ++m) { const int row = ai * 128 + wr * 64 + m * 16 + fr;
#pragma unroll
                        for (int bj = 0; bj < 2; ++bj) { const float r = rstd[ai][m][bj];
                            store8bf(Zt + (size_t)row * 8192 + bj * 128 + wc * 32 + 8 * fq, acc[ai][bj][m][0] * r * g0, acc[ai][bj][m][1] * r * g1); } } } };
        fg::gemm_phase<false, fg::DUnit>(lds, DM, S, E);
        skinny_gemm<16>(lds, HN, WSP(bf16, WS_SK) + (size_t)1 * 4 * 256 * 512, WSP(float, WS_PF), G, bx);
    }
}
__device__ __forceinline__ void ph_gemm_qkv(LAS unsigned char* lds) {
    PH_BEGIN;
    bf16* QL = WSP(bf16, WS_QL); bf16* KVL = WSP(bf16, WS_KVL);
    fg::DenseSched S{WSP(bf16, WS_CQN), WSP(bf16, WS_W_UQT), 12, WSP(bf16, WS_CKVN), WSP(bf16, WS_W_UKVT), 16, 512, G, bx};
    const float* gk = INF(8) + 192;
    auto E = [=](const f32x4 (&acc)[2][2][4][2], const fg::DUnit& u, int wr, int wc, int fr, int fq) {
        if (u.p == 0) { bf16* Ct = QL + (size_t)u.pm * 256 * 3072 + u.pn * 256;
            FG_FOREACH(acc, { store8bf(Ct + (size_t)row * 3072 + col, v0, v1); }); }
        else {
            float rstd[2][4][2]; epi_head_rstd<1>(lds, acc, u.par, wr, wc, fr, fq, rstd);
            const f32x4 g0 = *(const f32x4*)(gk + wc * 32 + 8 * fq), g1 = *(const f32x4*)(gk + wc * 32 + 8 * fq + 4);
            bf16* Ct = KVL + (size_t)u.pm * 256 * 4096 + u.pn * 256 + wc * 32 + 8 * fq;
#pragma unroll
            for (int ai = 0; ai < 2; ++ai)
#pragma unroll
                for (int m = 0; m < 4; ++m) { const int row = ai * 128 + wr * 64 + m * 16 + fr; const float r = rstd[ai][m][0];
                    store8bf(Ct + (size_t)row * 4096, acc[ai][0][m][0] * r * g0, acc[ai][0][m][1] * r * g1);
                    store8bf(Ct + (size_t)row * 4096 + 128, acc[ai][1][m][0], acc[ai][1][m][1]); } } };
    fg::gemm_phase<false, fg::DUnit>(lds, 512, S, E);
}
template <int layer>
__device__ __forceinline__ void ph_gemm_wo(LAS unsigned char* lds) {
    PH_BEGIN;
    const float* R = INF(0); bf16* H1b = WSP(bf16, WS_H1);
    const float* gff = INF(layer == 0 ? 10 : 22); bf16* HN = WSP(bf16, WS_HN); float* SSQ = WSP(float, WS_SSQ);
    fg::DenseSched S{WSP(bf16, WS_O), WSP(bf16, layer == 0 ? WS_W_O0T : WS_W_O1T), 8, nullptr, nullptr, 0, DM, G, bx};
    auto E = [=](const f32x4 (&acc)[2][2][4][2], const fg::DUnit& u, int wr, int wc, int fr, int fq) {
        const int colb = u.pn * 256 + wc * 32 + 8 * fq; const size_t o0 = (size_t)u.pm * 256 * DM + colb;
        f32x4 g[2][2];
#pragma unroll
        for (int bj = 0; bj < 2; ++bj) { g[bj][0] = *(const f32x4*)(gff + colb + bj * 128); g[bj][1] = *(const f32x4*)(gff + colb + bj * 128 + 4); }
#pragma unroll
        for (int ai = 0; ai < 2; ++ai) {
            f32x4 rr[4][2][2];
#pragma unroll
            for (int m = 0; m < 4; ++m)
#pragma unroll
                for (int bj = 0; bj < 2; ++bj) { const size_t o = o0 + (size_t)(ai * 128 + wr * 64 + m * 16 + fr) * DM + bj * 128;
                    if (layer == 0) { rr[m][bj][0] = *(const f32x4*)(R + o); rr[m][bj][1] = *(const f32x4*)(R + o + 4); }
                    else { const u32x4 w = *(const u32x4*)(H1b + o); rr[m][bj][0] = bf4((u32x2){w[0], w[1]}); rr[m][bj][1] = bf4((u32x2){w[2], w[3]}); } }
            asm volatile("" ::: "memory");
#pragma unroll
            for (int m = 0; m < 4; ++m) { const int row = ai * 128 + wr * 64 + m * 16 + fr; float ss = 0.f;
#pragma unroll
                for (int bj = 0; bj < 2; ++bj) { const size_t o = o0 + (size_t)row * DM + bj * 128;
                    const f32x4 h0 = rr[m][bj][0] + acc[ai][bj][m][0], h1 = rr[m][bj][1] + acc[ai][bj][m][1];
                    store8bf(H1b + o, h0, h1);
                    ss += (h0[0] * h0[0] + h0[1] * h0[1]) + (h0[2] * h0[2] + h0[3] * h0[3]) + (h1[0] * h1[0] + h1[1] * h1[1]) + (h1[2] * h1[2] + h1[3] * h1[3]);
                    store8bf(HN + o, h0 * g[bj][0], h1 * g[bj][1]); }
                ss += __shfl_xor(ss, 16); ss += __shfl_xor(ss, 32);
                if (fq == 0) SSQ[((size_t)u.pm * 256 + row) * 32 + u.pn * 4 + wc] = ss; } } };
    fg::gemm_phase<false, fg::DUnit>(lds, DM, S, E);
}

__device__ __forceinline__ void ph_mla_prep() {
    PH_BEGIN;
    const bf16* Z = WSP(bf16, WS_Z); bf16* CQN = WSP(bf16, WS_CQN); bf16* CKVN = WSP(bf16, WS_CKVN); bf16* KR = WSP(bf16, WS_KR); const float* PK = WSP(float, WS_PK);
    const float* gq = INF(4); const float* gkv = INF(5); const float* qkg = INF(8); const int* positions = (const int*)arg_ptr(1);
    for (int t = gw; t < T; t += ngw) {
        const bf16* zr = Z + (size_t)t * 1024;
        float xq[8], xk[8]; unpack8(*(const u32x4*)(zr + 8 * lane), xq); unpack8(*(const u32x4*)(zr + 512 + 8 * lane), xk);
        float sq = 0.f, sk = 0.f;
#pragma unroll
        for (int j = 0; j < 8; ++j) { sq += xq[j] * xq[j]; sk += xk[j] * xk[j]; }
        sq = wave_sum(sq); sk = wave_sum(sk);
        const float rq = rsq(sq * (1.0f / 512) + EPS), rk = rsq(sk * (1.0f / 512) + EPS);
        u32x4 oq, ok;
#pragma unroll
        for (int j = 0; j < 4; ++j) { oq[j] = pk2(xq[2 * j] * rq * gq[8 * lane + 2 * j], xq[2 * j + 1] * rq * gq[8 * lane + 2 * j + 1]);
                                      ok[j] = pk2(xk[2 * j] * rk * gkv[8 * lane + 2 * j], xk[2 * j + 1] * rk * gkv[8 * lane + 2 * j + 1]); }
        *(u32x4*)(CQN + (size_t)t * 512 + 8 * lane) = oq; *(u32x4*)(CKVN + (size_t)t * 512 + 8 * lane) = ok;
        const float* pk = PK + (size_t)t * 64 + lane;
        const float xr = (pk[0] + pk[(size_t)T * 64]) + (pk[(size_t)2 * T * 64] + pk[(size_t)3 * T * 64]);
        const float s2 = wave_sum(xr * xr);
        const float xn = xr * rsq(s2 * (1.0f / 64) + EPS) * qkg[192 + 128 + lane];
        KR[(size_t)t * 64 + lane] = (bf16)f2bf(rope64(xn, lane, (float)positions[t]));
    }
}
template <int LD, int COL0, int HSTRIDE>
__device__ __forceinline__ void knorm_rows(bf16* Kbase, const float* gain  , int gw, int ngw, int lane) {
    const int h = lane >> 2, part = lane & 3;
    f32x4 g[8];
#pragma unroll
    for (int i = 0; i < 8; ++i) g[i] = *(const f32x4*)(gain + part * 32 + 4 * i);
    for (int t = gw; t < T; t += ngw) {
        bf16* kp = Kbase + (size_t)t * LD + COL0 + h * HSTRIDE + part * 32;
        u32x4 w[4]; float x[32]; float ss = 0.f;
#pragma unroll
        for (int i = 0; i < 4; ++i) w[i] = *(const u32x4*)(kp + 8 * i);
#pragma unroll
        for (int i = 0; i < 4; ++i)
#pragma unroll
            for (int j = 0; j < 4; ++j) { x[8 * i + 2 * j] = bf2f(w[i][j] & 0xffffu); x[8 * i + 2 * j + 1] = bf2f(w[i][j] >> 16); }
#pragma unroll
        for (int i = 0; i < 32; ++i) ss += x[i] * x[i];
        ss += __shfl_xor(ss, 1); ss += __shfl_xor(ss, 2);
        const float r = rsq(ss * (1.0f / 128) + EPS);
#pragma unroll
        for (int i = 0; i < 4; ++i) { u32x4 o;
#pragma unroll
            for (int j = 0; j < 4; ++j) o[j] = pk2(x[8 * i + 2 * j] * r * g[2 * i + (j >> 1)][(2 * j) & 3], x[8 * i + 2 * j + 1] * r * g[2 * i + (j >> 1)][(2 * j + 1) & 3]);
            *(u32x4*)(kp + 8 * i) = o; }
    }
}
__device__ __forceinline__ void ph_mla_knorm() {
    PH_BEGIN;
    knorm_rows<4096, 0, 256>(WSP(bf16, WS_KVL), INF(8) + 192, gw, ngw, lane);
}
__device__ __forceinline__ void ph_fox_prep(LAS unsigned char* lds) {
    PH_BEGIN;
    const float* PF = WSP(float, WS_PF); float* CB = WSP(float, WS_C); const float* fb = INF(19);
    LAS float* wtot = (LAS float*)lds;
    for (int bh = bx; bh < NB * NH; bh += G) {
        const int b = bh >> 4, h = bh & 15; const float bias = fb[h];
        const float* pf = PF + ((size_t)b * SEQ + tid * 8) * 16 + h;
        float v[8]; float run = 0.f;
#pragma unroll
        for (int i = 0; i < 8; ++i) { const float* q = pf + i * 16;
            const float xx = ((q[0] + q[(size_t)T * 16]) + (q[(size_t)2 * T * 16] + q[(size_t)3 * T * 16])) + bias;
            run += fminf(xx, 0.f) - log1pf(expf(-fabsf(xx))); v[i] = run; }
        float incl = run;
#pragma unroll
        for (int o = 1; o < 64; o <<= 1) { const float up = __shfl_up(incl, o); if (lane >= o) incl += up; }
        if (lane == 63) wtot[wave] = incl;
        __syncthreads();
        float base = incl - run;
        for (int w = 0; w < wave; ++w) base += wtot[w];
        float* cb = CB + (size_t)bh * SEQ + tid * 8;
        *(f32x4*)cb = (f32x4){-(base + v[0]) * 1.4426950408889634f, -(base + v[1]) * 1.4426950408889634f, -(base + v[2]) * 1.4426950408889634f, -(base + v[3]) * 1.4426950408889634f};
        *(f32x4*)(cb + 4) = (f32x4){-(base + v[4]) * 1.4426950408889634f, -(base + v[5]) * 1.4426950408889634f, -(base + v[6]) * 1.4426950408889634f, -(base + v[7]) * 1.4426950408889634f};
        __syncthreads();
    }
}

namespace fa {
typedef short s16x4 __attribute__((ext_vector_type(4)));
typedef float f32x16 __attribute__((ext_vector_type(16)));
constexpr int KVB = 64, SHM_V = KVB * 128 * 2;
__device__ __forceinline__ int v_rd_base(int lane) { return ((lane & 3) << 3) | (((lane >> 2) & 3) << 6) | (((lane >> 4) & 1) << 5) | (((lane >> 5) & 1) << 8); }
constexpr int v_rd_off(int d0, int ks, int half) { return d0 * 512 + ks * 4096 + half * 2048; }
__device__ __forceinline__ int crow(int r, int hi) { return (r & 3) + 8 * (r >> 2) + 4 * hi; }
__device__ __forceinline__ unsigned cvtpk(float lo, float hi) { unsigned r; asm volatile("v_cvt_pk_bf16_f32 %0, %1, %2" : "=v"(r) : "v"(lo), "v"(hi)); return r; }

template <int layer>
__device__ __forceinline__ void attn_phase(LAS unsigned char* lds) {
    PH_BEGIN;
    constexpr int DK = layer == 0 ? 192 : 128, NQ = DK / 16, CPR = DK / 8, NKC = KVB * CPR / NTHREADS;
    constexpr int SHM_K = KVB * DK * 2;
    constexpr int OFF_V = 0, OFF_K = 2 * SHM_V, OFF_WS = OFF_K + 2 * SHM_K, OFF_CB = OFF_WS + NWAVES * 256, OFF_CV = 86016;
    static_assert(OFF_CB + 512 <= OFF_CV && OFF_CV + NWAVES * 8192 <= LDS_BARW, "attention LDS map");
    constexpr float C2 = (layer == 0 ? 0.07216878364870322f : 0.08838834764831845f) * 1.4426950408889634f;
    constexpr int QLD = layer == 0 ? 3072 : 8192, QHS = layer == 0 ? 192 : 128, KLD = layer == 0 ? 4096 : 8192, KC0 = layer == 0 ? 0 : 2048, KHS = layer == 0 ? 256 : 128, VC0 = layer == 0 ? 128 : 4096;
    const bf16* Qs = layer == 0 ? WSP(bf16, WS_QL) : WSP(bf16, WS_Z); const bf16* Ks = layer == 0 ? WSP(bf16, WS_KVL) : WSP(bf16, WS_Z); const bf16* KRs = WSP(bf16, WS_KR); bf16* Ob = WSP(bf16, WS_O);
    const float* qkg = INF(layer == 0 ? 8 : 20); const int* positions = (const int*)arg_ptr(1);
    const float* CBg = WSP(float, WS_C); const bf16* Zg = WSP(bf16, WS_Z);
    const int wid = __builtin_amdgcn_readfirstlane(tid >> 6), r32 = lane & 31, hi = lane >> 5;
    auto koff_n = [](int tk, int j) { const int ci = j * 256 + tk, row = ci >> 4, pc = ci & 15, lc = pc ^ (row & 7); return (unsigned)(row * KLD + lc * 8) * 2u; };
    auto koff_r = [](int tk, int j) { const int ci = j * 256 + tk, row = ci >> 3, pc = ci & 7, lc = pc ^ (row & 7); return (unsigned)(row * 64 + lc * 8) * 2u; };
    auto voff_f = [](int tk, int j) { const int ci = j * 256 + tk, st = ci >> 5, w = ci & 31, kk = (st >> 2) * 8 + (w >> 2), key = (kk & ~0xC) | ((kk & 4) << 1) | ((kk & 8) >> 1), c = (st & 3) * 32 + (w & 3) * 8;
        return (unsigned)(key * KLD + c) * 2u; };
    const int tkp = (tid - 256) & 255; const unsigned kof0 = koff_n(tkp, 0), vof0 = voff_f(tkp, 0), rof0 = koff_r(tkp, 0);
    const int kbn = r32 * 256 + ((hi * 16) ^ ((r32 & 7) << 4)), kbr0 = 16384 + r32 * 128 + ((hi * 16) ^ ((r32 & 7) << 4));
    const unsigned ldsb = (unsigned)(uintptr_t)lds;
    const int vb0 = (int)(unsigned)(uintptr_t)(lds + OFF_V) + v_rd_base(lane);
    LAS float* wsl = (LAS float*)(lds + OFF_WS) + wid * 64; LAS float* li_l = wsl; LAS float* al_l = wsl + 32;

    const float* cv_wgu = INF(layer == 0 ? 15 : 27); const float* cv_wdn = INF(layer == 0 ? 16 : 28); bf16* cv_gut = WSP(bf16, CV_MODE >= 2 ? WS_Q : WS_W_GUT); bf16* cv_dt = WSP(bf16, CV_MODE >= 2 ? WS_Q : WS_W_DT);
    constexpr int CV_IG = 32 * 32, CV_ID = 8 * 64, CV_NIT = NEXP * (CV_IG + CV_ID);
    int cv_it = (CV_MODE == 1) ? CV_NIT : bx * 4 + wid, cv_pend = -1; const int cv_stride = G * 4;
    const unsigned cv_lds = (unsigned)(uintptr_t)(lds + OFF_CV) + (unsigned)(wid & 3) * 16384u;
#define CV_DECODE(it_) const bool gu_ = (it_) < NEXP * CV_IG; const int v_ = gu_ ? (it_) : (it_) - NEXP * CV_IG, e_ = gu_ ? v_ >> 10 : v_ >> 9, r_ = gu_ ? v_ & 1023 : v_ & 511;     \
        const int lgN_ = gu_ ? 10 : 11, lgK_ = gu_ ? 11 : 9, N_ = 1 << lgN_, k0_ = (r_ >> (lgN_ - 5)) << 6, n0_ = (r_ & ((1 << (lgN_ - 5)) - 1)) << 5; \
        const float* W_ = (gu_ ? cv_wgu : cv_wdn) + ((size_t)e_ << (gu_ ? 21 : 20)); bf16* WT_ = (gu_ ? cv_gut : cv_dt) + (((size_t)e_ << (gu_ ? 21 : 20)) & (CV_MODE >= 2 ? (size_t)0x1ffffff : ~(size_t)0))
#define CV_ISSUE(it_, SLOT) do { { CV_DECODE(it_); const int lz_ = otid() & 63; \
        const unsigned vb_ = (unsigned)((lz_ >> 3) * N_) * 4u; const char* sb_ = (const char*)(W_ + (size_t)k0_ * N_ + n0_); \
        _Pragma("unroll") for (int i = 0; i < 8; ++i) { const char* si_ = sb_ + (size_t)i * 8 * N_ * 4; const unsigned vo_ = vb_ + ((unsigned)((lz_ & 7) ^ i) << 4); unsigned keep_; \
            asm volatile("s_mov_b32 %0, m0\n\ts_mov_b32 m0, %3\n\ts_nop 0\n\tglobal_load_lds_dwordx4 %1, %2 nt\n\ts_mov_b32 m0, %0" : "=&s"(keep_) : "v"(vo_), "s"(si_), "s"(cv_lds + (unsigned)(SLOT) * 8192u + (unsigned)i * 1024u) : "memory"); } } } while (0)
#define CV_FINISH(it_, SLOT) do { { CV_DECODE(it_); const int lz_ = otid() & 63, c_ = lz_ & 7; const LAS float* scr_ = (const LAS float*)(lds + OFF_CV) + (wid & 3) * 4096 + (SLOT) * 2048; \
        float cvr_[4][8];                                                                           \
        _Pragma("unroll") for (int j = 0; j < 4; ++j) { const int n_ = (lz_ >> 3) + 8 * j; const LAS float* sp_ = scr_ + (8 * c_) * 32 + (((n_ >> 2) ^ c_) << 2) + (n_ & 3); \
            _Pragma("unroll") for (int q = 0; q < 8; ++q) cvr_[j][q] = sp_[32 * q]; } \
        asm volatile("s_waitcnt lgkmcnt(0)" ::: "memory"); __builtin_amdgcn_sched_barrier(0); \
        _Pragma("unroll") for (int j = 0; j < 4; ++j) { const int n_ = (lz_ >> 3) + 8 * j; \
            u32x4 o_; o_.x = pk2(cvr_[j][0], cvr_[j][1]); o_.y = pk2(cvr_[j][2], cvr_[j][3]); o_.z = pk2(cvr_[j][4], cvr_[j][5]); o_.w = pk2(cvr_[j][6], cvr_[j][7]); \
            const int nn_ = n0_ + n_; const int f_ = nn_ & 511; \
            const int dr_ = gu_ ? ((f_ >> 7) * 256 + ((f_ >> 6) & 1) * 128 + ((f_ >> 4) & 3) * 32 + ((f_ >> 2) & 3) * 8 + (nn_ >> 9) * 4 + (f_ & 3)) : nn_;     \
            __builtin_nontemporal_store(o_, (u32x4*)(WT_ + ((size_t)dr_ << lgK_) + k0_ + 8 * c_)); } \
        } } while (0)
    u32x4 raw[NQ]; float posq = 0.f;
#define FA_QLOAD(B_, H_, QLO_) do { const int tzp = otid(), r32p = tzp & 31, hip = (tzp >> 5) & 1;     \
        const size_t tq_ = (size_t)(B_) * SEQ + (QLO_) + r32p; const bf16* qp_ = Qs + tq_ * QLD + (H_) * QHS + hip * 8; \
        _Pragma("unroll") for (int d0 = 0; d0 < NQ; ++d0) raw[d0] = *(const u32x4*)(qp_ + d0 * 16); \
        if (layer == 0) posq = (float)positions[tq_]; } while (0)
    { const int bh0 = (bx & 7) * 8 + (bx >> 6), pair0 = (bx >> 3) & 7; FA_QLOAD(bh0 >> 4, bh0 & 15, (15 - pair0) * 256 + wid * 32); }
    for (int L = bx; L < NB * NH * 8; L += G) {
        const int bh = (L & 7) * 8 + (L >> 6), pair = (L >> 3) & 7, b = bh >> 4, h = bh & 15;
        const char* Kg = (const char*)(Ks + (size_t)b * SEQ * KLD + KC0 + h * KHS); const char* Vg = (const char*)(Ks + (size_t)b * SEQ * KLD + VC0 + h * KHS);
        const char* KRg = (const char*)(KRs + (size_t)b * SEQ * 64); const float* cbg = CBg + (size_t)bh * SEQ;
        for (int pass = 0; pass < 2; ++pass) {
            const int qb = pass ? pair : 15 - pair, P0 = qb * 256, NT = P0 / KVB + 4, qlo = P0 + wid * 32;
            bf16x8 qr[NQ];
            {
                float ss = 0.f;
#pragma unroll
                for (int d0 = 0; d0 < 8; ++d0)
#pragma unroll
                    for (int j = 0; j < 4; ++j) { const float x0 = bf2f(raw[d0][j] & 0xffffu), x1 = bf2f(raw[d0][j] >> 16); ss += x0 * x0 + x1 * x1; }
                { auto rr = __builtin_amdgcn_permlane32_swap(__float_as_uint(ss), __float_as_uint(ss), false, false); ss = __uint_as_float(rr[0]) + __uint_as_float(rr[1]); }
                const float rn = rsq(ss * (1.0f / 128) + EPS) * C2;
#pragma unroll
                for (int d0 = 0; d0 < 8; ++d0) { const f32x4 g0 = *(const f32x4*)(qkg + d0 * 16 + hi * 8), g1 = *(const f32x4*)(qkg + d0 * 16 + hi * 8 + 4); u32x4 o;
#pragma unroll
                    for (int j = 0; j < 4; ++j) { const float x0 = bf2f(raw[d0][j] & 0xffffu), x1 = bf2f(raw[d0][j] >> 16); const f32x4 gg = j < 2 ? g0 : g1;
                        o[j] = cvtpk(x0 * rn * gg[(2 * j) & 3], x1 * rn * gg[(2 * j + 1) & 3]); }
                    qr[d0] = *reinterpret_cast<bf16x8*>(&o); }
                if constexpr (layer == 0) {
                    float xr[4][8]; float s2 = 0.f;
#pragma unroll
                    for (int c = 0; c < 4; ++c)
#pragma unroll
                        for (int j = 0; j < 4; ++j) { xr[c][2 * j] = bf2f(raw[8 + c][j] & 0xffffu); xr[c][2 * j + 1] = bf2f(raw[8 + c][j] >> 16); s2 += xr[c][2 * j] * xr[c][2 * j] + xr[c][2 * j + 1] * xr[c][2 * j + 1]; }
                    { auto rr = __builtin_amdgcn_permlane32_swap(__float_as_uint(s2), __float_as_uint(s2), false, false); s2 = __uint_as_float(rr[0]) + __uint_as_float(rr[1]); }
                    const float r2 = rsq(s2 * (1.0f / 64) + EPS); const float pos = posq;
#pragma unroll
                    for (int c = 0; c < 4; ++c) { const f32x4 g0 = *(const f32x4*)(qkg + 128 + c * 16 + hi * 8), g1 = *(const f32x4*)(qkg + 128 + c * 16 + hi * 8 + 4);
#pragma unroll
                        for (int j = 0; j < 8; ++j) xr[c][j] *= r2 * (j < 4 ? g0[j & 3] : g1[j & 3]); }
#pragma unroll
                    for (int c = 0; c < 2; ++c) { u32x4 o1, o2;
#pragma unroll
                        for (int jj = 0; jj < 4; ++jj) { float y1[2], y2[2];
#pragma unroll
                            for (int e = 0; e < 2; ++e) { const int j = 2 * jj + e; const int i = c * 16 + hi * 8 + j;
                                const float freq = exp2f(-(float)i * (13.287712379549449f / 32.0f)); float rev = pos * freq * 0.15915494309189535f; rev -= floorf(rev);
                                const float sn = __builtin_amdgcn_sinf(rev), cs = __builtin_amdgcn_cosf(rev);
                                y1[e] = (xr[c][j] * cs - xr[c + 2][j] * sn) * C2; y2[e] = (xr[c + 2][j] * cs + xr[c][j] * sn) * C2; }
                            o1[jj] = cvtpk(y1[0], y1[1]); o2[jj] = cvtpk(y2[0], y2[1]); }
                        qr[8 + c] = *reinterpret_cast<bf16x8*>(&o1); qr[10 + c] = *reinterpret_cast<bf16x8*>(&o2); }
                }
            }
            float m_reg = 0.f, l_reg = 0.f; f32x16 o[4];
#pragma unroll
            for (int d0 = 0; d0 < 4; ++d0)
#pragma unroll
                for (int r = 0; r < 16; ++r) o[d0][r] = 0.f;
#define FA_DMA16(sbase_, voff_, ldsaddr_) do { unsigned keep_; asm volatile("s_mov_b32 %0, m0\n\ts_mov_b32 m0, %3\n\ts_nop 0\n\tglobal_load_lds_dwordx4 %1, %2\n\ts_mov_b32 m0, %0" \
        : "=&s"(keep_) : "v"(voff_), "s"(sbase_), "s"(ldsaddr_) : "memory"); } while (0)
#define FA_DMA4(sbase_, voff_, ldsaddr_) do { unsigned keep_; asm volatile("s_mov_b32 %0, m0\n\ts_mov_b32 m0, %3\n\ts_nop 0\n\tglobal_load_lds_dword %1, %2\n\ts_mov_b32 m0, %0" \
        : "=&s"(keep_) : "v"(voff_), "s"(sbase_), "s"(ldsaddr_) : "memory"); } while (0)
#define FA_ISSUE(t_, BUF) do { if (wid >= 4) { const char* ks_ = Kg + (size_t)(t_) * (KVB * KLD * 2); const char* vs_ = Vg + (size_t)(t_) * (KVB * KLD * 2); const unsigned wl_ = (unsigned)(wid - 4) * 1024u; \
        _Pragma("unroll") for (int j = 0; j < 4; ++j) FA_DMA16(ks_, kof0 + (unsigned)(j * 16 * KLD * 2), ldsb + (unsigned)(OFF_K + (BUF) * SHM_K + j * 4096) + wl_); \
        if constexpr (layer == 0) { const char* kr_ = KRg + (size_t)(t_) * (KVB * 64 * 2); \
            _Pragma("unroll") for (int j = 0; j < 2; ++j) FA_DMA16(kr_, rof0 + (unsigned)(j * 32 * 64 * 2), ldsb + (unsigned)(OFF_K + (BUF) * SHM_K + 16384 + j * 4096) + wl_); } \
        _Pragma("unroll") for (int j = 0; j < 4; ++j) FA_DMA16(vs_, vof0 + (unsigned)(j * 16 * KLD * 2), ldsb + (unsigned)(OFF_V + (BUF) * SHM_V + j * 4096) + wl_); \
        if (layer == 1 && wid == 4) { const float* cs_ = cbg + (t_) * KVB; FA_DMA4(cs_, (unsigned)lane * 4u, ldsb + (unsigned)(OFF_CB + (BUF) * 256)); } } } while (0)
#define FA_TRRD(dst, off) asm volatile("ds_read_b64_tr_b16 %0, %1 offset:%2" : "=&v"(dst) : "v"(vb0), "i"(off) : "memory")
#define FA_PV_D0(BUF, d0) do { s16x4 l0, l1, l2, l3, h0, h1, h2, h3; constexpr int b_ = (BUF) * SHM_V + v_rd_off(d0, 0, 0); \
        FA_TRRD(l0, b_); FA_TRRD(h0, b_ + 2048); FA_TRRD(l1, b_ + 4096); FA_TRRD(h1, b_ + 6144); FA_TRRD(l2, b_ + 8192); FA_TRRD(h2, b_ + 10240); FA_TRRD(l3, b_ + 12288); FA_TRRD(h3, b_ + 14336); \
        asm volatile("s_waitcnt lgkmcnt(0)" ::: "memory"); __builtin_amdgcn_sched_barrier(0); \
        o[d0] = __builtin_amdgcn_mfma_f32_32x32x16_bf16((bf16x8){l0[0], l0[1], l0[2], l0[3], h0[0], h0[1], h0[2], h0[3]}, pa0, o[d0], 0, 0, 0); \
        o[d0] = __builtin_amdgcn_mfma_f32_32x32x16_bf16((bf16x8){l1[0], l1[1], l1[2], l1[3], h1[0], h1[1], h1[2], h1[3]}, pa1, o[d0], 0, 0, 0); \
        o[d0] = __builtin_amdgcn_mfma_f32_32x32x16_bf16((bf16x8){l2[0], l2[1], l2[2], l2[3], h2[0], h2[1], h2[2], h2[3]}, pa2, o[d0], 0, 0, 0); \
        o[d0] = __builtin_amdgcn_mfma_f32_32x32x16_bf16((bf16x8){l3[0], l3[1], l3[2], l3[3], h3[0], h3[1], h3[2], h3[3]}, pa3, o[d0], 0, 0, 0); } while (0)
#define FA_PK4(P, B_, OUT) do { const unsigned a0 = cvtpk(P[B_ + 0], P[B_ + 1]), a1 = cvtpk(P[B_ + 2], P[B_ + 3]), b0_ = cvtpk(P[B_ + 4], P[B_ + 5]), b1_ = cvtpk(P[B_ + 6], P[B_ + 7]); \
        auto r0 = __builtin_amdgcn_permlane32_swap(a0, b0_, false, false); auto r1 = __builtin_amdgcn_permlane32_swap(a1, b1_, false, false); \
        u32x4 w_ = {r0[0], r1[0], r0[1], r1[1]}; OUT = *reinterpret_cast<bf16x8*>(&w_); } while (0)
#define FA_STEP(t_, BUF) do { \
          \
        if (wid >= 4 || (t_) == 0) asm volatile("s_waitcnt vmcnt(0)" ::: "memory");                 \
        asm volatile("s_waitcnt lgkmcnt(0)" ::: "memory"); __builtin_amdgcn_s_barrier(); asm volatile("" ::: "memory");     \
        if ((t_) + 1 < NT) FA_ISSUE((t_) + 1, (BUF) ^ 1); \
        if (wid < 4) {                                                                             \
            if (cv_pend >= 0) { asm volatile("s_waitcnt vmcnt(0)" ::: "memory"); CV_FINISH(cv_pend, (BUF) ^ 1); cv_pend = -1; }     \
            if (cv_it < CV_NIT) { CV_ISSUE(cv_it, BUF); cv_pend = cv_it; cv_it += cv_stride; } }         \
        const int kbase = (t_) * KVB; \
        if (kbase <= qlo + 31) {                                                                   \
            f32x16 p0, p1; \
            _Pragma("unroll") for (int r = 0; r < 16; ++r) { p0[r] = 0.f; p1[r] = 0.f; } \
            const LAS unsigned char* kt = lds + OFF_K + (BUF) * SHM_K; \
            int kbn_ = kbn, kbr_ = kbr0; asm volatile("" : "+v"(kbn_), "+v"(kbr_));                 \
            if (wid < 4) __builtin_amdgcn_s_setprio(2); else __builtin_amdgcn_s_setprio(1);          \
            _Pragma("unroll") for (int d0 = 0; d0 < NQ; ++d0) { const LAS unsigned char* a_ = d0 < 8 ? kt + (kbn_ ^ ((d0 & 3) << 5)) + (d0 >> 2) * 128 : kt + (kbr_ ^ ((d0 & 3) << 5)); \
                const bf16x8 k0 = *(const LAS bf16x8*)a_, k1 = *(const LAS bf16x8*)(a_ + (d0 < 8 ? 32 * 256 : 32 * 128)); \
                p0 = __builtin_amdgcn_mfma_f32_32x32x16_bf16(k0, qr[d0], p0, 0, 0, 0); p1 = __builtin_amdgcn_mfma_f32_32x32x16_bf16(k1, qr[d0], p1, 0, 0, 0); \
                if ((d0 & 3) == 3) __builtin_amdgcn_sched_barrier(0); } \
            if (layer == 1) { const LAS f32x4* cb = (const LAS f32x4*)(lds + OFF_CB + (BUF) * 256); \
                _Pragma("unroll") for (int g = 0; g < 4; ++g) { const f32x4 c0 = cb[2 * g + hi], c1 = cb[8 + 2 * g + hi]; \
                    _Pragma("unroll") for (int j = 0; j < 4; ++j) { p0[4 * g + j] += c0[j]; p1[4 * g + j] += c1[j]; } \
                    __builtin_amdgcn_sched_barrier(0); } } \
            if (kbase + KVB - 1 > qlo) { const int dq = qlo + r32 - 4 * hi - kbase; const float NEG = -__builtin_inff();     \
                _Pragma("unroll") for (int r = 0; r < 16; ++r) { const int c = (r & 3) + 8 * (r >> 2); if (dq - c < 0) p0[r] = NEG; if (dq - c - 32 < 0) p1[r] = NEG; } } \
            float pmax = p0[0]; \
            _Pragma("unroll") for (int r = 1; r < 16; ++r) pmax = fmaxf(pmax, p0[r]); \
            _Pragma("unroll") for (int r = 0; r < 16; ++r) pmax = fmaxf(pmax, p1[r]); \
            { auto rr = __builtin_amdgcn_permlane32_swap(__float_as_uint(pmax), __float_as_uint(pmax), false, false); pmax = fmaxf(__uint_as_float(rr[0]), __uint_as_float(rr[1])); } \
              \
            if ((t_) == 0) m_reg = pmax < -64.0f ? pmax : 0.f; \
            float mn, alpha; \
            if (__all(pmax - m_reg <= 64.0f)) { mn = m_reg; alpha = 1.f; } else { mn = fmaxf(m_reg, pmax); alpha = __builtin_amdgcn_exp2f(m_reg - mn); m_reg = mn; } \
            float ps = 0.f; \
            if (__all(mn == 0.f)) { _Pragma("unroll") for (int r = 0; r < 16; ++r) { p0[r] = __builtin_amdgcn_exp2f(p0[r]); p1[r] = __builtin_amdgcn_exp2f(p1[r]); ps += p0[r] + p1[r]; } } \
            else { _Pragma("unroll") for (int r = 0; r < 16; ++r) { p0[r] = __builtin_amdgcn_exp2f(p0[r] - mn); p1[r] = __builtin_amdgcn_exp2f(p1[r] - mn); ps += p0[r] + p1[r]; } } \
            { auto rr = __builtin_amdgcn_permlane32_swap(__float_as_uint(ps), __float_as_uint(ps), false, false); ps = __uint_as_float(rr[0]) + __uint_as_float(rr[1]); } \
            l_reg = l_reg * alpha + ps; \
            bf16x8 pa0, pa1, pa2, pa3; FA_PK4(p0, 0, pa0); FA_PK4(p0, 8, pa1); FA_PK4(p1, 0, pa2); FA_PK4(p1, 8, pa3); \
            if (__any(alpha < 1.f)) {                                                              \
                _Pragma("unroll") for (int d_ = 0; d_ < 4; ++d_) _Pragma("unroll") for (int r = 0; r < 16; ++r) o[d_][r] *= alpha; } \
            FA_PV_D0(BUF, 0); FA_PV_D0(BUF, 1); FA_PV_D0(BUF, 2); FA_PV_D0(BUF, 3); __builtin_amdgcn_s_setprio(0); \
        } \
        } while (0)
            if (pass == 0) FA_ISSUE(0, 0);
            for (int t = 0; t < NT; t += 2) { FA_STEP(t, 0); FA_STEP(t + 1, 1); }
            if (pass == 0) { FA_ISSUE(0, 0); FA_QLOAD(b, h, pair * 256 + wid * 32); }
            else { const int Ln = L + G < NB * NH * 8 ? L + G : L, bhn = (Ln & 7) * 8 + (Ln >> 6), pairn = (Ln >> 3) & 7; FA_QLOAD(bhn >> 4, bhn & 15, (15 - pairn) * 256 + wid * 32); }
            { const int tz = otid(), hz = (tz >> 5) & 1, rz = tz & 31;
              const size_t trow = (size_t)b * SEQ + qlo + rz; const float rl = __builtin_amdgcn_rcpf(l_reg);
              u32x2 gts[4][4];
              if (layer == 1) { const bf16* gp = Zg + trow * 8192 + 6144 + h * 128 + 4 * hz;
#pragma unroll
                  for (int d0 = 0; d0 < 4; ++d0)
#pragma unroll
                      for (int g = 0; g < 4; ++g) gts[d0][g] = *(const u32x2*)(gp + d0 * 32 + 8 * g); }
              bf16* op = Ob + trow * DM + h * 128 + 8 * hz;
#pragma unroll
              for (int d0 = 0; d0 < 4; ++d0)
#pragma unroll
                  for (int gp2 = 0; gp2 < 2; ++gp2) { unsigned pk[2][2];
#pragma unroll
                      for (int e = 0; e < 2; ++e) { const int g = 2 * gp2 + e; float v[4];
#pragma unroll
                          for (int j = 0; j < 4; ++j) v[j] = o[d0][4 * g + j] * rl;
                          if (layer == 1) { const u32x2 gw = gts[d0][g]; const float g4[4] = {bf2f(gw[0] & 0xffffu), bf2f(gw[0] >> 16), bf2f(gw[1] & 0xffffu), bf2f(gw[1] >> 16)};
#pragma unroll
                              for (int j = 0; j < 4; ++j) v[j] *= 1.0f / (1.0f + __expf(-g4[j])); }
                          pk[e][0] = cvtpk(v[0], v[1]); pk[e][1] = cvtpk(v[2], v[3]); }
                      auto s0 = __builtin_amdgcn_permlane32_swap(pk[0][0], pk[1][0], false, false); auto s1 = __builtin_amdgcn_permlane32_swap(pk[0][1], pk[1][1], false, false);
                      *(u32x4*)(op + d0 * 32 + 16 * gp2) = (u32x4){s0[0], s1[0], s0[1], s1[1]}; } }
        }
    }
    asm volatile("s_waitcnt vmcnt(0)" ::: "memory");
    if (wid < 4) { if (cv_pend >= 0) CV_FINISH(cv_pend, 1);
        while (cv_it < CV_NIT) { CV_ISSUE(cv_it, 0); asm volatile("s_waitcnt vmcnt(0)" ::: "memory"); CV_FINISH(cv_it, 0); cv_it += cv_stride; } }
    __syncthreads();
#undef CV_DECODE
#undef CV_ISSUE
#undef CV_FINISH
#undef FA_ISSUE
#undef FA_DMA16
#undef FA_DMA4
#undef FA_TRRD
#undef FA_PV_D0
#undef FA_PK4
#undef FA_STEP
#undef FA_QLOAD
}
}

template <int layer>
__device__ __forceinline__ void ph_router(LAS unsigned char* lds) {
    PH_BEGIN;
    skinny_gemm<80>(lds, WSP(bf16, WS_HN), WSP(bf16, WS_SK) + (size_t)(2 + layer) * 4 * 256 * 512, WSP(float, WS_PR), G, bx);
}
template <int layer>
__device__ __forceinline__ void ph_route() {
    PH_BEGIN;
    const float* PR = WSP(float, WS_PR); int* TOK = WSP(int, WS_TOK); float* GATE = WSP(float, WS_GATE); int* TSLOT = WSP(int, WS_TSLOT); const float* SSQ = WSP(float, WS_SSQ); float* RSL = WSP(float, WS_RSL);
    unsigned* cnt = WSP(unsigned, WS_CTL) + (layer == 0 ? CW_CNT0 : CW_CNT1);
    const float* b_rg = INF(layer == 0 ? 12 : 24); const float* b_re = INF(layer == 0 ? 14 : 26);
    for (int t = bx * NTHREADS + tid; t < T; t += G * NTHREADS) {
        const float* pr = PR + (size_t)t * 80;
        float rstd; { f32x4 q = *(const f32x4*)(SSQ + (size_t)t * 32);
#pragma unroll
            for (int i = 1; i < 8; ++i) q += *(const f32x4*)(SSQ + (size_t)t * 32 + 4 * i);
            rstd = rsq(((q[0] + q[1]) + (q[2] + q[3])) * (1.0f / DM) + EPS); }
        auto sum4 = [=](int j) { const f32x4 a0 = *(const f32x4*)(pr + j), a1 = *(const f32x4*)(pr + (size_t)T * 80 + j), a2 = *(const f32x4*)(pr + (size_t)2 * T * 80 + j), a3 = *(const f32x4*)(pr + (size_t)3 * T * 80 + j);
            return (a0 + a1) + (a2 + a3); };
        float gl[8]; int g = 0; float gm = -3.0e38f;
        { const f32x4 x0 = sum4(0), x1 = sum4(4);
#pragma unroll
          for (int j = 0; j < 8; ++j) { gl[j] = (j < 4 ? x0[j & 3] : x1[j & 3]) * rstd + b_rg[j]; if (gl[j] > gm) { gm = gl[j]; g = j; } } }
        float se = 0.f;
#pragma unroll
        for (int j = 0; j < 8; ++j) se += expf(gl[j] - gm);
        const float pg = 1.0f / se;
        float el[8]; int i1 = 0; float m1 = -3.0e38f;
        { const f32x4 x0 = sum4(8 + g * 8), x1 = sum4(12 + g * 8);
#pragma unroll
          for (int j = 0; j < 8; ++j) { el[j] = (j < 4 ? x0[j & 3] : x1[j & 3]) * rstd + b_re[g * 8 + j]; if (el[j] > m1) { m1 = el[j]; i1 = j; } } }
        int i2 = 0; float m2 = -3.0e38f;
#pragma unroll
        for (int j = 0; j < 8; ++j) { if (j != i1 && el[j] > m2) { m2 = el[j]; i2 = j; } }
        const float w2 = expf(m2 - m1), g1 = pg / (1.0f + w2), g2 = pg * w2 / (1.0f + w2);
        const int e1 = g * 8 + i1, e2 = g * 8 + i2;
        const unsigned s1 = atomicAdd(&cnt[e1], 1u); TOK[(size_t)e1 * T + s1] = t; GATE[(size_t)e1 * T + s1] = g1; RSL[(size_t)e1 * T + s1] = rstd;
        const unsigned s2 = atomicAdd(&cnt[e2], 1u); TOK[(size_t)e2 * T + s2] = t; GATE[(size_t)e2 * T + s2] = g2; RSL[(size_t)e2 * T + s2] = rstd;
        TSLOT[2 * t] = (e1 << 16) | (int)s1; TSLOT[2 * t + 1] = (e2 << 16) | (int)s2;
    }
}
struct MUnit { int e, mt, mtg, pn, ce; };
template <bool GU>
struct MoeSched {
    const LAS int* ts; const LAS int* cn; const char* A; const char* B; const int* tok; int G, c;
    static constexpr int NPN = GU ? 4 : 8, K = GU ? DM : DEXP;
    __device__ __forceinline__ bool next(int i, MUnit& u) const {
        const LAS int* xs = (const LAS int*)((const LAS unsigned char*)ts + (LDS_XS - LDS_TS));
        const int x = c & 7, W = G >> 3, q = i * W + (c >> 3); if ((G & 7) != 0 || q >= xs[8] * NPN) return false;
        int k = 0; while (xs[k + 1] * NPN <= q) ++k;
        const int e = x + 8 * k, rq = q - xs[k] * NPN, nte = xs[k + 1] - xs[k]; u.pn = rq / nte; u.mt = rq - u.pn * nte;
        u.e = e; u.mtg = ts[e] + u.mt; u.ce = cn[e]; return true; }
    __device__ __forceinline__ const char* a_base(const MUnit& u) const { return GU ? A : A + (size_t)u.mtg * 256 * DEXP * 2; }
    __device__ __forceinline__ const char* b_base(const MUnit& u) const { return B + ((size_t)u.e * (GU ? 1024 : DM) + u.pn * 256) * K * 2; }
    __device__ __forceinline__ unsigned a_voff(const MUnit& u, int row, int col) const {
        if (GU) { const int s = u.mt * 256 + row; return (unsigned)tok[(size_t)u.e * T + (s < u.ce ? s : 0)] * (unsigned)(DM * 2) + (unsigned)col * 2u; }
        return (unsigned)(row * DEXP + col) * 2u; }
    __device__ __forceinline__ bool lo_only(const MUnit& u) const { return u.ce - u.mt * 256 <= 128; }
};
template <int layer>
__device__ __forceinline__ void ph_gateup(LAS unsigned char* lds) {
    PH_BEGIN;
    moe_prefix(lds, WSP(unsigned, WS_CTL) + (layer == 0 ? CW_CNT0 : CW_CNT1));
    bf16* ACT = WSP(bf16, WS_ACT); const float* RSL = WSP(float, WS_RSL);
    MoeSched<true> S{(const LAS int*)(lds + LDS_TS), (const LAS int*)(lds + LDS_CN), (const char*)WSP(bf16, WS_HN), (const char*)WSP(bf16, WS_W_GUT), WSP(int, WS_TOK), G, bx};
    auto E = [=](const f32x4 (&acc)[2][2][4][2], const MUnit& u, int wr, int wc, int fr, int fq) {
        bf16* At = ACT + (size_t)u.mtg * 256 * DEXP + u.pn * 128 + wc * 16 + 4 * fq;
        float rsv[2][4];
#pragma unroll
        for (int ai = 0; ai < 2; ++ai)
#pragma unroll
            for (int m = 0; m < 4; ++m) { const int row = ai * 128 + wr * 64 + m * 16 + fr; rsv[ai][m] = u.mt * 256 + row < u.ce ? RSL[(size_t)u.e * T + u.mt * 256 + row] : 0.f; }
        asm volatile("" ::: "memory");
#pragma unroll
        for (int ai = 0; ai < 2; ++ai)
#pragma unroll
            for (int m = 0; m < 4; ++m) { const int row = ai * 128 + wr * 64 + m * 16 + fr; if (ai == 1 && u.ce - u.mt * 256 <= 128) continue;
                const float rs = rsv[ai][m];
#pragma unroll
                for (int bj = 0; bj < 2; ++bj) { const f32x4 g = acc[ai][bj][m][0] * rs, up = acc[ai][bj][m][1] * rs; f32x4 o;
#pragma unroll
                    for (int j = 0; j < 4; ++j) o[j] = g[j] / (1.0f + __expf(-g[j])) * up[j];
                    store4bf(At + (size_t)row * DEXP + bj * 64, o); } } };
    fg::gemm_phase<true, MUnit>(lds, DM, S, E);
}
template <int layer>
__device__ __forceinline__ void ph_down(LAS unsigned char* lds) {
    PH_BEGIN;
    moe_prefix(lds, WSP(unsigned, WS_CTL) + (layer == 0 ? CW_CNT0 : CW_CNT1));
    bf16* YS = WSP(bf16, WS_YS); const float* GATE = WSP(float, WS_GATE);
    MoeSched<false> S{(const LAS int*)(lds + LDS_TS), (const LAS int*)(lds + LDS_CN), (const char*)WSP(bf16, WS_ACT), (const char*)WSP(bf16, WS_W_DT), nullptr, G, bx};
    auto E = [=](const f32x4 (&acc)[2][2][4][2], const MUnit& u, int wr, int wc, int fr, int fq) {
        const int rem = u.ce - u.mt * 256; const float* gt = GATE + (size_t)u.e * T + u.mt * 256;
        bf16* Yt = YS + (size_t)u.mtg * 256 * DM + u.pn * 256 + wc * 32 + 8 * fq;
        float gv[2][4];
#pragma unroll
        for (int ai = 0; ai < 2; ++ai)
#pragma unroll
            for (int m = 0; m < 4; ++m) { const int row = ai * 128 + wr * 64 + m * 16 + fr; gv[ai][m] = row < rem ? gt[row] : 0.f; }
        asm volatile("" ::: "memory");
#pragma unroll
        for (int ai = 0; ai < 2; ++ai)
#pragma unroll
            for (int m = 0; m < 4; ++m) { const int row = ai * 128 + wr * 64 + m * 16 + fr;
                if (row < rem) { const float g = gv[ai][m];
#pragma unroll
                    for (int bj = 0; bj < 2; ++bj) store8bf(Yt + (size_t)row * DM + bj * 128, acc[ai][bj][m][0] * g, acc[ai][bj][m][1] * g); } } };
    fg::gemm_phase<false, MUnit>(lds, DEXP, S, E);
}

#define GRID_BAR() xcd_barrier(bar)
__global__ void __launch_bounds__(NTHREADS, 2) fwd(Args a) {
    extern __shared__ __attribute__((aligned(16))) unsigned char lds_raw[];
    LAS unsigned char* lds = (LAS unsigned char*)lds_raw;
    (void)a;
    if (threadIdx.x < 4) ((LAS unsigned*)(lds + LDS_BARW))[threadIdx.x] = 0u;
    __syncthreads();
    unsigned* ctl0 = (unsigned*)arg_ptr(30);
    const XcdBarrier bar = xcd_barrier_post(ctl0 + CW_BAR, (volatile LAS unsigned*)(lds + LDS_BARW));
    ph_convert_dense(lds);
    if (CV_MODE >= 1) ph_convert_moe<0>(lds);
    norm_rows<0>(lds, const_cast<float*>(INF(0)), INF(2), nullptr); GRID_BAR();
    ph_gemm_z<0>(lds); GRID_BAR();
    ph_mla_prep(); GRID_BAR();
    ph_gemm_qkv(lds); GRID_BAR();
    fa::attn_phase<0>(lds); GRID_BAR();
    ph_gemm_wo<0>(lds); GRID_BAR();
    ph_router<0>(lds); GRID_BAR();
    ph_route<0>(); GRID_BAR();
    ph_gateup<0>(lds); GRID_BAR();
    ph_down<0>(lds); GRID_BAR();
    norm_rows<1>(lds, (float*)arg_ptr(29), INF(17), (const unsigned*)arg_ptr(30) + CW_CNT0); if (CV_MODE >= 1) ph_convert_moe<1>(lds); GRID_BAR();
    ph_gemm_z<1>(lds); GRID_BAR();
    ph_fox_prep(lds); GRID_BAR();
    fa::attn_phase<1>(lds); GRID_BAR();
    ph_gemm_wo<1>(lds); GRID_BAR();
    ph_router<1>(lds); GRID_BAR();
    ph_route<1>(); GRID_BAR();
    ph_gateup<1>(lds); GRID_BAR();
    ph_down<1>(lds); GRID_BAR();
    norm_rows<2>(lds, (float*)arg_ptr(29), nullptr, (const unsigned*)arg_ptr(30) + CW_CNT1);
}

extern "C" void kernel_launch(void* const* d_in, const int* in_sizes, int n_in, void* d_out, int out_size, void* d_ws, size_t ws_size, hipStream_t stream) {
    static int grid = 0;
    if (grid == 0) {
        if (n_in != 29 || out_size != T * DM || ws_size < WS_END) { fprintf(stderr, "kernel_launch: unexpected shapes (n_in %d out %d ws %zu, need %zu)\n", n_in, out_size, ws_size, (size_t)WS_END); grid = -1; return; }
        int dev = 0, cus = 0;
        if (hipGetDevice(&dev) != hipSuccess || hipDeviceGetAttribute(&cus, hipDeviceAttributeMultiprocessorCount, dev) != hipSuccess || cus <= 0) cus = 256;
        if (hipFuncSetAttribute((const void*)fwd, hipFuncAttributeMaxDynamicSharedMemorySize, LDS_BYTES) != hipSuccess) fprintf(stderr, "kernel_launch: hipFuncSetAttribute failed\n");
        grid = cus & ~7;
        if (grid < 8) grid = 8;
    }
    if (grid < 0) return;
    (void)in_sizes;
    (void)hipMemsetAsync((char*)d_ws + WS_CTL, 0, CTL_BYTES, stream);
    Args a{};
    for (int i = 0; i < 29; ++i) a.in[i] = d_in[i];
    a.out = (float*)d_out; a.ws = (unsigned char*)d_ws;
    hipLaunchKernelGGL(fwd, dim3(grid), dim3(NTHREADS), LDS_BYTES, stream, a);
}
```

```cpp
#include <hip/hip_runtime.h>
#include <cstdio>
#include <cstdint>
#ifndef CV_MODE
#define CV_MODE 0
#endif

#define LAS __attribute__((address_space(3)))
typedef unsigned short bf16;
typedef short bf16x8 __attribute__((ext_vector_type(8)));
typedef float f32x4 __attribute__((ext_vector_type(4)));
typedef unsigned u32x4 __attribute__((ext_vector_type(4)));
typedef unsigned u32x2 __attribute__((ext_vector_type(2)));

constexpr int T = 16384, DM = 2048, NB = 4, SEQ = 4096, NH = 16;
constexpr int NEXP = 64, DEXP = 512;
constexpr float EPS = 1e-6f;
constexpr int NTHREADS = 512, NWAVES = 8;

constexpr size_t MiB = 1u << 20;
constexpr size_t WS_CTL = 0, CTL_BYTES = 1 * MiB;
constexpr size_t WS_W_IN0T = 1 * MiB;
constexpr size_t WS_W_UQT = WS_W_IN0T + 5 * MiB;
constexpr size_t WS_W_UKVT = WS_W_UQT + 3 * MiB;
constexpr size_t WS_W_O0T = WS_W_UKVT + 4 * MiB;
constexpr size_t WS_W_IN1T = WS_W_O0T + 8 * MiB;
constexpr size_t WS_W_O1T = WS_W_IN1T + 33 * MiB;
constexpr size_t WS_W_GUT = WS_W_O1T + 8 * MiB;
constexpr size_t WS_W_DT = WS_W_GUT + 256 * MiB;
constexpr size_t WS_HN = WS_W_DT + 128 * MiB;
constexpr size_t WS_Z = WS_HN + 64 * MiB;
constexpr size_t WS_CQN = WS_Z + 256 * MiB;
constexpr size_t WS_CKVN = WS_CQN + 16 * MiB;
constexpr size_t WS_KR = WS_CKVN + 16 * MiB;
constexpr size_t WS_Q = WS_KR + 2 * MiB;
constexpr size_t WS_K = WS_Q + 96 * MiB;
constexpr size_t WS_V = WS_K + 96 * MiB;
constexpr size_t WS_O = WS_V + 64 * MiB;
constexpr size_t WS_H1 = WS_O + 64 * MiB;
constexpr size_t WS_RL = WS_H1 + 128 * MiB;
constexpr size_t WS_SSQ = WS_RL, WS_RSL = WS_RL + 2 * MiB;
constexpr size_t WS_TOK = WS_RL + 8 * MiB;
constexpr size_t WS_GATE = WS_TOK + 4 * MiB;
constexpr size_t WS_TSLOT = WS_GATE + 4 * MiB;
constexpr size_t WS_ACT = WS_TSLOT + 1 * MiB;
constexpr size_t WS_YS = WS_ACT + 48 * MiB;
constexpr size_t WS_FLOG = WS_YS + 192 * MiB;
constexpr size_t WS_C = WS_FLOG + 1 * MiB;
constexpr size_t WS_QL = WS_C + 1 * MiB;
constexpr size_t WS_KVL = WS_QL + 96 * MiB;
constexpr size_t WS_SK = WS_KVL + 128 * MiB;
constexpr size_t WS_PK = WS_SK + 4 * MiB;
constexpr size_t WS_PF = WS_PK + 16 * MiB;
constexpr size_t WS_PR = WS_PF + 4 * MiB;
constexpr size_t WS_END = WS_PR + 20 * MiB;
constexpr int CW_CNT0 = 1024, CW_CNT1 = 2048;
constexpr int CW_BAR = 4096;
constexpr int LDS_BARW = 155 * 1024, LDS_TS = LDS_BARW + 64, LDS_CN = LDS_BARW + 64 + 272, LDS_TE = LDS_BARW + 64 + 272 + 256, LDS_XS = LDS_BARW + 64 + 272 + 256 + 192, LDS_BYTES = 156 * 1024;

__device__ __forceinline__ float bf2f(unsigned b) { return __uint_as_float(b << 16); }
__device__ __forceinline__ unsigned f2bf(float f) { unsigned u = __float_as_uint(f); return (u + 0x7fffu + ((u >> 16) & 1u)) >> 16; }
__device__ __forceinline__ unsigned pk2(float lo, float hi) { unsigned r; asm("v_cvt_pk_bf16_f32 %0, %1, %2" : "=v"(r) : "v"(lo), "v"(hi)); return r; }
__device__ __forceinline__ float wave_sum(float v) {
#pragma unroll
    for (int o = 1; o < 64; o <<= 1) v += __shfl_xor(v, o);
    return v;
}
__device__ __forceinline__ float wave_max(float v) {
#pragma unroll
    for (int o = 1; o < 64; o <<= 1) v = fmaxf(v, __shfl_xor(v, o));
    return v;
}
__device__ __forceinline__ int otid() { int t = threadIdx.x; asm volatile("" : "+v"(t)); return t; }
__device__ __forceinline__ int obid() { int t = blockIdx.x; asm volatile("" : "+s"(t)); return t; }
__device__ __forceinline__ int ogrid() { int t = gridDim.x; asm volatile("" : "+s"(t)); return t; }
__device__ __forceinline__ float rsq(float x) { return 1.0f / sqrtf(x); }
__device__ __forceinline__ float rope64(float xn, int lane, float pos) {
    const float partner = __shfl_xor(xn, 32);
    const int i = lane & 31;
    const float freq = exp2f(-(float)i * (13.287712379549449f / 32.0f));
    const float ang = pos * freq;
    float rev = ang * 0.15915494309189535f; rev -= floorf(rev);
    const float s = __builtin_amdgcn_sinf(rev), c = __builtin_amdgcn_cosf(rev);
    return lane < 32 ? xn * c - partner * s : xn * c + partner * s;
}

enum { B_N_F32 = 0, B_N_BF16 = 1, B_T_BF16 = 2 };
template <int BMODE, class AP, class BP, class EP>
__device__ __forceinline__ void sg_tile(LAS unsigned char* lds, const AP& ap, const BP& bp, const EP& ep, int kbeg, int kend) {
    const int tid = otid(), wave = tid >> 6, lane = tid & 63, fr = lane & 15, fq = lane >> 4, wm = wave >> 2, wn = wave & 3;
    LAS bf16* sA = (LAS bf16*)lds; LAS bf16* sB = sA + 128 * 40;
    const bf16* pa = ap.row(tid >> 2) + (tid & 3) * 8;
    const int chunk = tid & 15, kk = tid >> 4;
    const bf16* pbt = nullptr; const float* pbf = nullptr; const bf16* pbh = nullptr; int ldb = 0;
    if constexpr (BMODE == B_T_BF16) { pbt = bp.row(tid >> 2); if (pbt) pbt += (tid & 3) * 8; }
    else if constexpr (BMODE == B_N_F32) { pbf = bp.col8(chunk, ldb); }
    else { pbh = bp.col8(chunk, ldb); }
    f32x4 acc[4][2];
#pragma unroll
    for (int mi = 0; mi < 4; ++mi)
#pragma unroll
        for (int ni = 0; ni < 2; ++ni) acc[mi][ni] = (f32x4){0.f, 0.f, 0.f, 0.f};
    for (int k0 = kbeg; k0 < kend; k0 += 32) {
        const u32x4 ra = *(const u32x4*)(pa + k0);
        u32x4 rb = (u32x4){0u, 0u, 0u, 0u};
        if constexpr (BMODE == B_T_BF16) { if (pbt) rb = *(const u32x4*)(pbt + k0); }
        else if constexpr (BMODE == B_N_F32) {
            if (pbf) { const float* p = pbf + (size_t)(k0 + kk) * ldb; const f32x4 x = *(const f32x4*)p, y = *(const f32x4*)(p + 4);
                rb = (u32x4){pk2(x[0], x[1]), pk2(x[2], x[3]), pk2(y[0], y[1]), pk2(y[2], y[3])}; }
        } else { if (pbh) rb = *(const u32x4*)(pbh + (size_t)(k0 + kk) * ldb); }
        __syncthreads();
        *(LAS u32x4*)(sA + (tid >> 2) * 40 + (tid & 3) * 8) = ra;
        if constexpr (BMODE == B_T_BF16) { *(LAS u32x4*)(sB + (tid >> 2) * 40 + (tid & 3) * 8) = rb; }
        else {
#pragma unroll
            for (int j = 0; j < 8; ++j) sB[(chunk * 8 + j) * 40 + kk] = (bf16)((rb[j >> 1] >> ((j & 1) * 16)) & 0xffffu);
        }
        __syncthreads();
        bf16x8 a[4], b[2];
#pragma unroll
        for (int mi = 0; mi < 4; ++mi) a[mi] = *(const LAS bf16x8*)(sA + (wm * 64 + mi * 16 + fr) * 40 + fq * 8);
#pragma unroll
        for (int ni = 0; ni < 2; ++ni) b[ni] = *(const LAS bf16x8*)(sB + (wn * 32 + ni * 16 + fr) * 40 + fq * 8);
#pragma unroll
        for (int mi = 0; mi < 4; ++mi)
#pragma unroll
            for (int ni = 0; ni < 2; ++ni) acc[mi][ni] = __builtin_amdgcn_mfma_f32_16x16x32_bf16(b[ni], a[mi], acc[mi][ni], 0, 0, 0);
    }
#pragma unroll
    for (int mi = 0; mi < 4; ++mi) ep(wm * 64 + mi * 16 + fr, wn * 32 + 4 * fq, acc[mi][0], acc[mi][1]);
}

struct APlain { const bf16* A; size_t lda; __device__ __forceinline__ const bf16* row(int r) const { return A + (size_t)r * lda; } };
struct BPlainF32 { const float* B; int ldb_, ncols; int n0;
    __device__ __forceinline__ const float* col8(int chunk, int& ldb) const { ldb = ldb_; const int c = n0 + chunk * 8; return c < ncols ? B + c : nullptr; } };
struct BPlainBf16 { const bf16* B; int ldb_;
    __device__ __forceinline__ const bf16* col8(int chunk, int& ldb) const { ldb = ldb_; return B + chunk * 8; } };
struct BRowsT { const bf16* Bt; size_t ld; __device__ __forceinline__ const bf16* row(int r) const { return Bt + (size_t)r * ld; } };

__device__ __forceinline__ void store4bf(bf16* p, f32x4 v) { *(u32x2*)p = (u32x2){pk2(v[0], v[1]), pk2(v[2], v[3])}; }
__device__ __forceinline__ void store8bf(bf16* p, f32x4 a, f32x4 b) { *(u32x4*)p = (u32x4){pk2(a[0], a[1]), pk2(a[2], a[3]), pk2(b[0], b[1]), pk2(b[2], b[3])}; }

struct EpBf16 { bf16* C; size_t ldc; int n0, N;
    __device__ __forceinline__ void operator()(int rl, int cl, f32x4 v0, f32x4 v1) const {
        bf16* p = C + (size_t)rl * ldc; const int c = n0 + cl;
        if (c < N) store4bf(p + c, v0);
        if (c + 16 < N) store4bf(p + c + 16, v1); } };
struct EpResF32 { const float* R; float* C; int n0;
    __device__ __forceinline__ void operator()(int rl, int cl, f32x4 v0, f32x4 v1) const {
        const size_t o = (size_t)rl * DM + n0 + cl;
        *(f32x4*)(C + o) = *(const f32x4*)(R + o) + v0; *(f32x4*)(C + o + 16) = *(const f32x4*)(R + o + 16) + v1; } };


#define XB_TMO      128
#define XB_XCNT(j)  (256  + 64 * (j))
#define XB_XSUB(j)  (1280 + 64 * (j))
#define XB_XGEN(j)  (2304 + 64 * (j))
#define XB_TOP      3328
#define XB_TOPGEN   3392
#define XCD_BAR_WORDS 3456
#define XB_SPIN_CAP (1u << 18)

__device__ __forceinline__ unsigned xb_ld(unsigned* p)              { return __hip_atomic_load(p, __ATOMIC_RELAXED, __HIP_MEMORY_SCOPE_AGENT); }
__device__ __forceinline__ unsigned xb_add(unsigned* p, unsigned v) { return __hip_atomic_fetch_add(p, v, __ATOMIC_RELAXED, __HIP_MEMORY_SCOPE_AGENT); }
__device__ __forceinline__ unsigned xb_xcc_id() { return (unsigned)__builtin_amdgcn_s_getreg((3 << 11) | 20) & 0xFu; }
#define XB_SPIN(cond, bar) do { unsigned _sp = 0; while (cond) { __builtin_amdgcn_s_sleep(1); \
    if ((++_sp & 255u) == 0u) { if (xb_ld(&(bar)[XB_TMO])) break; if (_sp > XB_SPIN_CAP) { atomicAdd(&(bar)[XB_TMO], 1u); break; } } } } while (0)

struct XcdBarrier {
    unsigned* bar; unsigned x;
    volatile LAS unsigned* st;
};

__device__ __forceinline__ XcdBarrier xcd_barrier_post(unsigned* bar, volatile LAS unsigned* st) {
    XcdBarrier b; b.bar = bar; b.x = xb_xcc_id(); b.st = st;
    if (threadIdx.x == 0) (void)xb_add(&bar[XB_XCNT(b.x)], 1u);
    return b;
}
__device__ __forceinline__ void xcd_barrier_complete(unsigned* bar, unsigned x, unsigned& nloc, unsigned& nx) {
    const unsigned G = gridDim.x * gridDim.y * gridDim.z;
    unsigned sum, cnt, mine, sp = 0u;
    for (;;) {
        sum = 0u; cnt = 0u; mine = 0u;
#pragma unroll
        for (unsigned j = 0; j < 16; ++j) { const unsigned c = xb_ld(&bar[XB_XCNT(j)]); sum += c; cnt += (c > 0u) ? 1u : 0u; mine = (j == x) ? c : mine; }
        if (sum == G) break;
        __builtin_amdgcn_s_sleep(1);
        if ((++sp & 255u) == 0u) { if (xb_ld(&bar[XB_TMO])) break; if (sp > XB_SPIN_CAP) { atomicAdd(&bar[XB_TMO], 1u); break; } }
    }
    nloc = mine > 0u ? mine : 1u; nx = cnt > 0u ? cnt : 1u;
}

__device__ __forceinline__ void xcd_barrier(const XcdBarrier& b) {
    asm volatile("s_waitcnt vmcnt(0)" ::: "memory");
    __syncthreads();
    if (threadIdx.x == 0) {
        unsigned* bar = b.bar;
        __builtin_amdgcn_s_waitcnt(0);
        unsigned nloc = b.st[0], nx = b.st[1];
        if (nloc == 0u) { xcd_barrier_complete(bar, b.x, nloc, nx); b.st[0] = nloc; b.st[1] = nx; }
        const unsigned old = xb_add(&bar[XB_XSUB(b.x)], 1u);
        const unsigned gen = old / nloc;
        if (old + 1u == (gen + 1u) * nloc) {
            __builtin_amdgcn_fence(__ATOMIC_RELEASE, "agent");
            asm volatile("s_waitcnt vmcnt(0)" ::: "memory");
            const unsigned og = xb_add(&bar[XB_TOP], 1u);
            const unsigned tg = og / nx;
            if (og + 1u == (tg + 1u) * nx) xb_add(&bar[XB_TOPGEN], 1u);
            else XB_SPIN(xb_ld(&bar[XB_TOPGEN]) == tg, bar);
            __builtin_amdgcn_fence(__ATOMIC_ACQUIRE, "agent");
            xb_add(&bar[XB_XGEN(b.x)], 1u);
            asm volatile("s_waitcnt vmcnt(0)" ::: "memory");
        } else {
            XB_SPIN(xb_ld(&bar[XB_XGEN(b.x)]) == gen, bar);
            __builtin_amdgcn_fence(__ATOMIC_ACQUIRE, "agent");
            asm volatile("s_waitcnt vmcnt(0)" ::: "memory");
        }
    }
    __syncthreads();
}

namespace fg {
constexpr int BM = 256, BK = 64, HALF = 128, HTB = HALF * BK * 2, STAGE_BYTES = 8 * HTB;
__host__ __device__ __forceinline__ int lds_byte(int r, int c) { const int st = (r >> 4) * 2 + (c >> 5), rr = r & 15, cc = c & 31, ob = rr * 64 + cc * 2; return st * 1024 + (ob ^ (((ob >> 9) & 1) << 5)); }
__host__ __device__ __forceinline__ void stage_rc(int b, int& R, int& C) { const int st = b / 1024, sb = b % 1024, swz = sb ^ (((sb >> 9) & 1) << 5); R = (st >> 1) * 16 + swz / 64; C = (st & 1) * 32 + (swz % 64) / 2; }

template <bool GATHER, class Unit, class Epi, class Sched>
__device__ __forceinline__ void gemm_phase(LAS unsigned char* lds, const int K, const Sched& S, const Epi& E) {
    const int tid = otid(), wid = __builtin_amdgcn_readfirstlane(tid >> 6), lane = tid & 63, wr = wid >> 2, wc = wid & 3, fr = lane & 15, fq = lane >> 4;
    const int nt = K / BK;
    int R0, C0, R1, C1; stage_rc(tid * 16, R0, C0); stage_rc(tid * 16 + 8192, R1, C1);
    const int Rb0 = (R0 & ~31) + 8 * ((R0 & 15) >> 2) + 4 * ((R0 >> 4) & 1) + (R0 & 3), Rb1 = (R1 & ~31) + 8 * ((R1 & 15) >> 2) + 4 * ((R1 >> 4) & 1) + (R1 & 3);
    const unsigned voffB0 = (unsigned)(Rb0 * K + C0) * 2u, voffB1 = (unsigned)(Rb1 * K + C1) * 2u;
    const size_t kstep = (size_t)(BK * 2);
    const size_t hstepB = (size_t)HALF * K * 2;
    const unsigned ldsw = (unsigned)wid * 1024u;
    const int aoff = lds_byte(wr * 64 + fr, fq * 8), boff = lds_byte(wc * 32 + fr, fq * 8);
#define FG_SA(b, h) (((b) * 2 + (h)) * HTB)
#define FG_SB(b, h) ((4 + (b) * 2 + (h)) * HTB)
#define FG_STAGE(bufoff, gbase, v0, v1) do { \
        __builtin_amdgcn_global_load_lds((const unsigned*)((const char*)(gbase) + (v0)), (LAS unsigned*)(lds + (bufoff) + ldsw), 16, 0, 0); \
        __builtin_amdgcn_global_load_lds((const unsigned*)((const char*)(gbase) + (v1)), (LAS unsigned*)(lds + (bufoff) + ldsw + 8192), 16, 0, 0); } while (0)
#define FG_LDA(dst, b, h) do { _Pragma("unroll") for (int m = 0; m < 4; ++m) _Pragma("unroll") for (int k = 0; k < 2; ++k) dst[m][k] = *(const LAS bf16x8*)(lds + FG_SA(b, h) + aoff + m * 2048 + k * 1024); } while (0)
#define FG_LDB(dst, b, h) do { _Pragma("unroll") for (int n = 0; n < 2; ++n) _Pragma("unroll") for (int k = 0; k < 2; ++k) dst[n][k] = *(const LAS bf16x8*)(lds + FG_SB(b, h) + boff + n * 2048 + k * 1024); } while (0)
#define FG_MMA(ai, bj, At, Bt) do { __builtin_amdgcn_s_setprio(1); _Pragma("unroll") for (int m = 0; m < 4; ++m) _Pragma("unroll") for (int n = 0; n < 2; ++n) _Pragma("unroll") for (int k = 0; k < 2; ++k) \
        acc[ai][bj][m][n] = __builtin_amdgcn_mfma_f32_16x16x32_bf16(Bt[n][k], At[m][k], acc[ai][bj][m][n], 0, 0, 0); __builtin_amdgcn_s_setprio(0); } while (0)
#define FG_WAIT_V(n) asm volatile("s_waitcnt vmcnt(" #n ")" ::: "memory")
#define FG_WAIT_L(n) asm volatile("s_waitcnt lgkmcnt(" #n ")" ::: "memory")
#define FG_BAR __builtin_amdgcn_s_barrier()
#define FG_SCHED __builtin_amdgcn_sched_barrier(0)
    Unit cur, nxt; int ui = 0;
    if (!S.next(0, cur)) return;
    f32x4 acc[2][2][4][2];
#pragma unroll
    for (int a = 0; a < 2; ++a)
#pragma unroll
        for (int b = 0; b < 2; ++b)
#pragma unroll
            for (int m = 0; m < 4; ++m)
#pragma unroll
                for (int n = 0; n < 2; ++n) acc[a][b][m][n] = (f32x4){0.f, 0.f, 0.f, 0.f};
    bf16x8 At[4][2], B0[2][2], B1[2][2];
    const char* cA = S.a_base(cur); const char* cB = S.b_base(cur);
    unsigned vA00 = S.a_voff(cur, R0, C0), vA01 = S.a_voff(cur, R1, C1), vA10 = S.a_voff(cur, HALF + R0, C0), vA11 = S.a_voff(cur, HALF + R1, C1);
    unsigned vN00 = vA00, vN01 = vA01, vN10 = vA10, vN11 = vA11;
    bool hi_on = !S.lo_only(cur);
    FG_STAGE(FG_SB(0, 0), cB, voffB0, voffB1); FG_STAGE(FG_SB(0, 1), cB + hstepB, voffB0, voffB1); FG_STAGE(FG_SA(0, 0), cA, vA00, vA01); FG_STAGE(FG_SA(0, 1), cA, vA10, vA11);
    if (wr == 1) FG_BAR;
    FG_WAIT_V(2); FG_BAR;
    FG_STAGE(FG_SB(1, 0), cB + kstep, voffB0, voffB1); FG_STAGE(FG_SA(1, 0), cA + kstep, vA00, vA01); FG_STAGE(FG_SB(1, 1), cB + hstepB + kstep, voffB0, voffB1);
    FG_WAIT_V(6); FG_BAR;
    for (;;) {
        const bool has_next = S.next(ui + 1, nxt);
        const char* nA = has_next ? S.a_base(nxt) : cA; const char* nB = has_next ? S.b_base(nxt) : cB;
        if (GATHER) { if (has_next) { vN00 = S.a_voff(nxt, R0, C0); vN01 = S.a_voff(nxt, R1, C1); vN10 = S.a_voff(nxt, HALF + R0, C0); vN11 = S.a_voff(nxt, HALF + R1, C1); }
                      else { vN00 = vA00; vN01 = vA01; vN10 = vA10; vN11 = vA11; } }
        for (int t = 0; t < nt; t += 2) {
            const bool last = (t == nt - 2);
            const char* a1 = cA + (size_t)(t + 1) * kstep;
            const char* a2 = last ? nA : cA + (size_t)(t + 2) * kstep; const char* b2 = last ? nB : cB + (size_t)(t + 2) * kstep;
            const char* a3 = a2 + kstep; const char* b3 = b2 + kstep;
            const unsigned x00 = (GATHER && last) ? vN00 : vA00, x01 = (GATHER && last) ? vN01 : vA01, x10 = (GATHER && last) ? vN10 : vA10, x11 = (GATHER && last) ? vN11 : vA11;
            FG_LDB(B0, 0, 0); FG_LDB(B1, 0, 1); FG_SCHED; FG_LDA(At, 0, 0); FG_STAGE(FG_SA(1, 1), a1, vA10, vA11);
            FG_WAIT_V(8); FG_WAIT_L(0); FG_BAR; FG_MMA(0, 0, At, B0); FG_MMA(0, 1, At, B1); FG_BAR; FG_SCHED;
            FG_LDA(At, 0, 1); FG_STAGE(FG_SB(0, 0), b2, voffB0, voffB1); FG_STAGE(FG_SB(0, 1), b2 + hstepB, voffB0, voffB1); FG_STAGE(FG_SA(0, 0), a2, x00, x01);
            FG_WAIT_V(8); FG_WAIT_L(0); FG_BAR; if (hi_on) { FG_MMA(1, 0, At, B0); FG_MMA(1, 1, At, B1); } FG_BAR; FG_SCHED;
            FG_LDB(B0, 1, 0); FG_LDB(B1, 1, 1); FG_SCHED; FG_LDA(At, 1, 0); FG_STAGE(FG_SA(0, 1), a2, x10, x11);
            FG_WAIT_V(8); FG_WAIT_L(0); FG_BAR; FG_MMA(0, 0, At, B0); FG_MMA(0, 1, At, B1); FG_BAR; FG_SCHED;
            FG_LDA(At, 1, 1); FG_STAGE(FG_SB(1, 0), b3, voffB0, voffB1); FG_STAGE(FG_SB(1, 1), b3 + hstepB, voffB0, voffB1); FG_STAGE(FG_SA(1, 0), a3, x00, x01);
            FG_WAIT_V(8); FG_WAIT_L(0); FG_BAR; if (hi_on) { FG_MMA(1, 0, At, B0); FG_MMA(1, 1, At, B1); } FG_BAR; FG_SCHED;
        }
        if (wr == 0) FG_BAR;
        { int tz = threadIdx.x; asm volatile("" : "+v"(tz));
          const int lz = tz & 63; E(acc, cur, (tz >> 6) >> 2, (tz >> 6) & 3, lz & 15, lz >> 4); }
        if (!has_next) break;
#pragma unroll
        for (int a = 0; a < 2; ++a)
#pragma unroll
            for (int b = 0; b < 2; ++b)
#pragma unroll
                for (int m = 0; m < 4; ++m)
#pragma unroll
                    for (int n = 0; n < 2; ++n) acc[a][b][m][n] = (f32x4){0.f, 0.f, 0.f, 0.f};
        cur = nxt; cA = nA; cB = nB; ++ui; hi_on = !S.lo_only(cur);
        if (GATHER) { vA00 = vN00; vA01 = vN01; vA10 = vN10; vA11 = vN11; }
        if (wr == 1) FG_BAR;
    }
    FG_WAIT_V(0);
    FG_BAR;
#undef FG_SA
#undef FG_SB
#undef FG_STAGE
#undef FG_LDA
#undef FG_LDB
#undef FG_MMA
#undef FG_WAIT_V
#undef FG_WAIT_L
#undef FG_BAR
#undef FG_SCHED
}

struct DUnit { int p, pm, pn, par; };
struct DenseSched {
    const bf16* A0; const bf16* B0; int nN0; const bf16* A1; const bf16* B1; int nN1; int K, G, c;
    static constexpr int nM = T / 256, NXCD = 8, WGM = 8;
    __device__ __forceinline__ bool next(int i, DUnit& u) const {
        long L = (long)i * G + c; const int nwg0 = nM * nN0, nwg1 = nM * nN1;
        int nN, nwg; if (L < nwg0) { u.p = 0; nN = nN0; nwg = nwg0; } else { L -= nwg0; if (L >= nwg1) return false; u.p = 1; nN = nN1; nwg = nwg1; }
        int wgid = (int)L; { const int q = nwg / NXCD, r = nwg % NXCD, xcd = wgid % NXCD, off = wgid / NXCD; wgid = (xcd < r ? xcd * (q + 1) : r * (q + 1) + (xcd - r) * q) + off; }
        const int nig = WGM * nN, gid = wgid / nig, fm = gid * WGM, gsz = (nM - fm) < WGM ? (nM - fm) : WGM;
        u.pm = fm + ((wgid % nig) % gsz); u.pn = (wgid % nig) / gsz; u.par = i & 1; return true;
    }
    __device__ __forceinline__ const char* a_base(const DUnit& u) const { return (const char*)(u.p ? A1 : A0) + (size_t)u.pm * 256 * K * 2; }
    __device__ __forceinline__ const char* b_base(const DUnit& u) const { return (const char*)(u.p ? B1 : B0) + (size_t)u.pn * 256 * K * 2; }
    __device__ __forceinline__ unsigned a_voff(const DUnit&, int row, int col) const { return (unsigned)(row * K + col) * 2u; }
    __device__ __forceinline__ bool lo_only(const DUnit&) const { return false; }
};
struct SkUnit { int pm, ks; };
struct SkinnySched {
    const char* A; const char* B; int G, c;
    __device__ __forceinline__ bool next(int i, SkUnit& u) const { const int L = i * G + c; if (L >= (T / 256) * 4) return false; u.pm = L >> 2; u.ks = L & 3; return true; }
    __device__ __forceinline__ const char* a_base(const SkUnit& u) const { return A + ((size_t)u.pm * 256 * DM + u.ks * 512) * 2; }
    __device__ __forceinline__ const char* b_base(const SkUnit& u) const { return B + (size_t)u.ks * 256 * 512 * 2; }
    __device__ __forceinline__ unsigned a_voff(const SkUnit&, int row, int col) const { return (unsigned)(row * DM + col) * 2u; }
    __device__ __forceinline__ bool lo_only(const SkUnit&) const { return false; }
};
#define FG_FOREACH(acc, BODY) do { _Pragma("unroll") for (int ai = 0; ai < 2; ++ai) _Pragma("unroll") for (int m = 0; m < 4; ++m) { const int row = ai * 128 + wr * 64 + m * 16 + fr; \
        _Pragma("unroll") for (int bj = 0; bj < 2; ++bj) { const int col = bj * 128 + wc * 32 + 8 * fq; const f32x4 v0 = acc[ai][bj][m][0], v1 = acc[ai][bj][m][1]; BODY } } } while (0)
}

template <class RowMap>
__device__ __forceinline__ void transpose_item(const float* W, int K, int N, bf16* WT, const RowMap& rowmap, LAS float* scr, int item, int lane) {
    const int nblk = (N + 31) / 32, kb = item / nblk, nb = item % nblk, k0 = 64 * kb, n0 = 32 * nb; const bool cv = n0 + (lane & 31) < N;
#pragma unroll 8
    for (int i = 0; i < 32; ++i) { const int kk = 2 * i + (lane >> 5); scr[kk * 33 + (lane & 31)] = cv ? W[(size_t)(k0 + kk) * N + n0 + (lane & 31)] : 0.f; }
    asm volatile("s_waitcnt lgkmcnt(0)" ::: "memory");
    const int c = lane & 7;
#pragma unroll
    for (int j = 0; j < 4; ++j) { const int n = (lane >> 3) + 8 * j; const LAS float* sp = scr + (8 * c) * 33 + n;
        u32x4 o; o.x = pk2(sp[0 * 33], sp[1 * 33]); o.y = pk2(sp[2 * 33], sp[3 * 33]); o.z = pk2(sp[4 * 33], sp[5 * 33]); o.w = pk2(sp[6 * 33], sp[7 * 33]);
        const int dr = rowmap(n0 + n);
        if (dr >= 0) *(u32x4*)(WT + (size_t)dr * K + k0 + 8 * c) = o; }
    asm volatile("s_waitcnt lgkmcnt(0)" ::: "memory");
}
template <class RowMap>
__device__ __forceinline__ void transpose_item16(const float* W, int K, int N, bf16* WT, const RowMap& rowmap, LAS unsigned char* scr, int item, int lane) {
    const int nblk = (N + 31) / 32, kb = item / nblk, nb = item % nblk, k0 = 64 * kb, n0 = 32 * nb, c = lane & 7, rr = lane >> 3; const bool cv = n0 + 4 * c < N;
    f32x4 v[8];
#pragma unroll
    for (int i = 0; i < 8; ++i) v[i] = cv ? __builtin_nontemporal_load((const f32x4*)(W + (size_t)(k0 + 8 * i + rr) * N + n0 + 4 * c)) : (f32x4){0.f, 0.f, 0.f, 0.f};
#pragma unroll
    for (int i = 0; i < 8; ++i) *(LAS f32x4*)(scr + (8 * i + rr) * 128 + ((c ^ i) << 4)) = v[i];
    asm volatile("s_waitcnt lgkmcnt(0)" ::: "memory");
    float t[4][8];
#pragma unroll
    for (int j = 0; j < 4; ++j) { const int n = rr + 8 * j; const LAS float* sp = (const LAS float*)scr + (8 * c) * 32 + (((n >> 2) ^ c) << 2) + (n & 3);
#pragma unroll
        for (int q = 0; q < 8; ++q) t[j][q] = sp[32 * q]; }
    asm volatile("s_waitcnt lgkmcnt(0)" ::: "memory");
#pragma unroll
    for (int j = 0; j < 4; ++j) { const int n = rr + 8 * j, dr = rowmap(n0 + n);
        if (dr >= 0) *(u32x4*)(WT + (size_t)dr * K + k0 + 8 * c) = (u32x4){pk2(t[j][0], t[j][1]), pk2(t[j][2], t[j][3]), pk2(t[j][4], t[j][5]), pk2(t[j][6], t[j][7])}; }
}
__device__ __forceinline__ void zero_rows(bf16* WT, int K, int r0, int r1, int gw, int ngw, int lane) {
    const size_t n8 = (size_t)(r1 - r0) * K / 8; u32x4* p = (u32x4*)(WT + (size_t)r0 * K);
    for (size_t i = (size_t)gw * 64 + lane; i < n8; i += (size_t)ngw * 64) p[i] = (u32x4){0u, 0u, 0u, 0u};
}

struct Args { const void* in[29]; float* out; unsigned char* ws; };
__device__ __forceinline__ int hide(int i) { asm volatile("" : "+s"(i)); return i; }
__device__ __forceinline__ const void* arg_ptr(int i) {
    typedef const void* cvp;
    const __attribute__((address_space(4))) cvp* ka = (const __attribute__((address_space(4))) cvp*)__builtin_amdgcn_kernarg_segment_ptr();
    return ka[hide(i)];
}
#define INF(i) ((const float*)arg_ptr(i))
#define PH_BEGIN unsigned char* ws = (unsigned char*)arg_ptr(30); \
    const int tid = otid(), lane = tid & 63, wave = tid >> 6, G = ogrid(), bx = obid(), gw = bx * NWAVES + wave, ngw = G * NWAVES; (void)lane; (void)gw; (void)ngw; (void)ws
#define WSP(TYPE, OFF) ((TYPE*)(ws + (OFF)))

__device__ __forceinline__ void unpack8(u32x4 w, float (&x)[8]) {
#pragma unroll
    for (int j = 0; j < 4; ++j) { x[2 * j] = bf2f(w[j] & 0xffffu); x[2 * j + 1] = bf2f(w[j] >> 16); }
}
__device__ __forceinline__ f32x4 bf4(u32x2 w) { return (f32x4){bf2f(w[0] & 0xffffu), bf2f(w[0] >> 16), bf2f(w[1] & 0xffffu), bf2f(w[1] >> 16)}; }

__device__ __forceinline__ void moe_prefix(LAS unsigned char* lds, const unsigned* cnt) {
    LAS int* s_ts = (LAS int*)(lds + LDS_TS); LAS int* s_cn = (LAS int*)(lds + LDS_CN);
    LAS unsigned char* s_te = lds + LDS_TE;
    LAS int* s_xs = (LAS int*)(lds + LDS_XS);
    if (otid() == 0) { int acc = 0; for (int e = 0; e < NEXP; ++e) { const int c = (int)cnt[e]; s_ts[e] = acc; s_cn[e] = c; const int nt = (c + 255) >> 8; for (int i = 0; i < nt; ++i) s_te[acc + i] = (unsigned char)e; acc += nt; } s_ts[NEXP] = acc;
        const int x = obid() & 7; int a2 = 0; for (int k = 0; k < 8; ++k) { s_xs[k] = a2; a2 += (s_cn[x + 8 * k] + 255) >> 8; } s_xs[8] = a2; }
    __syncthreads();
}

__device__ __forceinline__ void ph_convert_dense(LAS unsigned char* lds) {
    PH_BEGIN;
    LAS unsigned char* scr = lds + wave * 8192;
    const float* w_in0 = INF(3); const float* w_uq = INF(6); const float* w_ukv = INF(7); const float* w_o0 = INF(9); const float* w_in1 = INF(18); const float* w_o1 = INF(21);
    bf16* W_IN0T = WSP(bf16, WS_W_IN0T); bf16* W_UQT = WSP(bf16, WS_W_UQT); bf16* W_UKVT = WSP(bf16, WS_W_UKVT); bf16* W_O0T = WSP(bf16, WS_W_O0T); bf16* W_IN1T = WSP(bf16, WS_W_IN1T); bf16* W_O1T = WSP(bf16, WS_W_O1T);
    constexpr int I0 = 32 * 34, I1 = 8 * 96, I2 = 8 * 128, I3 = 32 * 64, I4 = 32 * 257, I5 = 32 * 64;
    auto ident = [](int n) { return n; };
    auto map0 = [](int n) { return n < 1024 ? n : -1; };
    auto map1 = [](int n) { return n < 6144 ? n : (n < 6160 ? -1 : (n < 8208 ? n - 16 : -1)); };
    for (int it = gw; it < I0 + I1 + I2 + I3 + I4 + I5; it += ngw) {
        int r = it;
        if (r < I0) { transpose_item16(w_in0, DM, 1088, W_IN0T, map0, scr, r, lane); continue; } r -= I0;
        if (r < I1) { transpose_item16(w_uq, 512, 3072, W_UQT, ident, scr, r, lane); continue; } r -= I1;
        if (r < I2) { transpose_item16(w_ukv, 512, 4096, W_UKVT, ident, scr, r, lane); continue; } r -= I2;
        if (r < I3) { transpose_item16(w_o0, DM, DM, W_O0T, ident, scr, r, lane); continue; } r -= I3;
        if (r < I4) { transpose_item16(w_in1, DM, 8208, W_IN1T, map1, scr, r, lane); continue; } r -= I4;
        transpose_item16(w_o1, DM, DM, W_O1T, ident, scr, r, lane);
    }
    { bf16* SK = WSP(bf16, WS_SK); const float* w_rg0 = INF(11); const float* w_re0 = INF(13); const float* w_rg1 = INF(23); const float* w_re1 = INF(25);
      for (int idx = bx * NTHREADS + tid; idx < 4 * 256 * 256; idx += G * NTHREADS) {
          const int set = idx >> 16, n = (idx >> 8) & 255, k = (idx & 255) * 8, ks = k >> 9;
          float v[8];
#pragma unroll
          for (int i = 0; i < 8; ++i) { float x = 0.f;
              if (set == 0) { if (n < 64) x = w_in0[(size_t)(k + i) * 1088 + 1024 + n]; }
              else if (set == 1) { if (n < 16) x = w_in1[(size_t)(k + i) * 8208 + 6144 + n]; }
              else { const float* wg = set == 2 ? w_rg0 : w_rg1; const float* we = set == 2 ? w_re0 : w_re1; if (n < 8) x = wg[(k + i) * 8 + n]; else if (n < 72) x = we[(k + i) * 64 + n - 8]; }
              v[i] = x; }
          *(u32x4*)(SK + (size_t)set * (4 * 256 * 512) + ((size_t)ks * 256 + n) * 512 + (k & 511)) = (u32x4){pk2(v[0], v[1]), pk2(v[2], v[3]), pk2(v[4], v[5]), pk2(v[6], v[7])}; } }
}
template <int layer>
__device__ __forceinline__ void ph_convert_moe(LAS unsigned char* lds) {
    PH_BEGIN;
    LAS float* scr = (LAS float*)(lds + wave * 8448);
    const float* w_gu = INF(layer == 0 ? 15 : 27); const float* w_dn = INF(layer == 0 ? 16 : 28);
    bf16* W_GUT = WSP(bf16, WS_W_GUT); bf16* W_DT = WSP(bf16, WS_W_DT);
    auto gumap = [](int n) { const int which = n >> 9, f = n & 511; return (f >> 7) * 256 + ((f >> 6) & 1) * 128 + ((f >> 4) & 3) * 32 + ((f >> 2) & 3) * 8 + which * 4 + (f & 3); };
    auto ident = [](int n) { return n; };
    constexpr int IG = 32 * 32, ID = 8 * 64;
    for (int it = gw; it < NEXP * (IG + ID); it += ngw) {
        if (it < NEXP * IG) { const int e = it / IG, r = it % IG; transpose_item(w_gu + (size_t)e * DM * 1024, DM, 1024, W_GUT + (size_t)e * 1024 * DM, gumap, scr, r, lane); }
        else { const int v = it - NEXP * IG, e = v / ID, r = v % ID; transpose_item(w_dn + (size_t)e * DEXP * DM, DEXP, DM, W_DT + (size_t)e * DM * DEXP, ident, scr, r, lane); }
    }
}

template <int MODE>
__device__ __forceinline__ void norm_rows(LAS unsigned char* lds, float* in, const float* gain, const unsigned* cnt) {
    PH_BEGIN;
    bf16* HN = WSP(bf16, WS_HN); const bf16* YS = WSP(bf16, WS_YS); const int* TSLOT = WSP(int, WS_TSLOT); bf16* H1b = WSP(bf16, WS_H1);
    if (MODE != 0) moe_prefix(lds, cnt);
    const LAS int* s_ts = (const LAS int*)(lds + LDS_TS);
    for (int m = gw; m < T; m += ngw) {
        f32x4* xr = (f32x4*)(in + (size_t)m * DM) + lane; bf16* hb = H1b + (size_t)m * DM + 4 * lane;
        f32x4 v[8]; float ss = 0.f;
        const bf16* y0 = nullptr; const bf16* y1 = nullptr;
        if (MODE != 0) { const int s0 = TSLOT[2 * m], s1 = TSLOT[2 * m + 1];
            y0 = YS + ((size_t)s_ts[s0 >> 16] * 256 + (s0 & 0xffff)) * DM + 4 * lane; y1 = YS + ((size_t)s_ts[s1 >> 16] * 256 + (s1 & 0xffff)) * DM + 4 * lane; }
#pragma unroll
        for (int j = 0; j < 8; ++j) {
            if (MODE == 0) v[j] = xr[64 * j];
            else { v[j] = bf4(*(const u32x2*)(hb + 256 * j)) + bf4(*(const u32x2*)(y0 + 256 * j)) + bf4(*(const u32x2*)(y1 + 256 * j));
                if (MODE == 1) store4bf(hb + 256 * j, v[j]); else xr[64 * j] = v[j]; }
            ss += (v[j][0] * v[j][0] + v[j][1] * v[j][1]) + (v[j][2] * v[j][2] + v[j][3] * v[j][3]); }
        if (MODE != 2) {
            ss = wave_sum(ss);
            const float r = rsq(ss * (1.0f / DM) + EPS);
#pragma unroll
            for (int j = 0; j < 8; ++j) { const f32x4 g = ((const f32x4*)gain)[lane + 64 * j];
                store4bf(HN + (size_t)m * DM + 4 * lane + 256 * j, (f32x4){v[j][0] * r * g[0], v[j][1] * r * g[1], v[j][2] * r * g[2], v[j][3] * r * g[3]}); }
        }
    }
}

template <int NC>
__device__ __forceinline__ void skinny_gemm(LAS unsigned char* lds, const bf16* HN, const bf16* SKset, float* P, int G, int bx) {
    fg::SkinnySched S{(const char*)HN, (const char*)SKset, G, bx};
    auto E = [=](const f32x4 (&acc)[2][2][4][2], const fg::SkUnit& u, int wr, int wc, int fr, int fq) {
        float* Pt = P + ((size_t)u.ks * T + (size_t)u.pm * 256) * NC;
        FG_FOREACH(acc, { if (col < NC) { *(f32x4*)(Pt + (size_t)row * NC + col) = v0; *(f32x4*)(Pt + (size_t)row * NC + col + 4) = v1; } }); };
    fg::gemm_phase<false, fg::SkUnit>(lds, 512, S, E);
}
constexpr int LDS_EPI_TAB = 131072;
template <int HMASK>
__device__ __forceinline__ void epi_head_rstd(LAS unsigned char* lds, const f32x4 (&acc)[2][2][4][2], int par, int wr, int wc, int fr, int fq, float (&rstd)[2][4][2]) {
    LAS float* tab = (LAS float*)(lds + LDS_EPI_TAB) + par * 2048;
#pragma unroll
    for (int ai = 0; ai < 2; ++ai)
#pragma unroll
        for (int m = 0; m < 4; ++m) { const int row = ai * 128 + wr * 64 + m * 16 + fr;
#pragma unroll
            for (int bj = 0; bj < 2; ++bj) if (HMASK & (1 << bj)) { const f32x4 a = acc[ai][bj][m][0], b = acc[ai][bj][m][1];
                float ss = (a[0] * a[0] + a[1] * a[1]) + (a[2] * a[2] + a[3] * a[3]) + (b[0] * b[0] + b[1] * b[1]) + (b[2] * b[2] + b[3] * b[3]);
                ss += __shfl_xor(ss, 16); ss += __shfl_xor(ss, 32);
                if (fq == 0) tab[(row * 2 + bj) * 4 + wc] = ss; } }
    asm volatile("s_waitcnt lgkmcnt(0)" ::: "memory"); __builtin_amdgcn_s_barrier(); asm volatile("" ::: "memory");
#pragma unroll
    for (int ai = 0; ai < 2; ++ai)
#pragma unroll
        for (int m = 0; m < 4; ++m) { const int row = ai * 128 + wr * 64 + m * 16 + fr;
#pragma unroll
            for (int bj = 0; bj < 2; ++bj) { rstd[ai][m][bj] = 1.f;
                if (HMASK & (1 << bj)) { const f32x4 t = *(const LAS f32x4*)(tab + (row * 2 + bj) * 4); rstd[ai][m][bj] = rsq(((t[0] + t[1]) + (t[2] + t[3])) * (1.0f / 128) + EPS); } } }
}
template <int layer>
__device__ __forceinline__ void ph_gemm_z(LAS unsigned char* lds) {
    PH_BEGIN;
    bf16* HN = WSP(bf16, WS_HN); bf16* Z = WSP(bf16, WS_Z);
    if (layer == 0) {
        fg::DenseSched S{HN, WSP(bf16, WS_W_IN0T), 4, nullptr, nullptr, 0, DM, G, bx};
        auto E = [=](const f32x4 (&acc)[2][2][4][2], const fg::DUnit& u, int wr, int wc, int fr, int fq) {
            bf16* Zt = Z + (size_t)u.pm * 256 * 1024 + u.pn * 256;
            FG_FOREACH(acc, { store8bf(Zt + (size_t)row * 1024 + col, v0, v1); }); };
        fg::gemm_phase<false, fg::DUnit>(lds, DM, S, E);
        skinny_gemm<64>(lds, HN, WSP(bf16, WS_SK), WSP(float, WS_PK), G, bx);
    } else {
        fg::DenseSched S{HN, WSP(bf16, WS_W_IN1T), 32, nullptr, nullptr, 0, DM, G, bx};
        const float* gk = INF(20) + 128;
        auto E = [=](const f32x4 (&acc)[2][2][4][2], const fg::DUnit& u, int wr, int wc, int fr, int fq) {
            bf16* Zt = Z + (size_t)u.pm * 256 * 8192 + u.pn * 256;
            if (u.pn < 8 || u.pn >= 16) { FG_FOREACH(acc, { store8bf(Zt + (size_t)row * 8192 + col, v0, v1); }); }
            else {
                float rstd[2][4][2]; epi_head_rstd<3>(lds, acc, u.par, wr, wc, fr, fq, rstd);
                const f32x4 g0 = *(const f32x4*)(gk + wc * 32 + 8 * fq), g1 = *(const f32x4*)(gk + wc * 32 + 8 * fq + 4);
#pragma unroll
                for (int ai = 0; ai < 2; ++ai)
#pragma unroll
                    for (int m = 0; m < 4; ++m) { const int row = ai * 128 + wr * 64 + m * 16 + fr;
#pragma unroll
                        for (int bj = 0; bj < 2; ++bj) { const float r = rstd[ai][m][bj];
                            store8bf(Zt + (size_t)row * 8192 + bj * 128 + wc * 32 + 8 * fq, acc[ai][bj][m][0] * r * g0, acc[ai][bj][m][1] * r * g1); } } } };
        fg::gemm_phase<false, fg::DUnit>(lds, DM, S, E);
        skinny_gemm<16>(lds, HN, WSP(bf16, WS_SK) + (size_t)1 * 4 * 256 * 512, WSP(float, WS_PF), G, bx);
    }
}
__device__ __forceinline__ void ph_gemm_qkv(LAS unsigned char* lds) {
    PH_BEGIN;
    bf16* QL = WSP(bf16, WS_QL); bf16* KVL = WSP(bf16, WS_KVL);
    fg::DenseSched S{WSP(bf16, WS_CQN), WSP(bf16, WS_W_UQT), 12, WSP(bf16, WS_CKVN), WSP(bf16, WS_W_UKVT), 16, 512, G, bx};
    const float* gk = INF(8) + 192;
    auto E = [=](const f32x4 (&acc)[2][2][4][2], const fg::DUnit& u, int wr, int wc, int fr, int fq) {
        if (u.p == 0) { bf16* Ct = QL + (size_t)u.pm * 256 * 3072 + u.pn * 256;
            FG_FOREACH(acc, { store8bf(Ct + (size_t)row * 3072 + col, v0, v1); }); }
        else {
            float rstd[2][4][2]; epi_head_rstd<1>(lds, acc, u.par, wr, wc, fr, fq, rstd);
            const f32x4 g0 = *(const f32x4*)(gk + wc * 32 + 8 * fq), g1 = *(const f32x4*)(gk + wc * 32 + 8 * fq + 4);
            bf16* Ct = KVL + (size_t)u.pm * 256 * 4096 + u.pn * 256 + wc * 32 + 8 * fq;
#pragma unroll
            for (int ai = 0; ai < 2; ++ai)
#pragma unroll
                for (int m = 0; m < 4; ++m) { const int row = ai * 128 + wr * 64 + m * 16 + fr; const float r = rstd[ai][m][0];
                    store8bf(Ct + (size_t)row * 4096, acc[ai][0][m][0] * r * g0, acc[ai][0][m][1] * r * g1);
                    store8bf(Ct + (size_t)row * 4096 + 128, acc[ai][1][m][0], acc[ai][1][m][1]); } } };
    fg::gemm_phase<false, fg::DUnit>(lds, 512, S, E);
}
template <int layer>
__device__ __forceinline__ void ph_gemm_wo(LAS unsigned char* lds) {
    PH_BEGIN;
    const float* R = INF(0); bf16* H1b = WSP(bf16, WS_H1);
    const float* gff = INF(layer == 0 ? 10 : 22); bf16* HN = WSP(bf16, WS_HN); float* SSQ = WSP(float, WS_SSQ);
    fg::DenseSched S{WSP(bf16, WS_O), WSP(bf16, layer == 0 ? WS_W_O0T : WS_W_O1T), 8, nullptr, nullptr, 0, DM, G, bx};
    auto E = [=](const f32x4 (&acc)[2][2][4][2], const fg::DUnit& u, int wr, int wc, int fr, int fq) {
        const int colb = u.pn * 256 + wc * 32 + 8 * fq; const size_t o0 = (size_t)u.pm * 256 * DM + colb;
        f32x4 g[2][2];
#pragma unroll
        for (int bj = 0; bj < 2; ++bj) { g[bj][0] = *(const f32x4*)(gff + colb + bj * 128); g[bj][1] = *(const f32x4*)(gff + colb + bj * 128 + 4); }
#pragma unroll
        for (int ai = 0; ai < 2; ++ai) {
            f32x4 rr[4][2][2];
#pragma unroll
            for (int m = 0; m < 4; ++m)
#pragma unroll
                for (int bj = 0; bj < 2; ++bj) { const size_t o = o0 + (size_t)(ai * 128 + wr * 64 + m * 16 + fr) * DM + bj * 128;
                    if (layer == 0) { rr[m][bj][0] = *(const f32x4*)(R + o); rr[m][bj][1] = *(const f32x4*)(R + o + 4); }
                    else { const u32x4 w = *(const u32x4*)(H1b + o); rr[m][bj][0] = bf4((u32x2){w[0], w[1]}); rr[m][bj][1] = bf4((u32x2){w[2], w[3]}); } }
            asm volatile("" ::: "memory");
#pragma unroll
            for (int m = 0; m < 4; ++m) { const int row = ai * 128 + wr * 64 + m * 16 + fr; float ss = 0.f;
#pragma unroll
                for (int bj = 0; bj < 2; ++bj) { const size_t o = o0 + (size_t)row * DM + bj * 128;
                    const f32x4 h0 = rr[m][bj][0] + acc[ai][bj][m][0], h1 = rr[m][bj][1] + acc[ai][bj][m][1];
                    store8bf(H1b + o, h0, h1);
                    ss += (h0[0] * h0[0] + h0[1] * h0[1]) + (h0[2] * h0[2] + h0[3] * h0[3]) + (h1[0] * h1[0] + h1[1] * h1[1]) + (h1[2] * h1[2] + h1[3] * h1[3]);
                    store8bf(HN + o, h0 * g[bj][0], h1 * g[bj][1]); }
                ss += __shfl_xor(ss, 16); ss += __shfl_xor(ss, 32);
                if (fq == 0) SSQ[((size_t)u.pm * 256 + row) * 32 + u.pn * 4 + wc] = ss; } } };
    fg::gemm_phase<false, fg::DUnit>(lds, DM, S, E);
}

__device__ __forceinline__ void ph_mla_prep() {
    PH_BEGIN;
    const bf16* Z = WSP(bf16, WS_Z); bf16* CQN = WSP(bf16, WS_CQN); bf16* CKVN = WSP(bf16, WS_CKVN); bf16* KR = WSP(bf16, WS_KR); const float* PK = WSP(float, WS_PK);
    const float* gq = INF(4); const float* gkv = INF(5); const float* qkg = INF(8); const int* positions = (const int*)arg_ptr(1);
    for (int t = gw; t < T; t += ngw) {
        const bf16* zr = Z + (size_t)t * 1024;
        float xq[8], xk[8]; unpack8(*(const u32x4*)(zr + 8 * lane), xq); unpack8(*(const u32x4*)(zr + 512 + 8 * lane), xk);
        float sq = 0.f, sk = 0.f;
#pragma unroll
        for (int j = 0; j < 8; ++j) { sq += xq[j] * xq[j]; sk += xk[j] * xk[j]; }
        sq = wave_sum(sq); sk = wave_sum(sk);
        const float rq = rsq(sq * (1.0f / 512) + EPS), rk = rsq(sk * (1.0f / 512) + EPS);
        u32x4 oq, ok;
#pragma unroll
        for (int j = 0; j < 4; ++j) { oq[j] = pk2(xq[2 * j] * rq * gq[8 * lane + 2 * j], xq[2 * j + 1] * rq * gq[8 * lane + 2 * j + 1]);
                                      ok[j] = pk2(xk[2 * j] * rk * gkv[8 * lane + 2 * j], xk[2 * j + 1] * rk * gkv[8 * lane + 2 * j + 1]); }
        *(u32x4*)(CQN + (size_t)t * 512 + 8 * lane) = oq; *(u32x4*)(CKVN + (size_t)t * 512 + 8 * lane) = ok;
        const float* pk = PK + (size_t)t * 64 + lane;
        const float xr = (pk[0] + pk[(size_t)T * 64]) + (pk[(size_t)2 * T * 64] + pk[(size_t)3 * T * 64]);
        const float s2 = wave_sum(xr * xr);
        const float xn = xr * rsq(s2 * (1.0f / 64) + EPS) * qkg[192 + 128 + lane];
        KR[(size_t)t * 64 + lane] = (bf16)f2bf(rope64(xn, lane, (float)positions[t]));
    }
}
template <int LD, int COL0, int HSTRIDE>
__device__ __forceinline__ void knorm_rows(bf16* Kbase, const float* gain  , int gw, int ngw, int lane) {
    const int h = lane >> 2, part = lane & 3;
    f32x4 g[8];
#pragma unroll
    for (int i = 0; i < 8; ++i) g[i] = *(const f32x4*)(gain + part * 32 + 4 * i);
    for (int t = gw; t < T; t += ngw) {
        bf16* kp = Kbase + (size_t)t * LD + COL0 + h * HSTRIDE + part * 32;
        u32x4 w[4]; float x[32]; float ss = 0.f;
#pragma unroll
        for (int i = 0; i < 4; ++i) w[i] = *(const u32x4*)(kp + 8 * i);
#pragma unroll
        for (int i = 0; i < 4; ++i)
#pragma unroll
            for (int j = 0; j < 4; ++j) { x[8 * i + 2 * j] = bf2f(w[i][j] & 0xffffu); x[8 * i + 2 * j + 1] = bf2f(w[i][j] >> 16); }
#pragma unroll
        for (int i = 0; i < 32; ++i) ss += x[i] * x[i];
        ss += __shfl_xor(ss, 1); ss += __shfl_xor(ss, 2);
        const float r = rsq(ss * (1.0f / 128) + EPS);
#pragma unroll
        for (int i = 0; i < 4; ++i) { u32x4 o;
#pragma unroll
            for (int j = 0; j < 4; ++j) o[j] = pk2(x[8 * i + 2 * j] * r * g[2 * i + (j >> 1)][(2 * j) & 3], x[8 * i + 2 * j + 1] * r * g[2 * i + (j >> 1)][(2 * j + 1) & 3]);
            *(u32x4*)(kp + 8 * i) = o; }
    }
}
__device__ __forceinline__ void ph_mla_knorm() {
    PH_BEGIN;
    knorm_rows<4096, 0, 256>(WSP(bf16, WS_KVL), INF(8) + 192, gw, ngw, lane);
}
__device__ __forceinline__ void ph_fox_prep(LAS unsigned char* lds) {
    PH_BEGIN;
    const float* PF = WSP(float, WS_PF); float* CB = WSP(float, WS_C); const float* fb = INF(19);
    LAS float* wtot = (LAS float*)lds;
    for (int bh = bx; bh < NB * NH; bh += G) {
        const int b = bh >> 4, h = bh & 15; const float bias = fb[h];
        const float* pf = PF + ((size_t)b * SEQ + tid * 8) * 16 + h;
        float v[8]; float run = 0.f;
#pragma unroll
        for (int i = 0; i < 8; ++i) { const float* q = pf + i * 16;
            const float xx = ((q[0] + q[(size_t)T * 16]) + (q[(size_t)2 * T * 16] + q[(size_t)3 * T * 16])) + bias;
            run += fminf(xx, 0.f) - log1pf(expf(-fabsf(xx))); v[i] = run; }
        float incl = run;
#pragma unroll
        for (int o = 1; o < 64; o <<= 1) { const float up = __shfl_up(incl, o); if (lane >= o) incl += up; }
        if (lane == 63) wtot[wave] = incl;
        __syncthreads();
        float base = incl - run;
        for (int w = 0; w < wave; ++w) base += wtot[w];
        float* cb = CB + (size_t)bh * SEQ + tid * 8;
        *(f32x4*)cb = (f32x4){-(base + v[0]) * 1.4426950408889634f, -(base + v[1]) * 1.4426950408889634f, -(base + v[2]) * 1.4426950408889634f, -(base + v[3]) * 1.4426950408889634f};
        *(f32x4*)(cb + 4) = (f32x4){-(base + v[4]) * 1.4426950408889634f, -(base + v[5]) * 1.4426950408889634f, -(base + v[6]) * 1.4426950408889634f, -(base + v[7]) * 1.4426950408889634f};
        __syncthreads();
    }
}

namespace fa {
typedef short s16x4 __attribute__((ext_vector_type(4)));
typedef float f32x16 __attribute__((ext_vector_type(16)));
constexpr int KVB = 64, SHM_V = KVB * 128 * 2;
__device__ __forceinline__ int v_rd_base(int lane) { return ((lane & 3) << 3) | (((lane >> 2) & 3) << 6) | (((lane >> 4) & 1) << 5) | (((lane >> 5) & 1) << 8); }
constexpr int v_rd_off(int d0, int ks, int half) { return d0 * 512 + ks * 4096 + half * 2048; }
__device__ __forceinline__ int crow(int r, int hi) { return (r & 3) + 8 * (r >> 2) + 4 * hi; }
__device__ __forceinline__ unsigned cvtpk(float lo, float hi) { unsigned r; asm volatile("v_cvt_pk_bf16_f32 %0, %1, %2" : "=v"(r) : "v"(lo), "v"(hi)); return r; }

template <int layer>
__device__ __forceinline__ void attn_phase(LAS unsigned char* lds) {
    PH_BEGIN;
    constexpr int DK = layer == 0 ? 192 : 128, NQ = DK / 16, CPR = DK / 8, NKC = KVB * CPR / NTHREADS;
    constexpr int SHM_K = KVB * DK * 2;
    constexpr int OFF_V = 0, OFF_K = 2 * SHM_V, OFF_WS = OFF_K + 2 * SHM_K, OFF_CB = OFF_WS + NWAVES * 256, OFF_CV = 86016;
    static_assert(OFF_CB + 512 <= OFF_CV && OFF_CV + NWAVES * 8192 <= LDS_BARW, "attention LDS map");
    constexpr float C2 = (layer == 0 ? 0.07216878364870322f : 0.08838834764831845f) * 1.4426950408889634f;
    constexpr int QLD = layer == 0 ? 3072 : 8192, QHS = layer == 0 ? 192 : 128, KLD = layer == 0 ? 4096 : 8192, KC0 = layer == 0 ? 0 : 2048, KHS = layer == 0 ? 256 : 128, VC0 = layer == 0 ? 128 : 4096;
    const bf16* Qs = layer == 0 ? WSP(bf16, WS_QL) : WSP(bf16, WS_Z); const bf16* Ks = layer == 0 ? WSP(bf16, WS_KVL) : WSP(bf16, WS_Z); const bf16* KRs = WSP(bf16, WS_KR); bf16* Ob = WSP(bf16, WS_O);
    const float* qkg = INF(layer == 0 ? 8 : 20); const int* positions = (const int*)arg_ptr(1);
    const float* CBg = WSP(float, WS_C); const bf16* Zg = WSP(bf16, WS_Z);
    const int wid = __builtin_amdgcn_readfirstlane(tid >> 6), r32 = lane & 31, hi = lane >> 5;
    auto koff_n = [](int tk, int j) { const int ci = j * 256 + tk, row = ci >> 4, pc = ci & 15, lc = pc ^ (row & 7); return (unsigned)(row * KLD + lc * 8) * 2u; };
    auto koff_r = [](int tk, int j) { const int ci = j * 256 + tk, row = ci >> 3, pc = ci & 7, lc = pc ^ (row & 7); return (unsigned)(row * 64 + lc * 8) * 2u; };
    auto voff_f = [](int tk, int j) { const int ci = j * 256 + tk, st = ci >> 5, w = ci & 31, kk = (st >> 2) * 8 + (w >> 2), key = (kk & ~0xC) | ((kk & 4) << 1) | ((kk & 8) >> 1), c = (st & 3) * 32 + (w & 3) * 8;
        return (unsigned)(key * KLD + c) * 2u; };
    const int tkp = (tid - 256) & 255; const unsigned kof0 = koff_n(tkp, 0), vof0 = voff_f(tkp, 0), rof0 = koff_r(tkp, 0);
    const int kbn = r32 * 256 + ((hi * 16) ^ ((r32 & 7) << 4)), kbr0 = 16384 + r32 * 128 + ((hi * 16) ^ ((r32 & 7) << 4));
    const unsigned ldsb = (unsigned)(uintptr_t)lds;
    const int vb0 = (int)(unsigned)(uintptr_t)(lds + OFF_V) + v_rd_base(lane);
    LAS float* wsl = (LAS float*)(lds + OFF_WS) + wid * 64; LAS float* li_l = wsl; LAS float* al_l = wsl + 32;

    const float* cv_wgu = INF(layer == 0 ? 15 : 27); const float* cv_wdn = INF(layer == 0 ? 16 : 28); bf16* cv_gut = WSP(bf16, CV_MODE >= 2 ? WS_Q : WS_W_GUT); bf16* cv_dt = WSP(bf16, CV_MODE >= 2 ? WS_Q : WS_W_DT);
    constexpr int CV_IG = 32 * 32, CV_ID = 8 * 64, CV_NIT = NEXP * (CV_IG + CV_ID);
    int cv_it = (CV_MODE == 1) ? CV_NIT : bx * 4 + wid, cv_pend = -1; const int cv_stride = G * 4;
    const unsigned cv_lds = (unsigned)(uintptr_t)(lds + OFF_CV) + (unsigned)(wid & 3) * 16384u;
#define CV_DECODE(it_) const bool gu_ = (it_) < NEXP * CV_IG; const int v_ = gu_ ? (it_) : (it_) - NEXP * CV_IG, e_ = gu_ ? v_ >> 10 : v_ >> 9, r_ = gu_ ? v_ & 1023 : v_ & 511;     \
        const int lgN_ = gu_ ? 10 : 11, lgK_ = gu_ ? 11 : 9, N_ = 1 << lgN_, k0_ = (r_ >> (lgN_ - 5)) << 6, n0_ = (r_ & ((1 << (lgN_ - 5)) - 1)) << 5; \
        const float* W_ = (gu_ ? cv_wgu : cv_wdn) + ((size_t)e_ << (gu_ ? 21 : 20)); bf16* WT_ = (gu_ ? cv_gut : cv_dt) + (((size_t)e_ << (gu_ ? 21 : 20)) & (CV_MODE >= 2 ? (size_t)0x1ffffff : ~(size_t)0))
#define CV_ISSUE(it_, SLOT) do { { CV_DECODE(it_); const int lz_ = otid() & 63; \
        const unsigned vb_ = (unsigned)((lz_ >> 3) * N_) * 4u; const char* sb_ = (const char*)(W_ + (size_t)k0_ * N_ + n0_); \
        _Pragma("unroll") for (int i = 0; i < 8; ++i) { const char* si_ = sb_ + (size_t)i * 8 * N_ * 4; const unsigned vo_ = vb_ + ((unsigned)((lz_ & 7) ^ i) << 4); unsigned keep_; \
            asm volatile("s_mov_b32 %0, m0\n\ts_mov_b32 m0, %3\n\ts_nop 0\n\tglobal_load_lds_dwordx4 %1, %2 nt\n\ts_mov_b32 m0, %0" : "=&s"(keep_) : "v"(vo_), "s"(si_), "s"(cv_lds + (unsigned)(SLOT) * 8192u + (unsigned)i * 1024u) : "memory"); } } } while (0)
#define CV_FINISH(it_, SLOT) do { { CV_DECODE(it_); const int lz_ = otid() & 63, c_ = lz_ & 7; const LAS float* scr_ = (const LAS float*)(lds + OFF_CV) + (wid & 3) * 4096 + (SLOT) * 2048; \
        float cvr_[4][8];                                                                           \
        _Pragma("unroll") for (int j = 0; j < 4; ++j) { const int n_ = (lz_ >> 3) + 8 * j; const LAS float* sp_ = scr_ + (8 * c_) * 32 + (((n_ >> 2) ^ c_) << 2) + (n_ & 3); \
            _Pragma("unroll") for (int q = 0; q < 8; ++q) cvr_[j][q] = sp_[32 * q]; } \
        asm volatile("s_waitcnt lgkmcnt(0)" ::: "memory"); __builtin_amdgcn_sched_barrier(0); \
        _Pragma("unroll") for (int j = 0; j < 4; ++j) { const int n_ = (lz_ >> 3) + 8 * j; \
            u32x4 o_; o_.x = pk2(cvr_[j][0], cvr_[j][1]); o_.y = pk2(cvr_[j][2], cvr_[j][3]); o_.z = pk2(cvr_[j][4], cvr_[j][5]); o_.w = pk2(cvr_[j][6], cvr_[j][7]); \
            const int nn_ = n0_ + n_; const int f_ = nn_ & 511; \
            const int dr_ = gu_ ? ((f_ >> 7) * 256 + ((f_ >> 6) & 1) * 128 + ((f_ >> 4) & 3) * 32 + ((f_ >> 2) & 3) * 8 + (nn_ >> 9) * 4 + (f_ & 3)) : nn_;     \
            __builtin_nontemporal_store(o_, (u32x4*)(WT_ + ((size_t)dr_ << lgK_) + k0_ + 8 * c_)); } \
        } } while (0)
    for (int L = bx; L < NB * NH * 8; L += G) {
        const int bh = (L & 7) * 8 + (L >> 6), pair = (L >> 3) & 7, b = bh >> 4, h = bh & 15;
        const char* Kg = (const char*)(Ks + (size_t)b * SEQ * KLD + KC0 + h * KHS); const char* Vg = (const char*)(Ks + (size_t)b * SEQ * KLD + VC0 + h * KHS);
        const char* KRg = (const char*)(KRs + (size_t)b * SEQ * 64); const float* cbg = CBg + (size_t)bh * SEQ;
        for (int pass = 0; pass < 2; ++pass) {
            const int qb = pass ? pair : 15 - pair, P0 = qb * 256, NT = P0 / KVB + 4, qlo = P0 + wid * 32;
            bf16x8 qr[NQ];
            {
                const size_t tq = (size_t)b * SEQ + qlo + r32;
                const bf16* qp = Qs + tq * QLD + h * QHS + hi * 8;
                u32x4 raw[NQ];
#pragma unroll
                for (int d0 = 0; d0 < NQ; ++d0) raw[d0] = *(const u32x4*)(qp + d0 * 16);
                float ss = 0.f;
#pragma unroll
                for (int d0 = 0; d0 < 8; ++d0)
#pragma unroll
                    for (int j = 0; j < 4; ++j) { const float x0 = bf2f(raw[d0][j] & 0xffffu), x1 = bf2f(raw[d0][j] >> 16); ss += x0 * x0 + x1 * x1; }
                { auto rr = __builtin_amdgcn_permlane32_swap(__float_as_uint(ss), __float_as_uint(ss), false, false); ss = __uint_as_float(rr[0]) + __uint_as_float(rr[1]); }
                const float rn = rsq(ss * (1.0f / 128) + EPS) * C2;
#pragma unroll
                for (int d0 = 0; d0 < 8; ++d0) { const f32x4 g0 = *(const f32x4*)(qkg + d0 * 16 + hi * 8), g1 = *(const f32x4*)(qkg + d0 * 16 + hi * 8 + 4); u32x4 o;
#pragma unroll
                    for (int j = 0; j < 4; ++j) { const float x0 = bf2f(raw[d0][j] & 0xffffu), x1 = bf2f(raw[d0][j] >> 16); const f32x4 gg = j < 2 ? g0 : g1;
                        o[j] = cvtpk(x0 * rn * gg[(2 * j) & 3], x1 * rn * gg[(2 * j + 1) & 3]); }
                    qr[d0] = *reinterpret_cast<bf16x8*>(&o); }
                if constexpr (layer == 0) {
                    float xr[4][8]; float s2 = 0.f;
#pragma unroll
                    for (int c = 0; c < 4; ++c)
#pragma unroll
                        for (int j = 0; j < 4; ++j) { xr[c][2 * j] = bf2f(raw[8 + c][j] & 0xffffu); xr[c][2 * j + 1] = bf2f(raw[8 + c][j] >> 16); s2 += xr[c][2 * j] * xr[c][2 * j] + xr[c][2 * j + 1] * xr[c][2 * j + 1]; }
                    { auto rr = __builtin_amdgcn_permlane32_swap(__float_as_uint(s2), __float_as_uint(s2), false, false); s2 = __uint_as_float(rr[0]) + __uint_as_float(rr[1]); }
                    const float r2 = rsq(s2 * (1.0f / 64) + EPS); const float pos = (float)positions[tq];
#pragma unroll
                    for (int c = 0; c < 4; ++c) { const f32x4 g0 = *(const f32x4*)(qkg + 128 + c * 16 + hi * 8), g1 = *(const f32x4*)(qkg + 128 + c * 16 + hi * 8 + 4);
#pragma unroll
                        for (int j = 0; j < 8; ++j) xr[c][j] *= r2 * (j < 4 ? g0[j & 3] : g1[j & 3]); }
#pragma unroll
                    for (int c = 0; c < 2; ++c) { u32x4 o1, o2;
#pragma unroll
                        for (int jj = 0; jj < 4; ++jj) { float y1[2], y2[2];
#pragma unroll
                            for (int e = 0; e < 2; ++e) { const int j = 2 * jj + e; const int i = c * 16 + hi * 8 + j;
                                const float freq = exp2f(-(float)i * (13.287712379549449f / 32.0f)); float rev = pos * freq * 0.15915494309189535f; rev -= floorf(rev);
                                const float sn = __builtin_amdgcn_sinf(rev), cs = __builtin_amdgcn_cosf(rev);
                                y1[e] = (xr[c][j] * cs - xr[c + 2][j] * sn) * C2; y2[e] = (xr[c + 2][j] * cs + xr[c][j] * sn) * C2; }
                            o1[jj] = cvtpk(y1[0], y1[1]); o2[jj] = cvtpk(y2[0], y2[1]); }
                        qr[8 + c] = *reinterpret_cast<bf16x8*>(&o1); qr[10 + c] = *reinterpret_cast<bf16x8*>(&o2); }
                }
            }
            float m_reg = 0.f, l_reg = 0.f; f32x16 o[4];
#pragma unroll
            for (int d0 = 0; d0 < 4; ++d0)
#pragma unroll
                for (int r = 0; r < 16; ++r) o[d0][r] = 0.f;
#define FA_DMA16(sbase_, voff_, ldsaddr_) do { unsigned keep_; asm volatile("s_mov_b32 %0, m0\n\ts_mov_b32 m0, %3\n\ts_nop 0\n\tglobal_load_lds_dwordx4 %1, %2\n\ts_mov_b32 m0, %0" \
        : "=&s"(keep_) : "v"(voff_), "s"(sbase_), "s"(ldsaddr_) : "memory"); } while (0)
#define FA_DMA4(sbase_, voff_, ldsaddr_) do { unsigned keep_; asm volatile("s_mov_b32 %0, m0\n\ts_mov_b32 m0, %3\n\ts_nop 0\n\tglobal_load_lds_dword %1, %2\n\ts_mov_b32 m0, %0" \
        : "=&s"(keep_) : "v"(voff_), "s"(sbase_), "s"(ldsaddr_) : "memory"); } while (0)
#define FA_ISSUE(t_, BUF) do { if (wid >= 4) { const char* ks_ = Kg + (size_t)(t_) * (KVB * KLD * 2); const char* vs_ = Vg + (size_t)(t_) * (KVB * KLD * 2); const unsigned wl_ = (unsigned)(wid - 4) * 1024u; \
        _Pragma("unroll") for (int j = 0; j < 4; ++j) FA_DMA16(ks_, kof0 + (unsigned)(j * 16 * KLD * 2), ldsb + (unsigned)(OFF_K + (BUF) * SHM_K + j * 4096) + wl_); \
        if constexpr (layer == 0) { const char* kr_ = KRg + (size_t)(t_) * (KVB * 64 * 2); \
            _Pragma("unroll") for (int j = 0; j < 2; ++j) FA_DMA16(kr_, rof0 + (unsigned)(j * 32 * 64 * 2), ldsb + (unsigned)(OFF_K + (BUF) * SHM_K + 16384 + j * 4096) + wl_); } \
        _Pragma("unroll") for (int j = 0; j < 4; ++j) FA_DMA16(vs_, vof0 + (unsigned)(j * 16 * KLD * 2), ldsb + (unsigned)(OFF_V + (BUF) * SHM_V + j * 4096) + wl_); \
        if (layer == 1 && wid == 4) { const float* cs_ = cbg + (t_) * KVB; FA_DMA4(cs_, (unsigned)lane * 4u, ldsb + (unsigned)(OFF_CB + (BUF) * 256)); } } } while (0)
#define FA_TRRD(dst, off) asm volatile("ds_read_b64_tr_b16 %0, %1 offset:%2" : "=&v"(dst) : "v"(vb0), "i"(off) : "memory")
#define FA_PV_D0(BUF, d0) do { s16x4 l0, l1, l2, l3, h0, h1, h2, h3; constexpr int b_ = (BUF) * SHM_V + v_rd_off(d0, 0, 0); \
        FA_TRRD(l0, b_); FA_TRRD(h0, b_ + 2048); FA_TRRD(l1, b_ + 4096); FA_TRRD(h1, b_ + 6144); FA_TRRD(l2, b_ + 8192); FA_TRRD(h2, b_ + 10240); FA_TRRD(l3, b_ + 12288); FA_TRRD(h3, b_ + 14336); \
        asm volatile("s_waitcnt lgkmcnt(0)" ::: "memory"); __builtin_amdgcn_sched_barrier(0); \
        o[d0] = __builtin_amdgcn_mfma_f32_32x32x16_bf16((bf16x8){l0[0], l0[1], l0[2], l0[3], h0[0], h0[1], h0[2], h0[3]}, pa0, o[d0], 0, 0, 0); \
        o[d0] = __builtin_amdgcn_mfma_f32_32x32x16_bf16((bf16x8){l1[0], l1[1], l1[2], l1[3], h1[0], h1[1], h1[2], h1[3]}, pa1, o[d0], 0, 0, 0); \
        o[d0] = __builtin_amdgcn_mfma_f32_32x32x16_bf16((bf16x8){l2[0], l2[1], l2[2], l2[3], h2[0], h2[1], h2[2], h2[3]}, pa2, o[d0], 0, 0, 0); \
        o[d0] = __builtin_amdgcn_mfma_f32_32x32x16_bf16((bf16x8){l3[0], l3[1], l3[2], l3[3], h3[0], h3[1], h3[2], h3[3]}, pa3, o[d0], 0, 0, 0); } while (0)
#define FA_PK4(P, B_, OUT) do { const unsigned a0 = cvtpk(P[B_ + 0], P[B_ + 1]), a1 = cvtpk(P[B_ + 2], P[B_ + 3]), b0_ = cvtpk(P[B_ + 4], P[B_ + 5]), b1_ = cvtpk(P[B_ + 6], P[B_ + 7]); \
        auto r0 = __builtin_amdgcn_permlane32_swap(a0, b0_, false, false); auto r1 = __builtin_amdgcn_permlane32_swap(a1, b1_, false, false); \
        u32x4 w_ = {r0[0], r1[0], r0[1], r1[1]}; OUT = *reinterpret_cast<bf16x8*>(&w_); } while (0)
#define FA_STEP(t_, BUF) do { \
          \
        if (wid >= 4 || (t_) == 0) asm volatile("s_waitcnt vmcnt(0)" ::: "memory");                 \
        asm volatile("s_waitcnt lgkmcnt(0)" ::: "memory"); __builtin_amdgcn_s_barrier(); asm volatile("" ::: "memory");     \
        if ((t_) + 1 < NT) FA_ISSUE((t_) + 1, (BUF) ^ 1); \
        if (wid < 4) {                                                                             \
            if (cv_pend >= 0) { asm volatile("s_waitcnt vmcnt(0)" ::: "memory"); CV_FINISH(cv_pend, (BUF) ^ 1); cv_pend = -1; }     \
            if (cv_it < CV_NIT) { CV_ISSUE(cv_it, BUF); cv_pend = cv_it; cv_it += cv_stride; } }         \
        const int kbase = (t_) * KVB; \
        if (kbase <= qlo + 31) {                                                                   \
            f32x16 p0, p1; \
            _Pragma("unroll") for (int r = 0; r < 16; ++r) { p0[r] = 0.f; p1[r] = 0.f; } \
            const LAS unsigned char* kt = lds + OFF_K + (BUF) * SHM_K; \
            int kbn_ = kbn, kbr_ = kbr0; asm volatile("" : "+v"(kbn_), "+v"(kbr_));                 \
            if (wid < 4) __builtin_amdgcn_s_setprio(2); else __builtin_amdgcn_s_setprio(1);          \
            _Pragma("unroll") for (int d0 = 0; d0 < NQ; ++d0) { const LAS unsigned char* a_ = d0 < 8 ? kt + (kbn_ ^ ((d0 & 3) << 5)) + (d0 >> 2) * 128 : kt + (kbr_ ^ ((d0 & 3) << 5)); \
                const bf16x8 k0 = *(const LAS bf16x8*)a_, k1 = *(const LAS bf16x8*)(a_ + (d0 < 8 ? 32 * 256 : 32 * 128)); \
                p0 = __builtin_amdgcn_mfma_f32_32x32x16_bf16(k0, qr[d0], p0, 0, 0, 0); p1 = __builtin_amdgcn_mfma_f32_32x32x16_bf16(k1, qr[d0], p1, 0, 0, 0); \
                if ((d0 & 3) == 3) __builtin_amdgcn_sched_barrier(0); } \
            if (layer == 1) { const LAS f32x4* cb = (const LAS f32x4*)(lds + OFF_CB + (BUF) * 256); \
                _Pragma("unroll") for (int g = 0; g < 4; ++g) { const f32x4 c0 = cb[2 * g + hi], c1 = cb[8 + 2 * g + hi]; \
                    _Pragma("unroll") for (int j = 0; j < 4; ++j) { p0[4 * g + j] += c0[j]; p1[4 * g + j] += c1[j]; } \
                    __builtin_amdgcn_sched_barrier(0); } } \
            if (kbase + KVB - 1 > qlo) { const int dq = qlo + r32 - 4 * hi - kbase; const float NEG = -__builtin_inff();     \
                _Pragma("unroll") for (int r = 0; r < 16; ++r) { const int c = (r & 3) + 8 * (r >> 2); if (dq - c < 0) p0[r] = NEG; if (dq - c - 32 < 0) p1[r] = NEG; } } \
            float pmax = p0[0]; \
            _Pragma("unroll") for (int r = 1; r < 16; ++r) pmax = fmaxf(pmax, p0[r]); \
            _Pragma("unroll") for (int r = 0; r < 16; ++r) pmax = fmaxf(pmax, p1[r]); \
            { auto rr = __builtin_amdgcn_permlane32_swap(__float_as_uint(pmax), __float_as_uint(pmax), false, false); pmax = fmaxf(__uint_as_float(rr[0]), __uint_as_float(rr[1])); } \
              \
            if ((t_) == 0) m_reg = pmax < -64.0f ? pmax : 0.f; \
            float mn, alpha; \
            if (__all(pmax - m_reg <= 64.0f)) { mn = m_reg; alpha = 1.f; } else { mn = fmaxf(m_reg, pmax); alpha = __builtin_amdgcn_exp2f(m_reg - mn); m_reg = mn; } \
            float ps = 0.f; \
            if (__all(mn == 0.f)) { _Pragma("unroll") for (int r = 0; r < 16; ++r) { p0[r] = __builtin_amdgcn_exp2f(p0[r]); p1[r] = __builtin_amdgcn_exp2f(p1[r]); ps += p0[r] + p1[r]; } } \
            else { _Pragma("unroll") for (int r = 0; r < 16; ++r) { p0[r] = __builtin_amdgcn_exp2f(p0[r] - mn); p1[r] = __builtin_amdgcn_exp2f(p1[r] - mn); ps += p0[r] + p1[r]; } } \
            { auto rr = __builtin_amdgcn_permlane32_swap(__float_as_uint(ps), __float_as_uint(ps), false, false); ps = __uint_as_float(rr[0]) + __uint_as_float(rr[1]); } \
            l_reg = l_reg * alpha + ps; \
            bf16x8 pa0, pa1, pa2, pa3; FA_PK4(p0, 0, pa0); FA_PK4(p0, 8, pa1); FA_PK4(p1, 0, pa2); FA_PK4(p1, 8, pa3); \
            if (__any(alpha < 1.f)) {                                                              \
                _Pragma("unroll") for (int d_ = 0; d_ < 4; ++d_) _Pragma("unroll") for (int r = 0; r < 16; ++r) o[d_][r] *= alpha; } \
            FA_PV_D0(BUF, 0); FA_PV_D0(BUF, 1); FA_PV_D0(BUF, 2); FA_PV_D0(BUF, 3); __builtin_amdgcn_s_setprio(0); \
        } \
        } while (0)
            FA_ISSUE(0, 0);
            for (int t = 0; t < NT; t += 2) { FA_STEP(t, 0); FA_STEP(t + 1, 1); }
            { const int tz = otid(), hz = (tz >> 5) & 1, rz = tz & 31;
              const size_t trow = (size_t)b * SEQ + qlo + rz; const float rl = __builtin_amdgcn_rcpf(l_reg);
              u32x2 gts[4][4];
              if (layer == 1) { const bf16* gp = Zg + trow * 8192 + 6144 + h * 128 + 4 * hz;
#pragma unroll
                  for (int d0 = 0; d0 < 4; ++d0)
#pragma unroll
                      for (int g = 0; g < 4; ++g) gts[d0][g] = *(const u32x2*)(gp + d0 * 32 + 8 * g); }
              bf16* op = Ob + trow * DM + h * 128 + 8 * hz;
#pragma unroll
              for (int d0 = 0; d0 < 4; ++d0)
#pragma unroll
                  for (int gp2 = 0; gp2 < 2; ++gp2) { unsigned pk[2][2];
#pragma unroll
                      for (int e = 0; e < 2; ++e) { const int g = 2 * gp2 + e; float v[4];
#pragma unroll
                          for (int j = 0; j < 4; ++j) v[j] = o[d0][4 * g + j] * rl;
                          if (layer == 1) { const u32x2 gw = gts[d0][g]; const float g4[4] = {bf2f(gw[0] & 0xffffu), bf2f(gw[0] >> 16), bf2f(gw[1] & 0xffffu), bf2f(gw[1] >> 16)};
#pragma unroll
                              for (int j = 0; j < 4; ++j) v[j] *= 1.0f / (1.0f + __expf(-g4[j])); }
                          pk[e][0] = cvtpk(v[0], v[1]); pk[e][1] = cvtpk(v[2], v[3]); }
                      auto s0 = __builtin_amdgcn_permlane32_swap(pk[0][0], pk[1][0], false, false); auto s1 = __builtin_amdgcn_permlane32_swap(pk[0][1], pk[1][1], false, false);
                      *(u32x4*)(op + d0 * 32 + 16 * gp2) = (u32x4){s0[0], s1[0], s0[1], s1[1]}; } }
        }
    }
    asm volatile("s_waitcnt vmcnt(0)" ::: "memory");
    if (wid < 4) { if (cv_pend >= 0) CV_FINISH(cv_pend, 1);
        while (cv_it < CV_NIT) { CV_ISSUE(cv_it, 0); asm volatile("s_waitcnt vmcnt(0)" ::: "memory"); CV_FINISH(cv_it, 0); cv_it += cv_stride; } }
    __syncthreads();
#undef CV_DECODE
#undef CV_ISSUE
#undef CV_FINISH
#undef FA_ISSUE
#undef FA_DMA16
#undef FA_DMA4
#undef FA_TRRD
#undef FA_PV_D0
#undef FA_PK4
#undef FA_STEP
}
}

template <int layer>
__device__ __forceinline__ void ph_router(LAS unsigned char* lds) {
    PH_BEGIN;
    skinny_gemm<80>(lds, WSP(bf16, WS_HN), WSP(bf16, WS_SK) + (size_t)(2 + layer) * 4 * 256 * 512, WSP(float, WS_PR), G, bx);
}
template <int layer>
__device__ __forceinline__ void ph_route() {
    PH_BEGIN;
    const float* PR = WSP(float, WS_PR); int* TOK = WSP(int, WS_TOK); float* GATE = WSP(float, WS_GATE); int* TSLOT = WSP(int, WS_TSLOT); const float* SSQ = WSP(float, WS_SSQ); float* RSL = WSP(float, WS_RSL);
    unsigned* cnt = WSP(unsigned, WS_CTL) + (layer == 0 ? CW_CNT0 : CW_CNT1);
    const float* b_rg = INF(layer == 0 ? 12 : 24); const float* b_re = INF(layer == 0 ? 14 : 26);
    for (int t = bx * NTHREADS + tid; t < T; t += G * NTHREADS) {
        const float* pr = PR + (size_t)t * 80;
        float rstd; { f32x4 q = *(const f32x4*)(SSQ + (size_t)t * 32);
#pragma unroll
            for (int i = 1; i < 8; ++i) q += *(const f32x4*)(SSQ + (size_t)t * 32 + 4 * i);
            rstd = rsq(((q[0] + q[1]) + (q[2] + q[3])) * (1.0f / DM) + EPS); }
        auto sum4 = [=](int j) { const f32x4 a0 = *(const f32x4*)(pr + j), a1 = *(const f32x4*)(pr + (size_t)T * 80 + j), a2 = *(const f32x4*)(pr + (size_t)2 * T * 80 + j), a3 = *(const f32x4*)(pr + (size_t)3 * T * 80 + j);
            return (a0 + a1) + (a2 + a3); };
        float gl[8]; int g = 0; float gm = -3.0e38f;
        { const f32x4 x0 = sum4(0), x1 = sum4(4);
#pragma unroll
          for (int j = 0; j < 8; ++j) { gl[j] = (j < 4 ? x0[j & 3] : x1[j & 3]) * rstd + b_rg[j]; if (gl[j] > gm) { gm = gl[j]; g = j; } } }
        float se = 0.f;
#pragma unroll
        for (int j = 0; j < 8; ++j) se += expf(gl[j] - gm);
        const float pg = 1.0f / se;
        float el[8]; int i1 = 0; float m1 = -3.0e38f;
        { const f32x4 x0 = sum4(8 + g * 8), x1 = sum4(12 + g * 8);
#pragma unroll
          for (int j = 0; j < 8; ++j) { el[j] = (j < 4 ? x0[j & 3] : x1[j & 3]) * rstd + b_re[g * 8 + j]; if (el[j] > m1) { m1 = el[j]; i1 = j; } } }
        int i2 = 0; float m2 = -3.0e38f;
#pragma unroll
        for (int j = 0; j < 8; ++j) { if (j != i1 && el[j] > m2) { m2 = el[j]; i2 = j; } }
        const float w2 = expf(m2 - m1), g1 = pg / (1.0f + w2), g2 = pg * w2 / (1.0f + w2);
        const int e1 = g * 8 + i1, e2 = g * 8 + i2;
        const unsigned s1 = atomicAdd(&cnt[e1], 1u); TOK[(size_t)e1 * T + s1] = t; GATE[(size_t)e1 * T + s1] = g1; RSL[(size_t)e1 * T + s1] = rstd;
        const unsigned s2 = atomicAdd(&cnt[e2], 1u); TOK[(size_t)e2 * T + s2] = t; GATE[(size_t)e2 * T + s2] = g2; RSL[(size_t)e2 * T + s2] = rstd;
        TSLOT[2 * t] = (e1 << 16) | (int)s1; TSLOT[2 * t + 1] = (e2 << 16) | (int)s2;
    }
}
struct MUnit { int e, mt, mtg, pn, ce; };
template <bool GU>
struct MoeSched {
    const LAS int* ts; const LAS int* cn; const char* A; const char* B; const int* tok; int G, c;
    static constexpr int NPN = GU ? 4 : 8, K = GU ? DM : DEXP;
    __device__ __forceinline__ bool next(int i, MUnit& u) const {
        const LAS int* xs = (const LAS int*)((const LAS unsigned char*)ts + (LDS_XS - LDS_TS));
        const int x = c & 7, W = G >> 3, q = i * W + (c >> 3); if ((G & 7) != 0 || q >= xs[8] * NPN) return false;
        int k = 0; while (xs[k + 1] * NPN <= q) ++k;
        const int e = x + 8 * k, rq = q - xs[k] * NPN, nte = xs[k + 1] - xs[k]; u.pn = rq / nte; u.mt = rq - u.pn * nte;
        u.e = e; u.mtg = ts[e] + u.mt; u.ce = cn[e]; return true; }
    __device__ __forceinline__ const char* a_base(const MUnit& u) const { return GU ? A : A + (size_t)u.mtg * 256 * DEXP * 2; }
    __device__ __forceinline__ const char* b_base(const MUnit& u) const { return B + ((size_t)u.e * (GU ? 1024 : DM) + u.pn * 256) * K * 2; }
    __device__ __forceinline__ unsigned a_voff(const MUnit& u, int row, int col) const {
        if (GU) { const int s = u.mt * 256 + row; return (unsigned)tok[(size_t)u.e * T + (s < u.ce ? s : 0)] * (unsigned)(DM * 2) + (unsigned)col * 2u; }
        return (unsigned)(row * DEXP + col) * 2u; }
    __device__ __forceinline__ bool lo_only(const MUnit& u) const { return u.ce - u.mt * 256 <= 128; }
};
template <int layer>
__device__ __forceinline__ void ph_gateup(LAS unsigned char* lds) {
    PH_BEGIN;
    moe_prefix(lds, WSP(unsigned, WS_CTL) + (layer == 0 ? CW_CNT0 : CW_CNT1));
    bf16* ACT = WSP(bf16, WS_ACT); const float* RSL = WSP(float, WS_RSL);
    MoeSched<true> S{(const LAS int*)(lds + LDS_TS), (const LAS int*)(lds + LDS_CN), (const char*)WSP(bf16, WS_HN), (const char*)WSP(bf16, WS_W_GUT), WSP(int, WS_TOK), G, bx};
    auto E = [=](const f32x4 (&acc)[2][2][4][2], const MUnit& u, int wr, int wc, int fr, int fq) {
        bf16* At = ACT + (size_t)u.mtg * 256 * DEXP + u.pn * 128 + wc * 16 + 4 * fq;
        float rsv[2][4];
#pragma unroll
        for (int ai = 0; ai < 2; ++ai)
#pragma unroll
            for (int m = 0; m < 4; ++m) { const int row = ai * 128 + wr * 64 + m * 16 + fr; rsv[ai][m] = u.mt * 256 + row < u.ce ? RSL[(size_t)u.e * T + u.mt * 256 + row] : 0.f; }
        asm volatile("" ::: "memory");
#pragma unroll
        for (int ai = 0; ai < 2; ++ai)
#pragma unroll
            for (int m = 0; m < 4; ++m) { const int row = ai * 128 + wr * 64 + m * 16 + fr; if (ai == 1 && u.ce - u.mt * 256 <= 128) continue;
                const float rs = rsv[ai][m];
#pragma unroll
                for (int bj = 0; bj < 2; ++bj) { const f32x4 g = acc[ai][bj][m][0] * rs, up = acc[ai][bj][m][1] * rs; f32x4 o;
#pragma unroll
                    for (int j = 0; j < 4; ++j) o[j] = g[j] / (1.0f + __expf(-g[j])) * up[j];
                    store4bf(At + (size_t)row * DEXP + bj * 64, o); } } };
    fg::gemm_phase<true, MUnit>(lds, DM, S, E);
}
template <int layer>
__device__ __forceinline__ void ph_down(LAS unsigned char* lds) {
    PH_BEGIN;
    moe_prefix(lds, WSP(unsigned, WS_CTL) + (layer == 0 ? CW_CNT0 : CW_CNT1));
    bf16* YS = WSP(bf16, WS_YS); const float* GATE = WSP(float, WS_GATE);
    MoeSched<false> S{(const LAS int*)(lds + LDS_TS), (const LAS int*)(lds + LDS_CN), (const char*)WSP(bf16, WS_ACT), (const char*)WSP(bf16, WS_W_DT), nullptr, G, bx};
    auto E = [=](const f32x4 (&acc)[2][2][4][2], const MUnit& u, int wr, int wc, int fr, int fq) {
        const int rem = u.ce - u.mt * 256; const float* gt = GATE + (size_t)u.e * T + u.mt * 256;
        bf16* Yt = YS + (size_t)u.mtg * 256 * DM + u.pn * 256 + wc * 32 + 8 * fq;
        float gv[2][4];
#pragma unroll
        for (int ai = 0; ai < 2; ++ai)
#pragma unroll
            for (int m = 0; m < 4; ++m) { const int row = ai * 128 + wr * 64 + m * 16 + fr; gv[ai][m] = row < rem ? gt[row] : 0.f; }
        asm volatile("" ::: "memory");
#pragma unroll
        for (int ai = 0; ai < 2; ++ai)
#pragma unroll
            for (int m = 0; m < 4; ++m) { const int row = ai * 128 + wr * 64 + m * 16 + fr;
                if (row < rem) { const float g = gv[ai][m];
#pragma unroll
                    for (int bj = 0; bj < 2; ++bj) store8bf(Yt + (size_t)row * DM + bj * 128, acc[ai][bj][m][0] * g, acc[ai][bj][m][1] * g); } } };
    fg::gemm_phase<false, MUnit>(lds, DEXP, S, E);
}

#define GRID_BAR() xcd_barrier(bar)
__global__ void __launch_bounds__(NTHREADS, 2) fwd(Args a) {
    extern __shared__ __attribute__((aligned(16))) unsigned char lds_raw[];
    LAS unsigned char* lds = (LAS unsigned char*)lds_raw;
    (void)a;
    if (threadIdx.x < 4) ((LAS unsigned*)(lds + LDS_BARW))[threadIdx.x] = 0u;
    __syncthreads();
    unsigned* ctl0 = (unsigned*)arg_ptr(30);
    const XcdBarrier bar = xcd_barrier_post(ctl0 + CW_BAR, (volatile LAS unsigned*)(lds + LDS_BARW));
    ph_convert_dense(lds);
    if (CV_MODE >= 1) ph_convert_moe<0>(lds);
    norm_rows<0>(lds, const_cast<float*>(INF(0)), INF(2), nullptr); GRID_BAR();
    ph_gemm_z<0>(lds); GRID_BAR();
    ph_mla_prep(); GRID_BAR();
    ph_gemm_qkv(lds); GRID_BAR();
    fa::attn_phase<0>(lds); GRID_BAR();
    ph_gemm_wo<0>(lds); GRID_BAR();
    ph_router<0>(lds); GRID_BAR();
    ph_route<0>(); GRID_BAR();
    ph_gateup<0>(lds); GRID_BAR();
    ph_down<0>(lds); GRID_BAR();
    norm_rows<1>(lds, (float*)arg_ptr(29), INF(17), (const unsigned*)arg_ptr(30) + CW_CNT0); if (CV_MODE >= 1) ph_convert_moe<1>(lds); GRID_BAR();
    ph_gemm_z<1>(lds); GRID_BAR();
    ph_fox_prep(lds); GRID_BAR();
    fa::attn_phase<1>(lds); GRID_BAR();
    ph_gemm_wo<1>(lds); GRID_BAR();
    ph_router<1>(lds); GRID_BAR();
    ph_route<1>(); GRID_BAR();
    ph_gateup<1>(lds); GRID_BAR();
    ph_down<1>(lds); GRID_BAR();
    norm_rows<2>(lds, (float*)arg_ptr(29), nullptr, (const unsigned*)arg_ptr(30) + CW_CNT1);
}

extern "C" void kernel_launch(void* const* d_in, const int* in_sizes, int n_in, void* d_out, int out_size, void* d_ws, size_t ws_size, hipStream_t stream) {
    static int grid = 0;
    if (grid == 0) {
        if (n_in != 29 || out_size != T * DM || ws_size < WS_END) { fprintf(stderr, "kernel_launch: unexpected shapes (n_in %d out %d ws %zu, need %zu)\n", n_in, out_size, ws_size, (size_t)WS_END); grid = -1; return; }
        int dev = 0, cus = 0;
        if (hipGetDevice(&dev) != hipSuccess || hipDeviceGetAttribute(&cus, hipDeviceAttributeMultiprocessorCount, dev) != hipSuccess || cus <= 0) cus = 256;
        if (hipFuncSetAttribute((const void*)fwd, hipFuncAttributeMaxDynamicSharedMemorySize, LDS_BYTES) != hipSuccess) fprintf(stderr, "kernel_launch: hipFuncSetAttribute failed\n");
        grid = cus & ~7;
        if (grid < 8) grid = 8;
    }
    if (grid < 0) return;
    (void)in_sizes;
    (void)hipMemsetAsync((char*)d_ws + WS_CTL, 0, CTL_BYTES, stream);
    Args a{};
    for (int i = 0; i < 29; ++i) a.in[i] = d_in[i];
    a.out = (float*)d_out; a.ws = (unsigned char*)d_ws;
    hipLaunchKernelGGL(fwd, dim3(grid), dim3(NTHREADS), LDS_BYTES, stream, a);
}
```

```cpp
#include <hip/hip_runtime.h>
#include <cstdio>
#include <cstdint>
#ifndef CV_MODE
#define CV_MODE 0
#endif

#define LAS __attribute__((address_space(3)))
typedef unsigned short bf16;
typedef short bf16x8 __attribute__((ext_vector_type(8)));
typedef float f32x4 __attribute__((ext_vector_type(4)));
typedef unsigned u32x4 __attribute__((ext_vector_type(4)));
typedef unsigned u32x2 __attribute__((ext_vector_type(2)));

constexpr int T = 16384, DM = 2048, NB = 4, SEQ = 4096, NH = 16;
constexpr int NEXP = 64, DEXP = 512;
constexpr float EPS = 1e-6f;
constexpr int NTHREADS = 512, NWAVES = 8;

constexpr size_t MiB = 1u << 20;
constexpr size_t WS_CTL = 0, CTL_BYTES = 1 * MiB;
constexpr size_t WS_W_IN0T = 1 * MiB;
constexpr size_t WS_W_UQT = WS_W_IN0T + 5 * MiB;
constexpr size_t WS_W_UKVT = WS_W_UQT + 3 * MiB;
constexpr size_t WS_W_O0T = WS_W_UKVT + 4 * MiB;
constexpr size_t WS_W_IN1T = WS_W_O0T + 8 * MiB;
constexpr size_t WS_W_O1T = WS_W_IN1T + 33 * MiB;
constexpr size_t WS_W_GUT = WS_W_O1T + 8 * MiB;
constexpr size_t WS_W_DT = WS_W_GUT + 256 * MiB;
constexpr size_t WS_HN = WS_W_DT + 128 * MiB;
constexpr size_t WS_Z = WS_HN + 64 * MiB;
constexpr size_t WS_CQN = WS_Z + 256 * MiB;
constexpr size_t WS_CKVN = WS_CQN + 16 * MiB;
constexpr size_t WS_KR = WS_CKVN + 16 * MiB;
constexpr size_t WS_Q = WS_KR + 2 * MiB;
constexpr size_t WS_K = WS_Q + 96 * MiB;
constexpr size_t WS_V = WS_K + 96 * MiB;
constexpr size_t WS_O = WS_V + 64 * MiB;
constexpr size_t WS_H1 = WS_O + 64 * MiB;
constexpr size_t WS_RL = WS_H1 + 128 * MiB;
constexpr size_t WS_SSQ = WS_RL, WS_RSL = WS_RL + 2 * MiB;
constexpr size_t WS_TOK = WS_RL + 8 * MiB;
constexpr size_t WS_GATE = WS_TOK + 4 * MiB;
constexpr size_t WS_TSLOT = WS_GATE + 4 * MiB;
constexpr size_t WS_ACT = WS_TSLOT + 1 * MiB;
constexpr size_t WS_YS = WS_ACT + 48 * MiB;
constexpr size_t WS_FLOG = WS_YS + 192 * MiB;
constexpr size_t WS_C = WS_FLOG + 1 * MiB;
constexpr size_t WS_QL = WS_C + 1 * MiB;
constexpr size_t WS_KVL = WS_QL + 96 * MiB;
constexpr size_t WS_SK = WS_KVL + 128 * MiB;
constexpr size_t WS_PK = WS_SK + 4 * MiB;
constexpr size_t WS_PF = WS_PK + 16 * MiB;
constexpr size_t WS_PR = WS_PF + 4 * MiB;
constexpr size_t WS_END = WS_PR + 20 * MiB;
constexpr int CW_CNT0 = 1024, CW_CNT1 = 2048;
constexpr int CW_BAR = 4096;
constexpr int LDS_BARW = 155 * 1024, LDS_TS = LDS_BARW + 64, LDS_CN = LDS_BARW + 64 + 272, LDS_TE = LDS_BARW + 64 + 272 + 256, LDS_XS = LDS_BARW + 64 + 272 + 256 + 192, LDS_BYTES = 156 * 1024;

__device__ __forceinline__ float bf2f(unsigned b) { return __uint_as_float(b << 16); }
__device__ __forceinline__ unsigned f2bf(float f) { unsigned u = __float_as_uint(f); return (u + 0x7fffu + ((u >> 16) & 1u)) >> 16; }
__device__ __forceinline__ unsigned pk2(float lo, float hi) { unsigned r; asm("v_cvt_pk_bf16_f32 %0, %1, %2" : "=v"(r) : "v"(lo), "v"(hi)); return r; }
__device__ __forceinline__ float wave_sum(float v) {
#pragma unroll
    for (int o = 1; o < 64; o <<= 1) v += __shfl_xor(v, o);
    return v;
}
__device__ __forceinline__ float wave_max(float v) {
#pragma unroll
    for (int o = 1; o < 64; o <<= 1) v = fmaxf(v, __shfl_xor(v, o));
    return v;
}
__device__ __forceinline__ int otid() { int t = threadIdx.x; asm volatile("" : "+v"(t)); return t; }
__device__ __forceinline__ int obid() { int t = blockIdx.x; asm volatile("" : "+s"(t)); return t; }
__device__ __forceinline__ int ogrid() { int t = gridDim.x; asm volatile("" : "+s"(t)); return t; }
__device__ __forceinline__ float rsq(float x) { return 1.0f / sqrtf(x); }
__device__ __forceinline__ float rope64(float xn, int lane, float pos) {
    const float partner = __shfl_xor(xn, 32);
    const int i = lane & 31;
    const float freq = exp2f(-(float)i * (13.287712379549449f / 32.0f));
    const float ang = pos * freq;
    float rev = ang * 0.15915494309189535f; rev -= floorf(rev);
    const float s = __builtin_amdgcn_sinf(rev), c = __builtin_amdgcn_cosf(rev);
    return lane < 32 ? xn * c - partner * s : xn * c + partner * s;
}

enum { B_N_F32 = 0, B_N_BF16 = 1, B_T_BF16 = 2 };
template <int BMODE, class AP, class BP, class EP>
__device__ __forceinline__ void sg_tile(LAS unsigned char* lds, const AP& ap, const BP& bp, const EP& ep, int kbeg, int kend) {
    const int tid = otid(), wave = tid >> 6, lane = tid & 63, fr = lane & 15, fq = lane >> 4, wm = wave >> 2, wn = wave & 3;
    LAS bf16* sA = (LAS bf16*)lds; LAS bf16* sB = sA + 128 * 40;
    const bf16* pa = ap.row(tid >> 2) + (tid & 3) * 8;
    const int chunk = tid & 15, kk = tid >> 4;
    const bf16* pbt = nullptr; const float* pbf = nullptr; const bf16* pbh = nullptr; int ldb = 0;
    if constexpr (BMODE == B_T_BF16) { pbt = bp.row(tid >> 2); if (pbt) pbt += (tid & 3) * 8; }
    else if constexpr (BMODE == B_N_F32) { pbf = bp.col8(chunk, ldb); }
    else { pbh = bp.col8(chunk, ldb); }
    f32x4 acc[4][2];
#pragma unroll
    for (int mi = 0; mi < 4; ++mi)
#pragma unroll
        for (int ni = 0; ni < 2; ++ni) acc[mi][ni] = (f32x4){0.f, 0.f, 0.f, 0.f};
    for (int k0 = kbeg; k0 < kend; k0 += 32) {
        const u32x4 ra = *(const u32x4*)(pa + k0);
        u32x4 rb = (u32x4){0u, 0u, 0u, 0u};
        if constexpr (BMODE == B_T_BF16) { if (pbt) rb = *(const u32x4*)(pbt + k0); }
        else if constexpr (BMODE == B_N_F32) {
            if (pbf) { const float* p = pbf + (size_t)(k0 + kk) * ldb; const f32x4 x = *(const f32x4*)p, y = *(const f32x4*)(p + 4);
                rb = (u32x4){pk2(x[0], x[1]), pk2(x[2], x[3]), pk2(y[0], y[1]), pk2(y[2], y[3])}; }
        } else { if (pbh) rb = *(const u32x4*)(pbh + (size_t)(k0 + kk) * ldb); }
        __syncthreads();
        *(LAS u32x4*)(sA + (tid >> 2) * 40 + (tid & 3) * 8) = ra;
        if constexpr (BMODE == B_T_BF16) { *(LAS u32x4*)(sB + (tid >> 2) * 40 + (tid & 3) * 8) = rb; }
        else {
#pragma unroll
            for (int j = 0; j < 8; ++j) sB[(chunk * 8 + j) * 40 + kk] = (bf16)((rb[j >> 1] >> ((j & 1) * 16)) & 0xffffu);
        }
        __syncthreads();
        bf16x8 a[4], b[2];
#pragma unroll
        for (int mi = 0; mi < 4; ++mi) a[mi] = *(const LAS bf16x8*)(sA + (wm * 64 + mi * 16 + fr) * 40 + fq * 8);
#pragma unroll
        for (int ni = 0; ni < 2; ++ni) b[ni] = *(const LAS bf16x8*)(sB + (wn * 32 + ni * 16 + fr) * 40 + fq * 8);
#pragma unroll
        for (int mi = 0; mi < 4; ++mi)
#pragma unroll
            for (int ni = 0; ni < 2; ++ni) acc[mi][ni] = __builtin_amdgcn_mfma_f32_16x16x32_bf16(b[ni], a[mi], acc[mi][ni], 0, 0, 0);
    }
#pragma unroll
    for (int mi = 0; mi < 4; ++mi) ep(wm * 64 + mi * 16 + fr, wn * 32 + 4 * fq, acc[mi][0], acc[mi][1]);
}

struct APlain { const bf16* A; size_t lda; __device__ __forceinline__ const bf16* row(int r) const { return A + (size_t)r * lda; } };
struct BPlainF32 { const float* B; int ldb_, ncols; int n0;
    __device__ __forceinline__ const float* col8(int chunk, int& ldb) const { ldb = ldb_; const int c = n0 + chunk * 8; return c < ncols ? B + c : nullptr; } };
struct BPlainBf16 { const bf16* B; int ldb_;
    __device__ __forceinline__ const bf16* col8(int chunk, int& ldb) const { ldb = ldb_; return B + chunk * 8; } };
struct BRowsT { const bf16* Bt; size_t ld; __device__ __forceinline__ const bf16* row(int r) const { return Bt + (size_t)r * ld; } };

__device__ __forceinline__ void store4bf(bf16* p, f32x4 v) { *(u32x2*)p = (u32x2){pk2(v[0], v[1]), pk2(v[2], v[3])}; }
__device__ __forceinline__ void store8bf(bf16* p, f32x4 a, f32x4 b) { *(u32x4*)p = (u32x4){pk2(a[0], a[1]), pk2(a[2], a[3]), pk2(b[0], b[1]), pk2(b[2], b[3])}; }

struct EpBf16 { bf16* C; size_t ldc; int n0, N;
    __device__ __forceinline__ void operator()(int rl, int cl, f32x4 v0, f32x4 v1) const {
        bf16* p = C + (size_t)rl * ldc; const int c = n0 + cl;
        if (c < N) store4bf(p + c, v0);
        if (c + 16 < N) store4bf(p + c + 16, v1); } };
struct EpResF32 { const float* R; float* C; int n0;
    __device__ __forceinline__ void operator()(int rl, int cl, f32x4 v0, f32x4 v1) const {
        const size_t o = (size_t)rl * DM + n0 + cl;
        *(f32x4*)(C + o) = *(const f32x4*)(R + o) + v0; *(f32x4*)(C + o + 16) = *(const f32x4*)(R + o + 16) + v1; } };


#define XB_TMO      128
#define XB_XCNT(j)  (256  + 64 * (j))
#define XB_XSUB(j)  (1280 + 64 * (j))
#define XB_XGEN(j)  (2304 + 64 * (j))
#define XB_TOP      3328
#define XB_TOPGEN   3392
#define XCD_BAR_WORDS 3456
#define XB_SPIN_CAP (1u << 18)

__device__ __forceinline__ unsigned xb_ld(unsigned* p)              { return __hip_atomic_load(p, __ATOMIC_RELAXED, __HIP_MEMORY_SCOPE_AGENT); }
__device__ __forceinline__ unsigned xb_add(unsigned* p, unsigned v) { return __hip_atomic_fetch_add(p, v, __ATOMIC_RELAXED, __HIP_MEMORY_SCOPE_AGENT); }
__device__ __forceinline__ unsigned xb_xcc_id() { return (unsigned)__builtin_amdgcn_s_getreg((3 << 11) | 20) & 0xFu; }
#define XB_SPIN(cond, bar) do { unsigned _sp = 0; while (cond) { __builtin_amdgcn_s_sleep(1); \
    if ((++_sp & 255u) == 0u) { if (xb_ld(&(bar)[XB_TMO])) break; if (_sp > XB_SPIN_CAP) { atomicAdd(&(bar)[XB_TMO], 1u); break; } } } } while (0)

struct XcdBarrier {
    unsigned* bar; unsigned x;
    volatile LAS unsigned* st;
};

__device__ __forceinline__ XcdBarrier xcd_barrier_post(unsigned* bar, volatile LAS unsigned* st) {
    XcdBarrier b; b.bar = bar; b.x = xb_xcc_id(); b.st = st;
    if (threadIdx.x == 0) (void)xb_add(&bar[XB_XCNT(b.x)], 1u);
    return b;
}
__device__ __forceinline__ void xcd_barrier_complete(unsigned* bar, unsigned x, unsigned& nloc, unsigned& nx) {
    const unsigned G = gridDim.x * gridDim.y * gridDim.z;
    unsigned sum, cnt, mine, sp = 0u;
    for (;;) {
        sum = 0u; cnt = 0u; mine = 0u;
#pragma unroll
        for (unsigned j = 0; j < 16; ++j) { const unsigned c = xb_ld(&bar[XB_XCNT(j)]); sum += c; cnt += (c > 0u) ? 1u : 0u; mine = (j == x) ? c : mine; }
        if (sum == G) break;
        __builtin_amdgcn_s_sleep(1);
        if ((++sp & 255u) == 0u) { if (xb_ld(&bar[XB_TMO])) break; if (sp > XB_SPIN_CAP) { atomicAdd(&bar[XB_TMO], 1u); break; } }
    }
    nloc = mine > 0u ? mine : 1u; nx = cnt > 0u ? cnt : 1u;
}

__device__ __forceinline__ void xcd_barrier(const XcdBarrier& b) {
    asm volatile("s_waitcnt vmcnt(0)" ::: "memory");
    __syncthreads();
    if (threadIdx.x == 0) {
        unsigned* bar = b.bar;
        __builtin_amdgcn_s_waitcnt(0);
        unsigned nloc = b.st[0], nx = b.st[1];
        if (nloc == 0u) { xcd_barrier_complete(bar, b.x, nloc, nx); b.st[0] = nloc; b.st[1] = nx; }
        const unsigned old = xb_add(&bar[XB_XSUB(b.x)], 1u);
        const unsigned gen = old / nloc;
        if (old + 1u == (gen + 1u) * nloc) {
            __builtin_amdgcn_fence(__ATOMIC_RELEASE, "agent");
            asm volatile("s_waitcnt vmcnt(0)" ::: "memory");
            const unsigned og = xb_add(&bar[XB_TOP], 1u);
            const unsigned tg = og / nx;
            if (og + 1u == (tg + 1u) * nx) xb_add(&bar[XB_TOPGEN], 1u);
            else XB_SPIN(xb_ld(&bar[XB_TOPGEN]) == tg, bar);
            __builtin_amdgcn_fence(__ATOMIC_ACQUIRE, "agent");
            xb_add(&bar[XB_XGEN(b.x)], 1u);
            asm volatile("s_waitcnt vmcnt(0)" ::: "memory");
        } else {
            XB_SPIN(xb_ld(&bar[XB_XGEN(b.x)]) == gen, bar);
            __builtin_amdgcn_fence(__ATOMIC_ACQUIRE, "agent");
            asm volatile("s_waitcnt vmcnt(0)" ::: "memory");
        }
    }
    __syncthreads();
}

namespace fg {
constexpr int BM = 256, BK = 64, HALF = 128, HTB = HALF * BK * 2, STAGE_BYTES = 8 * HTB;
__host__ __device__ __forceinline__ int lds_byte(int r, int c) { const int st = (r >> 4) * 2 + (c >> 5), rr = r & 15, cc = c & 31, ob = rr * 64 + cc * 2; return st * 1024 + (ob ^ (((ob >> 9) & 1) << 5)); }
__host__ __device__ __forceinline__ void stage_rc(int b, int& R, int& C) { const int st = b / 1024, sb = b % 1024, swz = sb ^ (((sb >> 9) & 1) << 5); R = (st >> 1) * 16 + swz / 64; C = (st & 1) * 32 + (swz % 64) / 2; }

template <bool GATHER, class Unit, class Epi, class Sched>
__device__ __forceinline__ void gemm_phase(LAS unsigned char* lds, const int K, const Sched& S, const Epi& E) {
    const int tid = otid(), wid = __builtin_amdgcn_readfirstlane(tid >> 6), lane = tid & 63, wr = wid >> 2, wc = wid & 3, fr = lane & 15, fq = lane >> 4;
    const int nt = K / BK;
    int R0, C0, R1, C1; stage_rc(tid * 16, R0, C0); stage_rc(tid * 16 + 8192, R1, C1);
    const int Rb0 = (R0 & ~31) + 8 * ((R0 & 15) >> 2) + 4 * ((R0 >> 4) & 1) + (R0 & 3), Rb1 = (R1 & ~31) + 8 * ((R1 & 15) >> 2) + 4 * ((R1 >> 4) & 1) + (R1 & 3);
    const unsigned voffB0 = (unsigned)(Rb0 * K + C0) * 2u, voffB1 = (unsigned)(Rb1 * K + C1) * 2u;
    const size_t kstep = (size_t)(BK * 2);
    const size_t hstepB = (size_t)HALF * K * 2;
    const unsigned ldsw = (unsigned)wid * 1024u;
    const int aoff = lds_byte(wr * 64 + fr, fq * 8), boff = lds_byte(wc * 32 + fr, fq * 8);
#define FG_SA(b, h) (((b) * 2 + (h)) * HTB)
#define FG_SB(b, h) ((4 + (b) * 2 + (h)) * HTB)
#define FG_STAGE(bufoff, gbase, v0, v1) do { \
        __builtin_amdgcn_global_load_lds((const unsigned*)((const char*)(gbase) + (v0)), (LAS unsigned*)(lds + (bufoff) + ldsw), 16, 0, 0); \
        __builtin_amdgcn_global_load_lds((const unsigned*)((const char*)(gbase) + (v1)), (LAS unsigned*)(lds + (bufoff) + ldsw + 8192), 16, 0, 0); } while (0)
#define FG_LDA(dst, b, h) do { _Pragma("unroll") for (int m = 0; m < 4; ++m) _Pragma("unroll") for (int k = 0; k < 2; ++k) dst[m][k] = *(const LAS bf16x8*)(lds + FG_SA(b, h) + aoff + m * 2048 + k * 1024); } while (0)
#define FG_LDB(dst, b, h) do { _Pragma("unroll") for (int n = 0; n < 2; ++n) _Pragma("unroll") for (int k = 0; k < 2; ++k) dst[n][k] = *(const LAS bf16x8*)(lds + FG_SB(b, h) + boff + n * 2048 + k * 1024); } while (0)
#define FG_MMA(ai, bj, At, Bt) do { __builtin_amdgcn_s_setprio(1); _Pragma("unroll") for (int m = 0; m < 4; ++m) _Pragma("unroll") for (int n = 0; n < 2; ++n) _Pragma("unroll") for (int k = 0; k < 2; ++k) \
        acc[ai][bj][m][n] = __builtin_amdgcn_mfma_f32_16x16x32_bf16(Bt[n][k], At[m][k], acc[ai][bj][m][n], 0, 0, 0); __builtin_amdgcn_s_setprio(0); } while (0)
#define FG_WAIT_V(n) asm volatile("s_waitcnt vmcnt(" #n ")" ::: "memory")
#define FG_WAIT_L(n) asm volatile("s_waitcnt lgkmcnt(" #n ")" ::: "memory")
#define FG_BAR __builtin_amdgcn_s_barrier()
#define FG_SCHED __builtin_amdgcn_sched_barrier(0)
    Unit cur, nxt; int ui = 0;
    if (!S.next(0, cur)) return;
    f32x4 acc[2][2][4][2];
#pragma unroll
    for (int a = 0; a < 2; ++a)
#pragma unroll
        for (int b = 0; b < 2; ++b)
#pragma unroll
            for (int m = 0; m < 4; ++m)
#pragma unroll
                for (int n = 0; n < 2; ++n) acc[a][b][m][n] = (f32x4){0.f, 0.f, 0.f, 0.f};
    bf16x8 At[4][2], B0[2][2], B1[2][2];
    const char* cA = S.a_base(cur); const char* cB = S.b_base(cur);
    unsigned vA00 = S.a_voff(cur, R0, C0), vA01 = S.a_voff(cur, R1, C1), vA10 = S.a_voff(cur, HALF + R0, C0), vA11 = S.a_voff(cur, HALF + R1, C1);
    unsigned vN00 = vA00, vN01 = vA01, vN10 = vA10, vN11 = vA11;
    bool hi_on = !S.lo_only(cur);
    FG_STAGE(FG_SB(0, 0), cB, voffB0, voffB1); FG_STAGE(FG_SB(0, 1), cB + hstepB, voffB0, voffB1); FG_STAGE(FG_SA(0, 0), cA, vA00, vA01); FG_STAGE(FG_SA(0, 1), cA, vA10, vA11);
    if (wr == 1) FG_BAR;
    FG_WAIT_V(2); FG_BAR;
    FG_STAGE(FG_SB(1, 0), cB + kstep, voffB0, voffB1); FG_STAGE(FG_SA(1, 0), cA + kstep, vA00, vA01); FG_STAGE(FG_SB(1, 1), cB + hstepB + kstep, voffB0, voffB1);
    FG_WAIT_V(6); FG_BAR;
    for (;;) {
        const bool has_next = S.next(ui + 1, nxt);
        const char* nA = has_next ? S.a_base(nxt) : cA; const char* nB = has_next ? S.b_base(nxt) : cB;
        if (GATHER) { if (has_next) { vN00 = S.a_voff(nxt, R0, C0); vN01 = S.a_voff(nxt, R1, C1); vN10 = S.a_voff(nxt, HALF + R0, C0); vN11 = S.a_voff(nxt, HALF + R1, C1); }
                      else { vN00 = vA00; vN01 = vA01; vN10 = vA10; vN11 = vA11; } }
        for (int t = 0; t < nt; t += 2) {
            const bool last = (t == nt - 2);
            const char* a1 = cA + (size_t)(t + 1) * kstep;
            const char* a2 = last ? nA : cA + (size_t)(t + 2) * kstep; const char* b2 = last ? nB : cB + (size_t)(t + 2) * kstep;
            const char* a3 = a2 + kstep; const char* b3 = b2 + kstep;
            const unsigned x00 = (GATHER && last) ? vN00 : vA00, x01 = (GATHER && last) ? vN01 : vA01, x10 = (GATHER && last) ? vN10 : vA10, x11 = (GATHER && last) ? vN11 : vA11;
            FG_LDB(B0, 0, 0); FG_LDB(B1, 0, 1); FG_SCHED; FG_LDA(At, 0, 0); FG_STAGE(FG_SA(1, 1), a1, vA10, vA11);
            FG_WAIT_V(8); FG_WAIT_L(0); FG_BAR; FG_MMA(0, 0, At, B0); FG_MMA(0, 1, At, B1); FG_BAR; FG_SCHED;
            FG_LDA(At, 0, 1); FG_STAGE(FG_SB(0, 0), b2, voffB0, voffB1); FG_STAGE(FG_SB(0, 1), b2 + hstepB, voffB0, voffB1); FG_STAGE(FG_SA(0, 0), a2, x00, x01);
            FG_WAIT_V(8); FG_WAIT_L(0); FG_BAR; if (hi_on) { FG_MMA(1, 0, At, B0); FG_MMA(1, 1, At, B1); } FG_BAR; FG_SCHED;
            FG_LDB(B0, 1, 0); FG_LDB(B1, 1, 1); FG_SCHED; FG_LDA(At, 1, 0); FG_STAGE(FG_SA(0, 1), a2, x10, x11);
            FG_WAIT_V(8); FG_WAIT_L(0); FG_BAR; FG_MMA(0, 0, At, B0); FG_MMA(0, 1, At, B1); FG_BAR; FG_SCHED;
            FG_LDA(At, 1, 1); FG_STAGE(FG_SB(1, 0), b3, voffB0, voffB1); FG_STAGE(FG_SB(1, 1), b3 + hstepB, voffB0, voffB1); FG_STAGE(FG_SA(1, 0), a3, x00, x01);
            FG_WAIT_V(8); FG_WAIT_L(0); FG_BAR; if (hi_on) { FG_MMA(1, 0, At, B0); FG_MMA(1, 1, At, B1); } FG_BAR; FG_SCHED;
        }
        if (wr == 0) FG_BAR;
        { int tz = threadIdx.x; asm volatile("" : "+v"(tz));
          const int lz = tz & 63; E(acc, cur, (tz >> 6) >> 2, (tz >> 6) & 3, lz & 15, lz >> 4); }
        if (!has_next) break;
#pragma unroll
        for (int a = 0; a < 2; ++a)
#pragma unroll
            for (int b = 0; b < 2; ++b)
#pragma unroll
                for (int m = 0; m < 4; ++m)
#pragma unroll
                    for (int n = 0; n < 2; ++n) acc[a][b][m][n] = (f32x4){0.f, 0.f, 0.f, 0.f};
        cur = nxt; cA = nA; cB = nB; ++ui; hi_on = !S.lo_only(cur);
        if (GATHER) { vA00 = vN00; vA01 = vN01; vA10 = vN10; vA11 = vN11; }
        if (wr == 1) FG_BAR;
    }
    FG_WAIT_V(0);
    FG_BAR;
#undef FG_SA
#undef FG_SB
#undef FG_STAGE
#undef FG_LDA
#undef FG_LDB
#undef FG_MMA
#undef FG_WAIT_V
#undef FG_WAIT_L
#undef FG_BAR
#undef FG_SCHED
}

struct DUnit { int p, pm, pn, par; };
struct DenseSched {
    const bf16* A0; const bf16* B0; int nN0; const bf16* A1; const bf16* B1; int nN1; int K, G, c;
    static constexpr int nM = T / 256, NXCD = 8, WGM = 8;
    __device__ __forceinline__ bool next(int i, DUnit& u) const {
        long L = (long)i * G + c; const int nwg0 = nM * nN0, nwg1 = nM * nN1;
        int nN, nwg; if (L < nwg0) { u.p = 0; nN = nN0; nwg = nwg0; } else { L -= nwg0; if (L >= nwg1) return false; u.p = 1; nN = nN1; nwg = nwg1; }
        int wgid = (int)L; { const int q = nwg / NXCD, r = nwg % NXCD, xcd = wgid % NXCD, off = wgid / NXCD; wgid = (xcd < r ? xcd * (q + 1) : r * (q + 1) + (xcd - r) * q) + off; }
        const int nig = WGM * nN, gid = wgid / nig, fm = gid * WGM, gsz = (nM - fm) < WGM ? (nM - fm) : WGM;
        u.pm = fm + ((wgid % nig) % gsz); u.pn = (wgid % nig) / gsz; u.par = i & 1; return true;
    }
    __device__ __forceinline__ const char* a_base(const DUnit& u) const { return (const char*)(u.p ? A1 : A0) + (size_t)u.pm * 256 * K * 2; }
    __device__ __forceinline__ const char* b_base(const DUnit& u) const { return (const char*)(u.p ? B1 : B0) + (size_t)u.pn * 256 * K * 2; }
    __device__ __forceinline__ unsigned a_voff(const DUnit&, int row, int col) const { return (unsigned)(row * K + col) * 2u; }
    __device__ __forceinline__ bool lo_only(const DUnit&) const { return false; }
};
struct SkUnit { int pm, ks; };
struct SkinnySched {
    const char* A; const char* B; int G, c;
    __device__ __forceinline__ bool next(int i, SkUnit& u) const { const int L = i * G + c; if (L >= (T / 256) * 4) return false; u.pm = L >> 2; u.ks = L & 3; return true; }
    __device__ __forceinline__ const char* a_base(const SkUnit& u) const { return A + ((size_t)u.pm * 256 * DM + u.ks * 512) * 2; }
    __device__ __forceinline__ const char* b_base(const SkUnit& u) const { return B + (size_t)u.ks * 256 * 512 * 2; }
    __device__ __forceinline__ unsigned a_voff(const SkUnit&, int row, int col) const { return (unsigned)(row * DM + col) * 2u; }
    __device__ __forceinline__ bool lo_only(const SkUnit&) const { return false; }
};
#define FG_FOREACH(acc, BODY) do { _Pragma("unroll") for (int ai = 0; ai < 2; ++ai) _Pragma("unroll") for (int m = 0; m < 4; ++m) { const int row = ai * 128 + wr * 64 + m * 16 + fr; \
        _Pragma("unroll") for (int bj = 0; bj < 2; ++bj) { const int col = bj * 128 + wc * 32 + 8 * fq; const f32x4 v0 = acc[ai][bj][m][0], v1 = acc[ai][bj][m][1]; BODY } } } while (0)
}

template <class RowMap>
__device__ __forceinline__ void transpose_item(const float* W, int K, int N, bf16* WT, const RowMap& rowmap, LAS float* scr, int item, int lane) {
    const int nblk = (N + 31) / 32, kb = item / nblk, nb = item % nblk, k0 = 64 * kb, n0 = 32 * nb; const bool cv = n0 + (lane & 31) < N;
#pragma unroll 8
    for (int i = 0; i < 32; ++i) { const int kk = 2 * i + (lane >> 5); scr[kk * 33 + (lane & 31)] = cv ? W[(size_t)(k0 + kk) * N + n0 + (lane & 31)] : 0.f; }
    asm volatile("s_waitcnt lgkmcnt(0)" ::: "memory");
    const int c = lane & 7;
#pragma unroll
    for (int j = 0; j < 4; ++j) { const int n = (lane >> 3) + 8 * j; const LAS float* sp = scr + (8 * c) * 33 + n;
        u32x4 o; o.x = pk2(sp[0 * 33], sp[1 * 33]); o.y = pk2(sp[2 * 33], sp[3 * 33]); o.z = pk2(sp[4 * 33], sp[5 * 33]); o.w = pk2(sp[6 * 33], sp[7 * 33]);
        const int dr = rowmap(n0 + n);
        if (dr >= 0) *(u32x4*)(WT + (size_t)dr * K + k0 + 8 * c) = o; }
    asm volatile("s_waitcnt lgkmcnt(0)" ::: "memory");
}
template <class RowMap>
__device__ __forceinline__ void transpose_item16(const float* W, int K, int N, bf16* WT, const RowMap& rowmap, LAS unsigned char* scr, int item, int lane) {
    const int nblk = (N + 31) / 32, kb = item / nblk, nb = item % nblk, k0 = 64 * kb, n0 = 32 * nb, c = lane & 7, rr = lane >> 3; const bool cv = n0 + 4 * c < N;
    f32x4 v[8];
#pragma unroll
    for (int i = 0; i < 8; ++i) v[i] = cv ? __builtin_nontemporal_load((const f32x4*)(W + (size_t)(k0 + 8 * i + rr) * N + n0 + 4 * c)) : (f32x4){0.f, 0.f, 0.f, 0.f};
#pragma unroll
    for (int i = 0; i < 8; ++i) *(LAS f32x4*)(scr + (8 * i + rr) * 128 + ((c ^ i) << 4)) = v[i];
    asm volatile("s_waitcnt lgkmcnt(0)" ::: "memory");
    float t[4][8];
#pragma unroll
    for (int j = 0; j < 4; ++j) { const int n = rr + 8 * j; const LAS float* sp = (const LAS float*)scr + (8 * c) * 32 + (((n >> 2) ^ c) << 2) + (n & 3);
#pragma unroll
        for (int q = 0; q < 8; ++q) t[j][q] = sp[32 * q]; }
    asm volatile("s_waitcnt lgkmcnt(0)" ::: "memory");
#pragma unroll
    for (int j = 0; j < 4; ++j) { const int n = rr + 8 * j, dr = rowmap(n0 + n);
        if (dr >= 0) *(u32x4*)(WT + (size_t)dr * K + k0 + 8 * c) = (u32x4){pk2(t[j][0], t[j][1]), pk2(t[j][2], t[j][3]), pk2(t[j][4], t[j][5]), pk2(t[j][6], t[j][7])}; }
}
__device__ __forceinline__ void zero_rows(bf16* WT, int K, int r0, int r1, int gw, int ngw, int lane) {
    const size_t n8 = (size_t)(r1 - r0) * K / 8; u32x4* p = (u32x4*)(WT + (size_t)r0 * K);
    for (size_t i = (size_t)gw * 64 + lane; i < n8; i += (size_t)ngw * 64) p[i] = (u32x4){0u, 0u, 0u, 0u};
}

struct Args { const void* in[29]; float* out; unsigned char* ws; };
__device__ __forceinline__ int hide(int i) { asm volatile("" : "+s"(i)); return i; }
__device__ __forceinline__ const void* arg_ptr(int i) {
    typedef const void* cvp;
    const __attribute__((address_space(4))) cvp* ka = (const __attribute__((address_space(4))) cvp*)__builtin_amdgcn_kernarg_segment_ptr();
    return ka[hide(i)];
}
#define INF(i) ((const float*)arg_ptr(i))
#define PH_BEGIN unsigned char* ws = (unsigned char*)arg_ptr(30); \
    const int tid = otid(), lane = tid & 63, wave = tid >> 6, G = ogrid(), bx = obid(), gw = bx * NWAVES + wave, ngw = G * NWAVES; (void)lane; (void)gw; (void)ngw; (void)ws
#define WSP(TYPE, OFF) ((TYPE*)(ws + (OFF)))

__device__ __forceinline__ void unpack8(u32x4 w, float (&x)[8]) {
#pragma unroll
    for (int j = 0; j < 4; ++j) { x[2 * j] = bf2f(w[j] & 0xffffu); x[2 * j + 1] = bf2f(w[j] >> 16); }
}
__device__ __forceinline__ f32x4 bf4(u32x2 w) { return (f32x4){bf2f(w[0] & 0xffffu), bf2f(w[0] >> 16), bf2f(w[1] & 0xffffu), bf2f(w[1] >> 16)}; }

__device__ __forceinline__ void moe_prefix(LAS unsigned char* lds, const unsigned* cnt) {
    LAS int* s_ts = (LAS int*)(lds + LDS_TS); LAS int* s_cn = (LAS int*)(lds + LDS_CN);
    LAS unsigned char* s_te = lds + LDS_TE;
    LAS int* s_xs = (LAS int*)(lds + LDS_XS);
    if (otid() == 0) { int acc = 0; for (int e = 0; e < NEXP; ++e) { const int c = (int)cnt[e]; s_ts[e] = acc; s_cn[e] = c; const int nt = (c + 255) >> 8; for (int i = 0; i < nt; ++i) s_te[acc + i] = (unsigned char)e; acc += nt; } s_ts[NEXP] = acc;
        const int x = obid() & 7; int a2 = 0; for (int k = 0; k < 8; ++k) { s_xs[k] = a2; a2 += (s_cn[x + 8 * k] + 255) >> 8; } s_xs[8] = a2; }
    __syncthreads();
}

__device__ __forceinline__ void ph_convert_dense(LAS unsigned char* lds) {
    PH_BEGIN;
    LAS unsigned char* scr = lds + wave * 8192;
    const float* w_in0 = INF(3); const float* w_uq = INF(6); const float* w_ukv = INF(7); const float* w_o0 = INF(9); const float* w_in1 = INF(18); const float* w_o1 = INF(21);
    bf16* W_IN0T = WSP(bf16, WS_W_IN0T); bf16* W_UQT = WSP(bf16, WS_W_UQT); bf16* W_UKVT = WSP(bf16, WS_W_UKVT); bf16* W_O0T = WSP(bf16, WS_W_O0T); bf16* W_IN1T = WSP(bf16, WS_W_IN1T); bf16* W_O1T = WSP(bf16, WS_W_O1T);
    constexpr int I0 = 32 * 34, I1 = 8 * 96, I2 = 8 * 128, I3 = 32 * 64, I4 = 32 * 257, I5 = 32 * 64;
    auto ident = [](int n) { return n; };
    auto map0 = [](int n) { return n < 1024 ? n : -1; };
    auto map1 = [](int n) { return n < 6144 ? n : (n < 6160 ? -1 : (n < 8208 ? n - 16 : -1)); };
    for (int it = gw; it < I0 + I1 + I2 + I3 + I4 + I5; it += ngw) {
        int r = it;
        if (r < I0) { transpose_item16(w_in0, DM, 1088, W_IN0T, map0, scr, r, lane); continue; } r -= I0;
        if (r < I1) { transpose_item16(w_uq, 512, 3072, W_UQT, ident, scr, r, lane); continue; } r -= I1;
        if (r < I2) { transpose_item16(w_ukv, 512, 4096, W_UKVT, ident, scr, r, lane); continue; } r -= I2;
        if (r < I3) { transpose_item16(w_o0, DM, DM, W_O0T, ident, scr, r, lane); continue; } r -= I3;
        if (r < I4) { transpose_item16(w_in1, DM, 8208, W_IN1T, map1, scr, r, lane); continue; } r -= I4;
        transpose_item16(w_o1, DM, DM, W_O1T, ident, scr, r, lane);
    }
    { bf16* SK = WSP(bf16, WS_SK); const float* w_rg0 = INF(11); const float* w_re0 = INF(13); const float* w_rg1 = INF(23); const float* w_re1 = INF(25);
      for (int idx = bx * NTHREADS + tid; idx < 4 * 256 * 256; idx += G * NTHREADS) {
          const int set = idx >> 16, n = (idx >> 8) & 255, k = (idx & 255) * 8, ks = k >> 9;
          float v[8];
#pragma unroll
          for (int i = 0; i < 8; ++i) { float x = 0.f;
              if (set == 0) { if (n < 64) x = w_in0[(size_t)(k + i) * 1088 + 1024 + n]; }
              else if (set == 1) { if (n < 16) x = w_in1[(size_t)(k + i) * 8208 + 6144 + n]; }
              else { const float* wg = set == 2 ? w_rg0 : w_rg1; const float* we = set == 2 ? w_re0 : w_re1; if (n < 8) x = wg[(k + i) * 8 + n]; else if (n < 72) x = we[(k + i) * 64 + n - 8]; }
              v[i] = x; }
          *(u32x4*)(SK + (size_t)set * (4 * 256 * 512) + ((size_t)ks * 256 + n) * 512 + (k & 511)) = (u32x4){pk2(v[0], v[1]), pk2(v[2], v[3]), pk2(v[4], v[5]), pk2(v[6], v[7])}; } }
}
template <int layer>
__device__ __forceinline__ void ph_convert_moe(LAS unsigned char* lds) {
    PH_BEGIN;
    LAS float* scr = (LAS float*)(lds + wave * 8448);
    const float* w_gu = INF(layer == 0 ? 15 : 27); const float* w_dn = INF(layer == 0 ? 16 : 28);
    bf16* W_GUT = WSP(bf16, WS_W_GUT); bf16* W_DT = WSP(bf16, WS_W_DT);
    auto gumap = [](int n) { const int which = n >> 9, f = n & 511; return (f >> 7) * 256 + ((f >> 6) & 1) * 128 + ((f >> 4) & 3) * 32 + ((f >> 2) & 3) * 8 + which * 4 + (f & 3); };
    auto ident = [](int n) { return n; };
    constexpr int IG = 32 * 32, ID = 8 * 64;
    for (int it = gw; it < NEXP * (IG + ID); it += ngw) {
        if (it < NEXP * IG) { const int e = it / IG, r = it % IG; transpose_item(w_gu + (size_t)e * DM * 1024, DM, 1024, W_GUT + (size_t)e * 1024 * DM, gumap, scr, r, lane); }
        else { const int v = it - NEXP * IG, e = v / ID, r = v % ID; transpose_item(w_dn + (size_t)e * DEXP * DM, DEXP, DM, W_DT + (size_t)e * DM * DEXP, ident, scr, r, lane); }
    }
}

template <int MODE>
__device__ __forceinline__ void norm_rows(LAS unsigned char* lds, float* in, const float* gain, const unsigned* cnt) {
    PH_BEGIN;
    bf16* HN = WSP(bf16, WS_HN); const bf16* YS = WSP(bf16, WS_YS); const int* TSLOT = WSP(int, WS_TSLOT); bf16* H1b = WSP(bf16, WS_H1);
    if (MODE != 0) moe_prefix(lds, cnt);
    const LAS int* s_ts = (const LAS int*)(lds + LDS_TS);
    for (int m = gw; m < T; m += ngw) {
        float* xr = in + (size_t)m * DM + 8 * lane; bf16* hb = H1b + (size_t)m * DM + 8 * lane;
        f32x4 v[8]; float ss = 0.f;
        const bf16* y0 = nullptr; const bf16* y1 = nullptr;
        if (MODE != 0) { const int s0 = TSLOT[2 * m], s1 = TSLOT[2 * m + 1];
            y0 = YS + ((size_t)s_ts[s0 >> 16] * 256 + (s0 & 0xffff)) * DM + 8 * lane; y1 = YS + ((size_t)s_ts[s1 >> 16] * 256 + (s1 & 0xffff)) * DM + 8 * lane; }
#pragma unroll
        for (int jj = 0; jj < 4; ++jj) {
            if (MODE == 0) { v[2 * jj] = *(const f32x4*)(xr + 512 * jj); v[2 * jj + 1] = *(const f32x4*)(xr + 512 * jj + 4); }
            else { const u32x4 wh = *(const u32x4*)(hb + 512 * jj), wa = *(const u32x4*)(y0 + 512 * jj), wb = *(const u32x4*)(y1 + 512 * jj);
                v[2 * jj] = bf4((u32x2){wh[0], wh[1]}) + bf4((u32x2){wa[0], wa[1]}) + bf4((u32x2){wb[0], wb[1]});
                v[2 * jj + 1] = bf4((u32x2){wh[2], wh[3]}) + bf4((u32x2){wa[2], wa[3]}) + bf4((u32x2){wb[2], wb[3]});
                if (MODE == 1) store8bf(hb + 512 * jj, v[2 * jj], v[2 * jj + 1]);
                else { *(f32x4*)(xr + 512 * jj) = v[2 * jj]; *(f32x4*)(xr + 512 * jj + 4) = v[2 * jj + 1]; } }
#pragma unroll
            for (int e = 0; e < 2; ++e) { const f32x4 w = v[2 * jj + e]; ss += (w[0] * w[0] + w[1] * w[1]) + (w[2] * w[2] + w[3] * w[3]); } }
        if (MODE != 2) {
            ss = wave_sum(ss);
            const float r = rsq(ss * (1.0f / DM) + EPS);
#pragma unroll
            for (int jj = 0; jj < 4; ++jj) { const f32x4 g0 = *(const f32x4*)(gain + 8 * lane + 512 * jj), g1 = *(const f32x4*)(gain + 8 * lane + 512 * jj + 4);
                store8bf(HN + (size_t)m * DM + 8 * lane + 512 * jj, v[2 * jj] * r * g0, v[2 * jj + 1] * r * g1); }
        }
    }
}

template <int NC>
__device__ __forceinline__ void skinny_gemm(LAS unsigned char* lds, const bf16* HN, const bf16* SKset, float* P, int G, int bx) {
    fg::SkinnySched S{(const char*)HN, (const char*)SKset, G, bx};
    auto E = [=](const f32x4 (&acc)[2][2][4][2], const fg::SkUnit& u, int wr, int wc, int fr, int fq) {
        float* Pt = P + ((size_t)u.ks * T + (size_t)u.pm * 256) * NC;
        FG_FOREACH(acc, { if (col < NC) { *(f32x4*)(Pt + (size_t)row * NC + col) = v0; *(f32x4*)(Pt + (size_t)row * NC + col + 4) = v1; } }); };
    fg::gemm_phase<false, fg::SkUnit>(lds, 512, S, E);
}
constexpr int LDS_EPI_TAB = 131072;
template <int HMASK>
__device__ __forceinline__ void epi_head_rstd(LAS unsigned char* lds, const f32x4 (&acc)[2][2][4][2], int par, int wr, int wc, int fr, int fq, float (&rstd)[2][4][2]) {
    LAS float* tab = (LAS float*)(lds + LDS_EPI_TAB) + par * 2048;
#pragma unroll
    for (int ai = 0; ai < 2; ++ai)
#pragma unroll
        for (int m = 0; m < 4; ++m) { const int row = ai * 128 + wr * 64 + m * 16 + fr;
#pragma unroll
            for (int bj = 0; bj < 2; ++bj) if (HMASK & (1 << bj)) { const f32x4 a = acc[ai][bj][m][0], b = acc[ai][bj][m][1];
                float ss = (a[0] * a[0] + a[1] * a[1]) + (a[2] * a[2] + a[3] * a[3]) + (b[0] * b[0] + b[1] * b[1]) + (b[2] * b[2] + b[3] * b[3]);
                ss += __shfl_xor(ss, 16); ss += __shfl_xor(ss, 32);
                if (fq == 0) tab[(row * 2 + bj) * 4 + wc] = ss; } }
    asm volatile("s_waitcnt lgkmcnt(0)" ::: "memory"); __builtin_amdgcn_s_barrier(); asm volatile("" ::: "memory");
#pragma unroll
    for (int ai = 0; ai < 2; ++ai)
#pragma unroll
        for (int m = 0; m < 4; ++m) { const int row = ai * 128 + wr * 64 + m * 16 + fr;
#pragma unroll
            for (int bj = 0; bj < 2; ++bj) { rstd[ai][m][bj] = 1.f;
                if (HMASK & (1 << bj)) { const f32x4 t = *(const LAS f32x4*)(tab + (row * 2 + bj) * 4); rstd[ai][m][bj] = rsq(((t[0] + t[1]) + (t[2] + t[3])) * (1.0f / 128) + EPS); } } }
}
template <int layer>
__device__ __forceinline__ void ph_gemm_z(LAS unsigned char* lds) {
    PH_BEGIN;
    bf16* HN = WSP(bf16, WS_HN); bf16* Z = WSP(bf16, WS_Z);
    if (layer == 0) {
        fg::DenseSched S{HN, WSP(bf16, WS_W_IN0T), 4, nullptr, nullptr, 0, DM, G, bx};
        auto E = [=](const f32x4 (&acc)[2][2][4][2], const fg::DUnit& u, int wr, int wc, int fr, int fq) {
            bf16* Zt = Z + (size_t)u.pm * 256 * 1024 + u.pn * 256;
            FG_FOREACH(acc, { store8bf(Zt + (size_t)row * 1024 + col, v0, v1); }); };
        fg::gemm_phase<false, fg::DUnit>(lds, DM, S, E);
        skinny_gemm<64>(lds, HN, WSP(bf16, WS_SK), WSP(float, WS_PK), G, bx);
    } else {
        fg::DenseSched S{HN, WSP(bf16, WS_W_IN1T), 32, nullptr, nullptr, 0, DM, G, bx};
        const float* gk = INF(20) + 128;
        auto E = [=](const f32x4 (&acc)[2][2][4][2], const fg::DUnit& u, int wr, int wc, int fr, int fq) {
            bf16* Zt = Z + (size_t)u.pm * 256 * 8192 + u.pn * 256;
            if (u.pn < 8 || u.pn >= 16) { FG_FOREACH(acc, { store8bf(Zt + (size_t)row * 8192 + col, v0, v1); }); }
            else {
                float rstd[2][4][2]; epi_head_rstd<3>(lds, acc, u.par, wr, wc, fr, fq, rstd);
                const f32x4 g0 = *(const f32x4*)(gk + wc * 32 + 8 * fq), g1 = *(const f32x4*)(gk + wc * 32 + 8 * fq + 4);
#pragma unroll
                for (int ai = 0; ai < 2; ++ai)
#pragma unroll
                    for (int m = 0; m < 4; ++m) { const int row = ai * 128 + wr * 64 + m * 16 + fr;
#pragma unroll
                        for (int bj = 0; bj < 2; ++bj) { const float r = rstd[ai][m][bj];
                            store8bf(Zt + (size_t)row * 8192 + bj * 128 + wc * 32 + 8 * fq, acc[ai][bj][m][0] * r * g0, acc[ai][bj][m][1] * r * g1); } } } };
        fg::gemm_phase<false, fg::DUnit>(lds, DM, S, E);
        skinny_gemm<16>(lds, HN, WSP(bf16, WS_SK) + (size_t)1 * 4 * 256 * 512, WSP(float, WS_PF), G, bx);
    }
}
__device__ __forceinline__ void ph_gemm_qkv(LAS unsigned char* lds) {
    PH_BEGIN;
    bf16* QL = WSP(bf16, WS_QL); bf16* KVL = WSP(bf16, WS_KVL);
    fg::DenseSched S{WSP(bf16, WS_CQN), WSP(bf16, WS_W_UQT), 12, WSP(bf16, WS_CKVN), WSP(bf16, WS_W_UKVT), 16, 512, G, bx};
    const float* gk = INF(8) + 192;
    auto E = [=](const f32x4 (&acc)[2][2][4][2], const fg::DUnit& u, int wr, int wc, int fr, int fq) {
        if (u.p == 0) { bf16* Ct = QL + (size_t)u.pm * 256 * 3072 + u.pn * 256;
            FG_FOREACH(acc, { store8bf(Ct + (size_t)row * 3072 + col, v0, v1); }); }
        else {
            float rstd[2][4][2]; epi_head_rstd<1>(lds, acc, u.par, wr, wc, fr, fq, rstd);
            const f32x4 g0 = *(const f32x4*)(gk + wc * 32 + 8 * fq), g1 = *(const f32x4*)(gk + wc * 32 + 8 * fq + 4);
            bf16* Ct = KVL + (size_t)u.pm * 256 * 4096 + u.pn * 256 + wc * 32 + 8 * fq;
#pragma unroll
            for (int ai = 0; ai < 2; ++ai)
#pragma unroll
                for (int m = 0; m < 4; ++m) { const int row = ai * 128 + wr * 64 + m * 16 + fr; const float r = rstd[ai][m][0];
                    store8bf(Ct + (size_t)row * 4096, acc[ai][0][m][0] * r * g0, acc[ai][0][m][1] * r * g1);
                    store8bf(Ct + (size_t)row * 4096 + 128, acc[ai][1][m][0], acc[ai][1][m][1]); } } };
    fg::gemm_phase<false, fg::DUnit>(lds, 512, S, E);
}
template <int layer>
__device__ __forceinline__ void ph_gemm_wo(LAS unsigned char* lds) {
    PH_BEGIN;
    const float* R = INF(0); bf16* H1b = WSP(bf16, WS_H1);
    const float* gff = INF(layer == 0 ? 10 : 22); bf16* HN = WSP(bf16, WS_HN); float* SSQ = WSP(float, WS_SSQ);
    fg::DenseSched S{WSP(bf16, WS_O), WSP(bf16, layer == 0 ? WS_W_O0T : WS_W_O1T), 8, nullptr, nullptr, 0, DM, G, bx};
    auto E = [=](const f32x4 (&acc)[2][2][4][2], const fg::DUnit& u, int wr, int wc, int fr, int fq) {
        const int colb = u.pn * 256 + wc * 32 + 8 * fq; const size_t o0 = (size_t)u.pm * 256 * DM + colb;
        f32x4 g[2][2];
#pragma unroll
        for (int bj = 0; bj < 2; ++bj) { g[bj][0] = *(const f32x4*)(gff + colb + bj * 128); g[bj][1] = *(const f32x4*)(gff + colb + bj * 128 + 4); }
#pragma unroll
        for (int ai = 0; ai < 2; ++ai) {
            f32x4 rr[4][2][2];
#pragma unroll
            for (int m = 0; m < 4; ++m)
#pragma unroll
                for (int bj = 0; bj < 2; ++bj) { const size_t o = o0 + (size_t)(ai * 128 + wr * 64 + m * 16 + fr) * DM + bj * 128;
                    if (layer == 0) { rr[m][bj][0] = *(const f32x4*)(R + o); rr[m][bj][1] = *(const f32x4*)(R + o + 4); }
                    else { const u32x4 w = *(const u32x4*)(H1b + o); rr[m][bj][0] = bf4((u32x2){w[0], w[1]}); rr[m][bj][1] = bf4((u32x2){w[2], w[3]}); } }
            asm volatile("" ::: "memory");
#pragma unroll
            for (int m = 0; m < 4; ++m) { const int row = ai * 128 + wr * 64 + m * 16 + fr; float ss = 0.f;
#pragma unroll
                for (int bj = 0; bj < 2; ++bj) { const size_t o = o0 + (size_t)row * DM + bj * 128;
                    const f32x4 h0 = rr[m][bj][0] + acc[ai][bj][m][0], h1 = rr[m][bj][1] + acc[ai][bj][m][1];
                    store8bf(H1b + o, h0, h1);
                    ss += (h0[0] * h0[0] + h0[1] * h0[1]) + (h0[2] * h0[2] + h0[3] * h0[3]) + (h1[0] * h1[0] + h1[1] * h1[1]) + (h1[2] * h1[2] + h1[3] * h1[3]);
                    store8bf(HN + o, h0 * g[bj][0], h1 * g[bj][1]); }
                ss += __shfl_xor(ss, 16); ss += __shfl_xor(ss, 32);
                if (fq == 0) SSQ[((size_t)u.pm * 256 + row) * 32 + u.pn * 4 + wc] = ss; } } };
    fg::gemm_phase<false, fg::DUnit>(lds, DM, S, E);
}

__device__ __forceinline__ void ph_mla_prep() {
    PH_BEGIN;
    const bf16* Z = WSP(bf16, WS_Z); bf16* CQN = WSP(bf16, WS_CQN); bf16* CKVN = WSP(bf16, WS_CKVN); bf16* KR = WSP(bf16, WS_KR); const float* PK = WSP(float, WS_PK);
    const float* gq = INF(4); const float* gkv = INF(5); const float* qkg = INF(8); const int* positions = (const int*)arg_ptr(1);
    for (int t = gw; t < T; t += ngw) {
        const bf16* zr = Z + (size_t)t * 1024;
        float xq[8], xk[8]; unpack8(*(const u32x4*)(zr + 8 * lane), xq); unpack8(*(const u32x4*)(zr + 512 + 8 * lane), xk);
        float sq = 0.f, sk = 0.f;
#pragma unroll
        for (int j = 0; j < 8; ++j) { sq += xq[j] * xq[j]; sk += xk[j] * xk[j]; }
        sq = wave_sum(sq); sk = wave_sum(sk);
        const float rq = rsq(sq * (1.0f / 512) + EPS), rk = rsq(sk * (1.0f / 512) + EPS);
        u32x4 oq, ok;
#pragma unroll
        for (int j = 0; j < 4; ++j) { oq[j] = pk2(xq[2 * j] * rq * gq[8 * lane + 2 * j], xq[2 * j + 1] * rq * gq[8 * lane + 2 * j + 1]);
                                      ok[j] = pk2(xk[2 * j] * rk * gkv[8 * lane + 2 * j], xk[2 * j + 1] * rk * gkv[8 * lane + 2 * j + 1]); }
        *(u32x4*)(CQN + (size_t)t * 512 + 8 * lane) = oq; *(u32x4*)(CKVN + (size_t)t * 512 + 8 * lane) = ok;
        const float* pk = PK + (size_t)t * 64 + lane;
        const float xr = (pk[0] + pk[(size_t)T * 64]) + (pk[(size_t)2 * T * 64] + pk[(size_t)3 * T * 64]);
        const float s2 = wave_sum(xr * xr);
        const float xn = xr * rsq(s2 * (1.0f / 64) + EPS) * qkg[192 + 128 + lane];
        KR[(size_t)t * 64 + lane] = (bf16)f2bf(rope64(xn, lane, (float)positions[t]));
    }
}
template <int LD, int COL0, int HSTRIDE>
__device__ __forceinline__ void knorm_rows(bf16* Kbase, const float* gain  , int gw, int ngw, int lane) {
    const int h = lane >> 2, part = lane & 3;
    f32x4 g[8];
#pragma unroll
    for (int i = 0; i < 8; ++i) g[i] = *(const f32x4*)(gain + part * 32 + 4 * i);
    for (int t = gw; t < T; t += ngw) {
        bf16* kp = Kbase + (size_t)t * LD + COL0 + h * HSTRIDE + part * 32;
        u32x4 w[4]; float x[32]; float ss = 0.f;
#pragma unroll
        for (int i = 0; i < 4; ++i) w[i] = *(const u32x4*)(kp + 8 * i);
#pragma unroll
        for (int i = 0; i < 4; ++i)
#pragma unroll
            for (int j = 0; j < 4; ++j) { x[8 * i + 2 * j] = bf2f(w[i][j] & 0xffffu); x[8 * i + 2 * j + 1] = bf2f(w[i][j] >> 16); }
#pragma unroll
        for (int i = 0; i < 32; ++i) ss += x[i] * x[i];
        ss += __shfl_xor(ss, 1); ss += __shfl_xor(ss, 2);
        const float r = rsq(ss * (1.0f / 128) + EPS);
#pragma unroll
        for (int i = 0; i < 4; ++i) { u32x4 o;
#pragma unroll
            for (int j = 0; j < 4; ++j) o[j] = pk2(x[8 * i + 2 * j] * r * g[2 * i + (j >> 1)][(2 * j) & 3], x[8 * i + 2 * j + 1] * r * g[2 * i + (j >> 1)][(2 * j + 1) & 3]);
            *(u32x4*)(kp + 8 * i) = o; }
    }
}
__device__ __forceinline__ void ph_mla_knorm() {
    PH_BEGIN;
    knorm_rows<4096, 0, 256>(WSP(bf16, WS_KVL), INF(8) + 192, gw, ngw, lane);
}
__device__ __forceinline__ void ph_fox_prep(LAS unsigned char* lds) {
    PH_BEGIN;
    const float* PF = WSP(float, WS_PF); float* CB = WSP(float, WS_C); const float* fb = INF(19);
    LAS float* wtot = (LAS float*)lds;
    for (int bh = bx; bh < NB * NH; bh += G) {
        const int b = bh >> 4, h = bh & 15; const float bias = fb[h];
        const float* pf = PF + ((size_t)b * SEQ + tid * 8) * 16 + h;
        float v[8]; float run = 0.f;
#pragma unroll
        for (int i = 0; i < 8; ++i) { const float* q = pf + i * 16;
            const float xx = ((q[0] + q[(size_t)T * 16]) + (q[(size_t)2 * T * 16] + q[(size_t)3 * T * 16])) + bias;
            run += fminf(xx, 0.f) - log1pf(expf(-fabsf(xx))); v[i] = run; }
        float incl = run;
#pragma unroll
        for (int o = 1; o < 64; o <<= 1) { const float up = __shfl_up(incl, o); if (lane >= o) incl += up; }
        if (lane == 63) wtot[wave] = incl;
        __syncthreads();
        float base = incl - run;
        for (int w = 0; w < wave; ++w) base += wtot[w];
        float* cb = CB + (size_t)bh * SEQ + tid * 8;
        *(f32x4*)cb = (f32x4){-(base + v[0]) * 1.4426950408889634f, -(base + v[1]) * 1.4426950408889634f, -(base + v[2]) * 1.4426950408889634f, -(base + v[3]) * 1.4426950408889634f};
        *(f32x4*)(cb + 4) = (f32x4){-(base + v[4]) * 1.4426950408889634f, -(base + v[5]) * 1.4426950408889634f, -(base + v[6]) * 1.4426950408889634f, -(base + v[7]) * 1.4426950408889634f};
        __syncthreads();
    }
}

namespace fa {
typedef short s16x4 __attribute__((ext_vector_type(4)));
typedef float f32x16 __attribute__((ext_vector_type(16)));
constexpr int KVB = 64, SHM_V = KVB * 128 * 2;
__device__ __forceinline__ int v_rd_base(int lane) { return ((lane & 3) << 3) | (((lane >> 2) & 3) << 6) | (((lane >> 4) & 1) << 5) | (((lane >> 5) & 1) << 8); }
constexpr int v_rd_off(int d0, int ks, int half) { return d0 * 512 + ks * 4096 + half * 2048; }
__device__ __forceinline__ int crow(int r, int hi) { return (r & 3) + 8 * (r >> 2) + 4 * hi; }
__device__ __forceinline__ unsigned cvtpk(float lo, float hi) { unsigned r; asm volatile("v_cvt_pk_bf16_f32 %0, %1, %2" : "=v"(r) : "v"(lo), "v"(hi)); return r; }

template <int layer>
__device__ __forceinline__ void attn_phase(LAS unsigned char* lds) {
    PH_BEGIN;
    constexpr int DK = layer == 0 ? 192 : 128, NQ = DK / 16, CPR = DK / 8, NKC = KVB * CPR / NTHREADS;
    constexpr int SHM_K = KVB * DK * 2;
    constexpr int OFF_V = 0, OFF_K = 2 * SHM_V, OFF_WS = OFF_K + 2 * SHM_K, OFF_CB = OFF_WS + NWAVES * 256, OFF_CV = 86016;
    static_assert(OFF_CB + 512 <= OFF_CV && OFF_CV + NWAVES * 8192 <= LDS_BARW, "attention LDS map");
    constexpr float C2 = (layer == 0 ? 0.07216878364870322f : 0.08838834764831845f) * 1.4426950408889634f;
    constexpr int QLD = layer == 0 ? 3072 : 8192, QHS = layer == 0 ? 192 : 128, KLD = layer == 0 ? 4096 : 8192, KC0 = layer == 0 ? 0 : 2048, KHS = layer == 0 ? 256 : 128, VC0 = layer == 0 ? 128 : 4096;
    const bf16* Qs = layer == 0 ? WSP(bf16, WS_QL) : WSP(bf16, WS_Z); const bf16* Ks = layer == 0 ? WSP(bf16, WS_KVL) : WSP(bf16, WS_Z); const bf16* KRs = WSP(bf16, WS_KR); bf16* Ob = WSP(bf16, WS_O);
    const float* qkg = INF(layer == 0 ? 8 : 20); const int* positions = (const int*)arg_ptr(1);
    const float* CBg = WSP(float, WS_C); const bf16* Zg = WSP(bf16, WS_Z);
    const int wid = __builtin_amdgcn_readfirstlane(tid >> 6), r32 = lane & 31, hi = lane >> 5;
    auto koff_n = [](int tk, int j) { const int ci = j * 256 + tk, row = ci >> 4, pc = ci & 15, lc = pc ^ (row & 7); return (unsigned)(row * KLD + lc * 8) * 2u; };
    auto koff_r = [](int tk, int j) { const int ci = j * 256 + tk, row = ci >> 3, pc = ci & 7, lc = pc ^ (row & 7); return (unsigned)(row * 64 + lc * 8) * 2u; };
    auto voff_f = [](int tk, int j) { const int ci = j * 256 + tk, st = ci >> 5, w = ci & 31, kk = (st >> 2) * 8 + (w >> 2), key = (kk & ~0xC) | ((kk & 4) << 1) | ((kk & 8) >> 1), c = (st & 3) * 32 + (w & 3) * 8;
        return (unsigned)(key * KLD + c) * 2u; };
    const int tkp = (tid - 256) & 255; const unsigned kof0 = koff_n(tkp, 0), vof0 = voff_f(tkp, 0), rof0 = koff_r(tkp, 0);
    const int kbn = r32 * 256 + ((hi * 16) ^ ((r32 & 7) << 4)), kbr0 = 16384 + r32 * 128 + ((hi * 16) ^ ((r32 & 7) << 4));
    const unsigned ldsb = (unsigned)(uintptr_t)lds;
    const int vb0 = (int)(unsigned)(uintptr_t)(lds + OFF_V) + v_rd_base(lane);
    LAS float* wsl = (LAS float*)(lds + OFF_WS) + wid * 64; LAS float* li_l = wsl; LAS float* al_l = wsl + 32;

    const float* cv_wgu = INF(layer == 0 ? 15 : 27); const float* cv_wdn = INF(layer == 0 ? 16 : 28); bf16* cv_gut = WSP(bf16, CV_MODE >= 2 ? WS_Q : WS_W_GUT); bf16* cv_dt = WSP(bf16, CV_MODE >= 2 ? WS_Q : WS_W_DT);
    constexpr int CV_IG = 32 * 32, CV_ID = 8 * 64, CV_NIT = NEXP * (CV_IG + CV_ID);
    int cv_it = (CV_MODE == 1) ? CV_NIT : bx * 4 + wid, cv_pend = -1; const int cv_stride = G * 4;
    const unsigned cv_lds = (unsigned)(uintptr_t)(lds + OFF_CV) + (unsigned)(wid & 3) * 16384u;
#define CV_DECODE(it_) const bool gu_ = (it_) < NEXP * CV_IG; const int v_ = gu_ ? (it_) : (it_) - NEXP * CV_IG, e_ = gu_ ? v_ >> 10 : v_ >> 9, r_ = gu_ ? v_ & 1023 : v_ & 511;     \
        const int lgN_ = gu_ ? 10 : 11, lgK_ = gu_ ? 11 : 9, N_ = 1 << lgN_, k0_ = (r_ >> (lgN_ - 5)) << 6, n0_ = (r_ & ((1 << (lgN_ - 5)) - 1)) << 5; \
        const float* W_ = (gu_ ? cv_wgu : cv_wdn) + ((size_t)e_ << (gu_ ? 21 : 20)); bf16* WT_ = (gu_ ? cv_gut : cv_dt) + (((size_t)e_ << (gu_ ? 21 : 20)) & (CV_MODE >= 2 ? (size_t)0x1ffffff : ~(size_t)0))
#define CV_ISSUE(it_, SLOT) do { { CV_DECODE(it_); const int lz_ = otid() & 63; \
        const unsigned vb_ = (unsigned)((lz_ >> 3) * N_) * 4u; const char* sb_ = (const char*)(W_ + (size_t)k0_ * N_ + n0_); \
        _Pragma("unroll") for (int i = 0; i < 8; ++i) { const char* si_ = sb_ + (size_t)i * 8 * N_ * 4; const unsigned vo_ = vb_ + ((unsigned)((lz_ & 7) ^ i) << 4); unsigned keep_; \
            asm volatile("s_mov_b32 %0, m0\n\ts_mov_b32 m0, %3\n\ts_nop 0\n\tglobal_load_lds_dwordx4 %1, %2 nt\n\ts_mov_b32 m0, %0" : "=&s"(keep_) : "v"(vo_), "s"(si_), "s"(cv_lds + (unsigned)(SLOT) * 8192u + (unsigned)i * 1024u) : "memory"); } } } while (0)
#define CV_FINISH(it_, SLOT) do { { CV_DECODE(it_); const int lz_ = otid() & 63, c_ = lz_ & 7; const LAS float* scr_ = (const LAS float*)(lds + OFF_CV) + (wid & 3) * 4096 + (SLOT) * 2048; \
        float cvr_[4][8];                                                                           \
        _Pragma("unroll") for (int j = 0; j < 4; ++j) { const int n_ = (lz_ >> 3) + 8 * j; const LAS float* sp_ = scr_ + (8 * c_) * 32 + (((n_ >> 2) ^ c_) << 2) + (n_ & 3); \
            _Pragma("unroll") for (int q = 0; q < 8; ++q) cvr_[j][q] = sp_[32 * q]; } \
        asm volatile("s_waitcnt lgkmcnt(0)" ::: "memory"); __builtin_amdgcn_sched_barrier(0); \
        _Pragma("unroll") for (int j = 0; j < 4; ++j) { const int n_ = (lz_ >> 3) + 8 * j; \
            u32x4 o_; o_.x = pk2(cvr_[j][0], cvr_[j][1]); o_.y = pk2(cvr_[j][2], cvr_[j][3]); o_.z = pk2(cvr_[j][4], cvr_[j][5]); o_.w = pk2(cvr_[j][6], cvr_[j][7]); \
            const int nn_ = n0_ + n_; const int f_ = nn_ & 511; \
            const int dr_ = gu_ ? ((f_ >> 7) * 256 + ((f_ >> 6) & 1) * 128 + ((f_ >> 4) & 3) * 32 + ((f_ >> 2) & 3) * 8 + (nn_ >> 9) * 4 + (f_ & 3)) : nn_;     \
            __builtin_nontemporal_store(o_, (u32x4*)(WT_ + ((size_t)dr_ << lgK_) + k0_ + 8 * c_)); } \
        } } while (0)
    for (int L = bx; L < NB * NH * 8; L += G) {
        const int bh = (L & 7) * 8 + (L >> 6), pair = (L >> 3) & 7, b = bh >> 4, h = bh & 15;
        const char* Kg = (const char*)(Ks + (size_t)b * SEQ * KLD + KC0 + h * KHS); const char* Vg = (const char*)(Ks + (size_t)b * SEQ * KLD + VC0 + h * KHS);
        const char* KRg = (const char*)(KRs + (size_t)b * SEQ * 64); const float* cbg = CBg + (size_t)bh * SEQ;
        for (int pass = 0; pass < 2; ++pass) {
            const int qb = pass ? pair : 15 - pair, P0 = qb * 256, NT = P0 / KVB + 4, qlo = P0 + wid * 32;
            bf16x8 qr[NQ];
            {
                const size_t tq = (size_t)b * SEQ + qlo + r32;
                const bf16* qp = Qs + tq * QLD + h * QHS + hi * 8;
                u32x4 raw[NQ];
#pragma unroll
                for (int d0 = 0; d0 < NQ; ++d0) raw[d0] = *(const u32x4*)(qp + d0 * 16);
                float ss = 0.f;
#pragma unroll
                for (int d0 = 0; d0 < 8; ++d0)
#pragma unroll
                    for (int j = 0; j < 4; ++j) { const float x0 = bf2f(raw[d0][j] & 0xffffu), x1 = bf2f(raw[d0][j] >> 16); ss += x0 * x0 + x1 * x1; }
                { auto rr = __builtin_amdgcn_permlane32_swap(__float_as_uint(ss), __float_as_uint(ss), false, false); ss = __uint_as_float(rr[0]) + __uint_as_float(rr[1]); }
                const float rn = rsq(ss * (1.0f / 128) + EPS) * C2;
#pragma unroll
                for (int d0 = 0; d0 < 8; ++d0) { const f32x4 g0 = *(const f32x4*)(qkg + d0 * 16 + hi * 8), g1 = *(const f32x4*)(qkg + d0 * 16 + hi * 8 + 4); u32x4 o;
#pragma unroll
                    for (int j = 0; j < 4; ++j) { const float x0 = bf2f(raw[d0][j] & 0xffffu), x1 = bf2f(raw[d0][j] >> 16); const f32x4 gg = j < 2 ? g0 : g1;
                        o[j] = cvtpk(x0 * rn * gg[(2 * j) & 3], x1 * rn * gg[(2 * j + 1) & 3]); }
                    qr[d0] = *reinterpret_cast<bf16x8*>(&o); }
                if constexpr (layer == 0) {
                    float xr[4][8]; float s2 = 0.f;
#pragma unroll
                    for (int c = 0; c < 4; ++c)
#pragma unroll
                        for (int j = 0; j < 4; ++j) { xr[c][2 * j] = bf2f(raw[8 + c][j] & 0xffffu); xr[c][2 * j + 1] = bf2f(raw[8 + c][j] >> 16); s2 += xr[c][2 * j] * xr[c][2 * j] + xr[c][2 * j + 1] * xr[c][2 * j + 1]; }
                    { auto rr = __builtin_amdgcn_permlane32_swap(__float_as_uint(s2), __float_as_uint(s2), false, false); s2 = __uint_as_float(rr[0]) + __uint_as_float(rr[1]); }
                    const float r2 = rsq(s2 * (1.0f / 64) + EPS); const float pos = (float)positions[tq];
#pragma unroll
                    for (int c = 0; c < 4; ++c) { const f32x4 g0 = *(const f32x4*)(qkg + 128 + c * 16 + hi * 8), g1 = *(const f32x4*)(qkg + 128 + c * 16 + hi * 8 + 4);
#pragma unroll
                        for (int j = 0; j < 8; ++j) xr[c][j] *= r2 * (j < 4 ? g0[j & 3] : g1[j & 3]); }
#pragma unroll
                    for (int c = 0; c < 2; ++c) { u32x4 o1, o2;
#pragma unroll
                        for (int jj = 0; jj < 4; ++jj) { float y1[2], y2[2];
#pragma unroll
                            for (int e = 0; e < 2; ++e) { const int j = 2 * jj + e; const int i = c * 16 + hi * 8 + j;
                                const float freq = exp2f(-(float)i * (13.287712379549449f / 32.0f)); float rev = pos * freq * 0.15915494309189535f; rev -= floorf(rev);
                                const float sn = __builtin_amdgcn_sinf(rev), cs = __builtin_amdgcn_cosf(rev);
                                y1[e] = (xr[c][j] * cs - xr[c + 2][j] * sn) * C2; y2[e] = (xr[c + 2][j] * cs + xr[c][j] * sn) * C2; }
                            o1[jj] = cvtpk(y1[0], y1[1]); o2[jj] = cvtpk(y2[0], y2[1]); }
                        qr[8 + c] = *reinterpret_cast<bf16x8*>(&o1); qr[10 + c] = *reinterpret_cast<bf16x8*>(&o2); }
                }
            }
            float m_reg = 0.f, l_reg = 0.f; f32x16 o[4];
#pragma unroll
            for (int d0 = 0; d0 < 4; ++d0)
#pragma unroll
                for (int r = 0; r < 16; ++r) o[d0][r] = 0.f;
#define FA_DMA16(sbase_, voff_, ldsaddr_) do { unsigned keep_; asm volatile("s_mov_b32 %0, m0\n\ts_mov_b32 m0, %3\n\ts_nop 0\n\tglobal_load_lds_dwordx4 %1, %2\n\ts_mov_b32 m0, %0" \
        : "=&s"(keep_) : "v"(voff_), "s"(sbase_), "s"(ldsaddr_) : "memory"); } while (0)
#define FA_DMA4(sbase_, voff_, ldsaddr_) do { unsigned keep_; asm volatile("s_mov_b32 %0, m0\n\ts_mov_b32 m0, %3\n\ts_nop 0\n\tglobal_load_lds_dword %1, %2\n\ts_mov_b32 m0, %0" \
        : "=&s"(keep_) : "v"(voff_), "s"(sbase_), "s"(ldsaddr_) : "memory"); } while (0)
#define FA_ISSUE(t_, BUF) do { if (wid >= 4) { const char* ks_ = Kg + (size_t)(t_) * (KVB * KLD * 2); const char* vs_ = Vg + (size_t)(t_) * (KVB * KLD * 2); const unsigned wl_ = (unsigned)(wid - 4) * 1024u; \
        _Pragma("unroll") for (int j = 0; j < 4; ++j) FA_DMA16(ks_, kof0 + (unsigned)(j * 16 * KLD * 2), ldsb + (unsigned)(OFF_K + (BUF) * SHM_K + j * 4096) + wl_); \
        if constexpr (layer == 0) { const char* kr_ = KRg + (size_t)(t_) * (KVB * 64 * 2); \
            _Pragma("unroll") for (int j = 0; j < 2; ++j) FA_DMA16(kr_, rof0 + (unsigned)(j * 32 * 64 * 2), ldsb + (unsigned)(OFF_K + (BUF) * SHM_K + 16384 + j * 4096) + wl_); } \
        _Pragma("unroll") for (int j = 0; j < 4; ++j) FA_DMA16(vs_, vof0 + (unsigned)(j * 16 * KLD * 2), ldsb + (unsigned)(OFF_V + (BUF) * SHM_V + j * 4096) + wl_); \
        if (layer == 1 && wid == 4) { const float* cs_ = cbg + (t_) * KVB; FA_DMA4(cs_, (unsigned)lane * 4u, ldsb + (unsigned)(OFF_CB + (BUF) * 256)); } } } while (0)
#define FA_TRRD(dst, off) asm volatile("ds_read_b64_tr_b16 %0, %1 offset:%2" : "=&v"(dst) : "v"(vb0), "i"(off) : "memory")
#define FA_PV_D0(BUF, d0) do { s16x4 l0, l1, l2, l3, h0, h1, h2, h3; constexpr int b_ = (BUF) * SHM_V + v_rd_off(d0, 0, 0); \
        FA_TRRD(l0, b_); FA_TRRD(h0, b_ + 2048); FA_TRRD(l1, b_ + 4096); FA_TRRD(h1, b_ + 6144); FA_TRRD(l2, b_ + 8192); FA_TRRD(h2, b_ + 10240); FA_TRRD(l3, b_ + 12288); FA_TRRD(h3, b_ + 14336); \
        asm volatile("s_waitcnt lgkmcnt(0)" ::: "memory"); __builtin_amdgcn_sched_barrier(0); \
        o[d0] = __builtin_amdgcn_mfma_f32_32x32x16_bf16((bf16x8){l0[0], l0[1], l0[2], l0[3], h0[0], h0[1], h0[2], h0[3]}, pa0, o[d0], 0, 0, 0); \
        o[d0] = __builtin_amdgcn_mfma_f32_32x32x16_bf16((bf16x8){l1[0], l1[1], l1[2], l1[3], h1[0], h1[1], h1[2], h1[3]}, pa1, o[d0], 0, 0, 0); \
        o[d0] = __builtin_amdgcn_mfma_f32_32x32x16_bf16((bf16x8){l2[0], l2[1], l2[2], l2[3], h2[0], h2[1], h2[2], h2[3]}, pa2, o[d0], 0, 0, 0); \
        o[d0] = __builtin_amdgcn_mfma_f32_32x32x16_bf16((bf16x8){l3[0], l3[1], l3[2], l3[3], h3[0], h3[1], h3[2], h3[3]}, pa3, o[d0], 0, 0, 0); } while (0)
#define FA_PK4(P, B_, OUT) do { const unsigned a0 = cvtpk(P[B_ + 0], P[B_ + 1]), a1 = cvtpk(P[B_ + 2], P[B_ + 3]), b0_ = cvtpk(P[B_ + 4], P[B_ + 5]), b1_ = cvtpk(P[B_ + 6], P[B_ + 7]); \
        auto r0 = __builtin_amdgcn_permlane32_swap(a0, b0_, false, false); auto r1 = __builtin_amdgcn_permlane32_swap(a1, b1_, false, false); \
        u32x4 w_ = {r0[0], r1[0], r0[1], r1[1]}; OUT = *reinterpret_cast<bf16x8*>(&w_); } while (0)
#define FA_STEP(t_, BUF) do { \
          \
        if (wid >= 4 || (t_) == 0) asm volatile("s_waitcnt vmcnt(0)" ::: "memory");                 \
        asm volatile("s_waitcnt lgkmcnt(0)" ::: "memory"); __builtin_amdgcn_s_barrier(); asm volatile("" ::: "memory");     \
        if ((t_) + 1 < NT) FA_ISSUE((t_) + 1, (BUF) ^ 1); \
        if (wid < 4) {                                                                             \
            if (cv_pend >= 0) { asm volatile("s_waitcnt vmcnt(0)" ::: "memory"); CV_FINISH(cv_pend, (BUF) ^ 1); cv_pend = -1; }     \
            if (cv_it < CV_NIT) { CV_ISSUE(cv_it, BUF); cv_pend = cv_it; cv_it += cv_stride; } }         \
        const int kbase = (t_) * KVB; \
        if (kbase <= qlo + 31) {                                                                   \
            f32x16 p0, p1; \
            _Pragma("unroll") for (int r = 0; r < 16; ++r) { p0[r] = 0.f; p1[r] = 0.f; } \
            const LAS unsigned char* kt = lds + OFF_K + (BUF) * SHM_K; \
            int kbn_ = kbn, kbr_ = kbr0; asm volatile("" : "+v"(kbn_), "+v"(kbr_));                 \
            if (wid < 4) __builtin_amdgcn_s_setprio(2); else __builtin_amdgcn_s_setprio(1);          \
            _Pragma("unroll") for (int d0 = 0; d0 < NQ; ++d0) { const LAS unsigned char* a_ = d0 < 8 ? kt + (kbn_ ^ ((d0 & 3) << 5)) + (d0 >> 2) * 128 : kt + (kbr_ ^ ((d0 & 3) << 5)); \
                const bf16x8 k0 = *(const LAS bf16x8*)a_, k1 = *(const LAS bf16x8*)(a_ + (d0 < 8 ? 32 * 256 : 32 * 128)); \
                p0 = __builtin_amdgcn_mfma_f32_32x32x16_bf16(k0, qr[d0], p0, 0, 0, 0); p1 = __builtin_amdgcn_mfma_f32_32x32x16_bf16(k1, qr[d0], p1, 0, 0, 0); \
                if ((d0 & 3) == 3) __builtin_amdgcn_sched_barrier(0); } \
            if (layer == 1) { const LAS f32x4* cb = (const LAS f32x4*)(lds + OFF_CB + (BUF) * 256); \
                _Pragma("unroll") for (int g = 0; g < 4; ++g) { const f32x4 c0 = cb[2 * g + hi], c1 = cb[8 + 2 * g + hi]; \
                    _Pragma("unroll") for (int j = 0; j < 4; ++j) { p0[4 * g + j] += c0[j]; p1[4 * g + j] += c1[j]; } \
                    __builtin_amdgcn_sched_barrier(0); } } \
            if (kbase + KVB - 1 > qlo) { const int dq = qlo + r32 - 4 * hi - kbase; const float NEG = -__builtin_inff();     \
                _Pragma("unroll") for (int r = 0; r < 16; ++r) { const int c = (r & 3) + 8 * (r >> 2); if (dq - c < 0) p0[r] = NEG; if (dq - c - 32 < 0) p1[r] = NEG; } } \
            float pmax = p0[0]; \
            _Pragma("unroll") for (int r = 1; r < 16; ++r) pmax = fmaxf(pmax, p0[r]); \
            _Pragma("unroll") for (int r = 0; r < 16; ++r) pmax = fmaxf(pmax, p1[r]); \
            { auto rr = __builtin_amdgcn_permlane32_swap(__float_as_uint(pmax), __float_as_uint(pmax), false, false); pmax = fmaxf(__uint_as_float(rr[0]), __uint_as_float(rr[1])); } \
              \
            if ((t_) == 0) m_reg = pmax < -64.0f ? pmax : 0.f; \
            float mn, alpha; \
            if (__all(pmax - m_reg <= 64.0f)) { mn = m_reg; alpha = 1.f; } else { mn = fmaxf(m_reg, pmax); alpha = __builtin_amdgcn_exp2f(m_reg - mn); m_reg = mn; } \
            float ps = 0.f; \
            if (__all(mn == 0.f)) { _Pragma("unroll") for (int r = 0; r < 16; ++r) { p0[r] = __builtin_amdgcn_exp2f(p0[r]); p1[r] = __builtin_amdgcn_exp2f(p1[r]); ps += p0[r] + p1[r]; } } \
            else { _Pragma("unroll") for (int r = 0; r < 16; ++r) { p0[r] = __builtin_amdgcn_exp2f(p0[r] - mn); p1[r] = __builtin_amdgcn_exp2f(p1[r] - mn); ps += p0[r] + p1[r]; } } \
            { auto rr = __builtin_amdgcn_permlane32_swap(__float_as_uint(ps), __float_as_uint(ps), false, false); ps = __uint_as_float(rr[0]) + __uint_as_float(rr[1]); } \
            l_reg = l_reg * alpha + ps; \
            bf16x8 pa0, pa1, pa2, pa3; FA_PK4(p0, 0, pa0); FA_PK4(p0, 8, pa1); FA_PK4(p1, 0, pa2); FA_PK4(p1, 8, pa3); \
            if (__any(alpha < 1.f)) {                                                              \
                _Pragma("unroll") for (int d_ = 0; d_ < 4; ++d_) _Pragma("unroll") for (int r = 0; r < 16; ++r) o[d_][r] *= alpha; } \
            FA_PV_D0(BUF, 0); FA_PV_D0(BUF, 1); FA_PV_D0(BUF, 2); FA_PV_D0(BUF, 3); __builtin_amdgcn_s_setprio(0); \
        } \
        } while (0)
            FA_ISSUE(0, 0);
            for (int t = 0; t < NT; t += 2) { FA_STEP(t, 0); FA_STEP(t + 1, 1); }
            { const int tz = otid(), hz = (tz >> 5) & 1, rz = tz & 31;
              const size_t trow = (size_t)b * SEQ + qlo + rz; const float rl = __builtin_amdgcn_rcpf(l_reg);
              u32x2 gts[4][4];
              if (layer == 1) { const bf16* gp = Zg + trow * 8192 + 6144 + h * 128 + 4 * hz;
#pragma unroll
                  for (int d0 = 0; d0 < 4; ++d0)
#pragma unroll
                      for (int g = 0; g < 4; ++g) gts[d0][g] = *(const u32x2*)(gp + d0 * 32 + 8 * g); }
              bf16* op = Ob + trow * DM + h * 128 + 8 * hz;
#pragma unroll
              for (int d0 = 0; d0 < 4; ++d0)
#pragma unroll
                  for (int gp2 = 0; gp2 < 2; ++gp2) { unsigned pk[2][2];
#pragma unroll
                      for (int e = 0; e < 2; ++e) { const int g = 2 * gp2 + e; float v[4];
#pragma unroll
                          for (int j = 0; j < 4; ++j) v[j] = o[d0][4 * g + j] * rl;
                          if (layer == 1) { const u32x2 gw = gts[d0][g]; const float g4[4] = {bf2f(gw[0] & 0xffffu), bf2f(gw[0] >> 16), bf2f(gw[1] & 0xffffu), bf2f(gw[1] >> 16)};
#pragma unroll
                              for (int j = 0; j < 4; ++j) v[j] *= 1.0f / (1.0f + __expf(-g4[j])); }
                          pk[e][0] = cvtpk(v[0], v[1]); pk[e][1] = cvtpk(v[2], v[3]); }
                      auto s0 = __builtin_amdgcn_permlane32_swap(pk[0][0], pk[1][0], false, false); auto s1 = __builtin_amdgcn_permlane32_swap(pk[0][1], pk[1][1], false, false);
                      *(u32x4*)(op + d0 * 32 + 16 * gp2) = (u32x4){s0[0], s1[0], s0[1], s1[1]}; } }
        }
    }
    asm volatile("s_waitcnt vmcnt(0)" ::: "memory");
    if (wid < 4) { if (cv_pend >= 0) CV_FINISH(cv_pend, 1);
        while (cv_it < CV_NIT) { CV_ISSUE(cv_it, 0); asm volatile("s_waitcnt vmcnt(0)" ::: "memory"); CV_FINISH(cv_it, 0); cv_it += cv_stride; } }
    __syncthreads();
#undef CV_DECODE
#undef CV_ISSUE
#undef CV_FINISH
#undef FA_ISSUE
#undef FA_DMA16
#undef FA_DMA4
#undef FA_TRRD
#undef FA_PV_D0
#undef FA_PK4
#undef FA_STEP
}
}

template <int layer>
__device__ __forceinline__ void ph_router(LAS unsigned char* lds) {
    PH_BEGIN;
    skinny_gemm<80>(lds, WSP(bf16, WS_HN), WSP(bf16, WS_SK) + (size_t)(2 + layer) * 4 * 256 * 512, WSP(float, WS_PR), G, bx);
}
template <int layer>
__device__ __forceinline__ void ph_route() {
    PH_BEGIN;
    const float* PR = WSP(float, WS_PR); int* TOK = WSP(int, WS_TOK); float* GATE = WSP(float, WS_GATE); int* TSLOT = WSP(int, WS_TSLOT); const float* SSQ = WSP(float, WS_SSQ); float* RSL = WSP(float, WS_RSL);
    unsigned* cnt = WSP(unsigned, WS_CTL) + (layer == 0 ? CW_CNT0 : CW_CNT1);
    const float* b_rg = INF(layer == 0 ? 12 : 24); const float* b_re = INF(layer == 0 ? 14 : 26);
    for (int t = bx * NTHREADS + tid; t < T; t += G * NTHREADS) {
        const float* pr = PR + (size_t)t * 80;
        float rstd; { f32x4 q = *(const f32x4*)(SSQ + (size_t)t * 32);
#pragma unroll
            for (int i = 1; i < 8; ++i) q += *(const f32x4*)(SSQ + (size_t)t * 32 + 4 * i);
            rstd = rsq(((q[0] + q[1]) + (q[2] + q[3])) * (1.0f / DM) + EPS); }
        auto sum4 = [=](int j) { const f32x4 a0 = *(const f32x4*)(pr + j), a1 = *(const f32x4*)(pr + (size_t)T * 80 + j), a2 = *(const f32x4*)(pr + (size_t)2 * T * 80 + j), a3 = *(const f32x4*)(pr + (size_t)3 * T * 80 + j);
            return (a0 + a1) + (a2 + a3); };
        float gl[8]; int g = 0; float gm = -3.0e38f;
        { const f32x4 x0 = sum4(0), x1 = sum4(4);
#pragma unroll
          for (int j = 0; j < 8; ++j) { gl[j] = (j < 4 ? x0[j & 3] : x1[j & 3]) * rstd + b_rg[j]; if (gl[j] > gm) { gm = gl[j]; g = j; } } }
        float se = 0.f;
#pragma unroll
        for (int j = 0; j < 8; ++j) se += expf(gl[j] - gm);
        const float pg = 1.0f / se;
        float el[8]; int i1 = 0; float m1 = -3.0e38f;
        { const f32x4 x0 = sum4(8 + g * 8), x1 = sum4(12 + g * 8);
#pragma unroll
          for (int j = 0; j < 8; ++j) { el[j] = (j < 4 ? x0[j & 3] : x1[j & 3]) * rstd + b_re[g * 8 + j]; if (el[j] > m1) { m1 = el[j]; i1 = j; } } }
        int i2 = 0; float m2 = -3.0e38f;
#pragma unroll
        for (int j = 0; j < 8; ++j) { if (j != i1 && el[j] > m2) { m2 = el[j]; i2 = j; } }
        const float w2 = expf(m2 - m1), g1 = pg / (1.0f + w2), g2 = pg * w2 / (1.0f + w2);
        const int e1 = g * 8 + i1, e2 = g * 8 + i2;
        const unsigned s1 = atomicAdd(&cnt[e1], 1u); TOK[(size_t)e1 * T + s1] = t; GATE[(size_t)e1 * T + s1] = g1; RSL[(size_t)e1 * T + s1] = rstd;
        const unsigned s2 = atomicAdd(&cnt[e2], 1u); TOK[(size_t)e2 * T + s2] = t; GATE[(size_t)e2 * T + s2] = g2; RSL[(size_t)e2 * T + s2] = rstd;
        TSLOT[2 * t] = (e1 << 16) | (int)s1; TSLOT[2 * t + 1] = (e2 << 16) | (int)s2;
    }
}
struct MUnit { int e, mt, mtg, pn, ce; };
template <bool GU>
struct MoeSched {
    const LAS int* ts; const LAS int* cn; const char* A; const char* B; const int* tok; int G, c;
    static constexpr int NPN = GU ? 4 : 8, K = GU ? DM : DEXP;
    __device__ __forceinline__ bool next(int i, MUnit& u) const {
        const LAS int* xs = (const LAS int*)((const LAS unsigned char*)ts + (LDS_XS - LDS_TS));
        const int x = c & 7, W = G >> 3, q = i * W + (c >> 3); if ((G & 7) != 0 || q >= xs[8] * NPN) return false;
        int k = 0; while (xs[k + 1] * NPN <= q) ++k;
        const int e = x + 8 * k, rq = q - xs[k] * NPN, nte = xs[k + 1] - xs[k]; u.pn = rq / nte; u.mt = rq - u.pn * nte;
        u.e = e; u.mtg = ts[e] + u.mt; u.ce = cn[e]; return true; }
    __device__ __forceinline__ const char* a_base(const MUnit& u) const { return GU ? A : A + (size_t)u.mtg * 256 * DEXP * 2; }
    __device__ __forceinline__ const char* b_base(const MUnit& u) const { return B + ((size_t)u.e * (GU ? 1024 : DM) + u.pn * 256) * K * 2; }
    __device__ __forceinline__ unsigned a_voff(const MUnit& u, int row, int col) const {
        if (GU) { const int s = u.mt * 256 + row; return (unsigned)tok[(size_t)u.e * T + (s < u.ce ? s : 0)] * (unsigned)(DM * 2) + (unsigned)col * 2u; }
        return (unsigned)(row * DEXP + col) * 2u; }
    __device__ __forceinline__ bool lo_only(const MUnit& u) const { return u.ce - u.mt * 256 <= 128; }
};
template <int layer>
__device__ __forceinline__ void ph_gateup(LAS unsigned char* lds) {
    PH_BEGIN;
    moe_prefix(lds, WSP(unsigned, WS_CTL) + (layer == 0 ? CW_CNT0 : CW_CNT1));
    bf16* ACT = WSP(bf16, WS_ACT); const float* RSL = WSP(float, WS_RSL);
    MoeSched<true> S{(const LAS int*)(lds + LDS_TS), (const LAS int*)(lds + LDS_CN), (const char*)WSP(bf16, WS_HN), (const char*)WSP(bf16, WS_W_GUT), WSP(int, WS_TOK), G, bx};
    auto E = [=](const f32x4 (&acc)[2][2][4][2], const MUnit& u, int wr, int wc, int fr, int fq) {
        bf16* At = ACT + (size_t)u.mtg * 256 * DEXP + u.pn * 128 + wc * 16 + 4 * fq;
        float rsv[2][4];
#pragma unroll
        for (int ai = 0; ai < 2; ++ai)
#pragma unroll
            for (int m = 0; m < 4; ++m) { const int row = ai * 128 + wr * 64 + m * 16 + fr; rsv[ai][m] = u.mt * 256 + row < u.ce ? RSL[(size_t)u.e * T + u.mt * 256 + row] : 0.f; }
        asm volatile("" ::: "memory");
#pragma unroll
        for (int ai = 0; ai < 2; ++ai)
#pragma unroll
            for (int m = 0; m < 4; ++m) { const int row = ai * 128 + wr * 64 + m * 16 + fr; if (ai == 1 && u.ce - u.mt * 256 <= 128) continue;
                const float rs = rsv[ai][m];
#pragma unroll
                for (int bj = 0; bj < 2; ++bj) { const f32x4 g = acc[ai][bj][m][0] * rs, up = acc[ai][bj][m][1] * rs; f32x4 o;
#pragma unroll
                    for (int j = 0; j < 4; ++j) o[j] = g[j] / (1.0f + __expf(-g[j])) * up[j];
                    store4bf(At + (size_t)row * DEXP + bj * 64, o); } } };
    fg::gemm_phase<true, MUnit>(lds, DM, S, E);
}
template <int layer>
__device__ __forceinline__ void ph_down(LAS unsigned char* lds) {
    PH_BEGIN;
    moe_prefix(lds, WSP(unsigned, WS_CTL) + (layer == 0 ? CW_CNT0 : CW_CNT1));
    bf16* YS = WSP(bf16, WS_YS); const float* GATE = WSP(float, WS_GATE);
    MoeSched<false> S{(const LAS int*)(lds + LDS_TS), (const LAS int*)(lds + LDS_CN), (const char*)WSP(bf16, WS_ACT), (const char*)WSP(bf16, WS_W_DT), nullptr, G, bx};
    auto E = [=](const f32x4 (&acc)[2][2][4][2], const MUnit& u, int wr, int wc, int fr, int fq) {
        const int rem = u.ce - u.mt * 256; const float* gt = GATE + (size_t)u.e * T + u.mt * 256;
        bf16* Yt = YS + (size_t)u.mtg * 256 * DM + u.pn * 256 + wc * 32 + 8 * fq;
        float gv[2][4];
#pragma unroll
        for (int ai = 0; ai < 2; ++ai)
#pragma unroll
            for (int m = 0; m < 4; ++m) { const int row = ai * 128 + wr * 64 + m * 16 + fr; gv[ai][m] = row < rem ? gt[row] : 0.f; }
        asm volatile("" ::: "memory");
#pragma unroll
        for (int ai = 0; ai < 2; ++ai)
#pragma unroll
            for (int m = 0; m < 4; ++m) { const int row = ai * 128 + wr * 64 + m * 16 + fr;
                if (row < rem) { const float g = gv[ai][m];
#pragma unroll
                    for (int bj = 0; bj < 2; ++bj) store8bf(Yt + (size_t)row * DM + bj * 128, acc[ai][bj][m][0] * g, acc[ai][bj][m][1] * g); } } };
    fg::gemm_phase<false, MUnit>(lds, DEXP, S, E);
}

#define GRID_BAR() xcd_barrier(bar)
__global__ void __launch_bounds__(NTHREADS, 2) fwd(Args a) {
    extern __shared__ __attribute__((aligned(16))) unsigned char lds_raw[];
    LAS unsigned char* lds = (LAS unsigned char*)lds_raw;
    (void)a;
    if (threadIdx.x < 4) ((LAS unsigned*)(lds + LDS_BARW))[threadIdx.x] = 0u;
    __syncthreads();
    unsigned* ctl0 = (unsigned*)arg_ptr(30);
    const XcdBarrier bar = xcd_barrier_post(ctl0 + CW_BAR, (volatile LAS unsigned*)(lds + LDS_BARW));
    ph_convert_dense(lds);
    if (CV_MODE >= 1) ph_convert_moe<0>(lds);
    norm_rows<0>(lds, const_cast<float*>(INF(0)), INF(2), nullptr); GRID_BAR();
    ph_gemm_z<0>(lds); GRID_BAR();
    ph_mla_prep(); GRID_BAR();
    ph_gemm_qkv(lds); GRID_BAR();
    fa::attn_phase<0>(lds); GRID_BAR();
    ph_gemm_wo<0>(lds); GRID_BAR();
    ph_router<0>(lds); GRID_BAR();
    ph_route<0>(); GRID_BAR();
    ph_gateup<0>(lds); GRID_BAR();
    ph_down<0>(lds); GRID_BAR();
    norm_rows<1>(lds, (float*)arg_ptr(29), INF(17), (const unsigned*)arg_ptr(30) + CW_CNT0); if (CV_MODE >= 1) ph_convert_moe<1>(lds); GRID_BAR();
    ph_gemm_z<1>(lds); GRID_BAR();
    ph_fox_prep(lds); GRID_BAR();
    fa::attn_phase<1>(lds); GRID_BAR();
    ph_gemm_wo<1>(lds); GRID_BAR();
    ph_router<1>(lds); GRID_BAR();
    ph_route<1>(); GRID_BAR();
    ph_gateup<1>(lds); GRID_BAR();
    ph_down<1>(lds); GRID_BAR();
    norm_rows<2>(lds, (float*)arg_ptr(29), nullptr, (const unsigned*)arg_ptr(30) + CW_CNT1);
}

extern "C" void kernel_launch(void* const* d_in, const int* in_sizes, int n_in, void* d_out, int out_size, void* d_ws, size_t ws_size, hipStream_t stream) {
    static int grid = 0;
    if (grid == 0) {
        if (n_in != 29 || out_size != T * DM || ws_size < WS_END) { fprintf(stderr, "kernel_launch: unexpected shapes (n_in %d out %d ws %zu, need %zu)\n", n_in, out_size, ws_size, (size_t)WS_END); grid = -1; return; }
        int dev = 0, cus = 0;
        if (hipGetDevice(&dev) != hipSuccess || hipDeviceGetAttribute(&cus, hipDeviceAttributeMultiprocessorCount, dev) != hipSuccess || cus <= 0) cus = 256;
        if (hipFuncSetAttribute((const void*)fwd, hipFuncAttributeMaxDynamicSharedMemorySize, LDS_BYTES) != hipSuccess) fprintf(stderr, "kernel_launch: hipFuncSetAttribute failed\n");
        grid = cus & ~7;
        if (grid < 8) grid = 8;
    }
    if (grid < 0) return;
    (void)in_sizes;
    (void)hipMemsetAsync((char*)d_ws + WS_CTL, 0, CTL_BYTES, stream);
    Args a{};
    for (int i = 0; i < 29; ++i) a.in[i] = d_in[i];
    a.out = (float*)d_out; a.ws = (unsigned char*)d_ws;
    hipLaunchKernelGGL(fwd, dim3(grid), dim3(NTHREADS), LDS_BYTES, stream, a);
}
```

```cpp
#include <hip/hip_runtime.h>
#include <cstdio>
#include <cstdint>
#ifndef CV_MODE
#define CV_MODE 0
#endif

#define LAS __attribute__((address_space(3)))
typedef unsigned short bf16;
typedef short bf16x8 __attribute__((ext_vector_type(8)));
typedef float f32x4 __attribute__((ext_vector_type(4)));
typedef unsigned u32x4 __attribute__((ext_vector_type(4)));
typedef unsigned u32x2 __attribute__((ext_vector_type(2)));

constexpr int T = 16384, DM = 2048, NB = 4, SEQ = 4096, NH = 16;
constexpr int NEXP = 64, DEXP = 512;
constexpr float EPS = 1e-6f;
constexpr int NTHREADS = 512, NWAVES = 8;

constexpr size_t MiB = 1u << 20;
constexpr size_t WS_CTL = 0, CTL_BYTES = 1 * MiB;
constexpr size_t WS_W_IN0T = 1 * MiB;
constexpr size_t WS_W_UQT = WS_W_IN0T + 5 * MiB;
constexpr size_t WS_W_UKVT = WS_W_UQT + 3 * MiB;
constexpr size_t WS_W_O0T = WS_W_UKVT + 4 * MiB;
constexpr size_t WS_W_IN1T = WS_W_O0T + 8 * MiB;
constexpr size_t WS_W_O1T = WS_W_IN1T + 33 * MiB;
constexpr size_t WS_W_GUT = WS_W_O1T + 8 * MiB;
constexpr size_t WS_W_DT = WS_W_GUT + 256 * MiB;
constexpr size_t WS_HN = WS_W_DT + 128 * MiB;
constexpr size_t WS_Z = WS_HN + 64 * MiB;
constexpr size_t WS_CQN = WS_Z + 256 * MiB;
constexpr size_t WS_CKVN = WS_CQN + 16 * MiB;
constexpr size_t WS_KR = WS_CKVN + 16 * MiB;
constexpr size_t WS_Q = WS_KR + 2 * MiB;
constexpr size_t WS_K = WS_Q + 96 * MiB;
constexpr size_t WS_V = WS_K + 96 * MiB;
constexpr size_t WS_O = WS_V + 64 * MiB;
constexpr size_t WS_H1 = WS_O + 64 * MiB;
constexpr size_t WS_RL = WS_H1 + 128 * MiB;
constexpr size_t WS_SSQ = WS_RL, WS_RSL = WS_RL + 2 * MiB;
constexpr size_t WS_TOK = WS_RL + 8 * MiB;
constexpr size_t WS_GATE = WS_TOK + 4 * MiB;
constexpr size_t WS_TSLOT = WS_GATE + 4 * MiB;
constexpr size_t WS_ACT = WS_TSLOT + 1 * MiB;
constexpr size_t WS_YS = WS_ACT + 48 * MiB;
constexpr size_t WS_FLOG = WS_YS + 192 * MiB;
constexpr size_t WS_C = WS_FLOG + 1 * MiB;
constexpr size_t WS_QL = WS_C + 1 * MiB;
constexpr size_t WS_KVL = WS_QL + 96 * MiB;
constexpr size_t WS_SK = WS_KVL + 128 * MiB;
constexpr size_t WS_PK = WS_SK + 4 * MiB;
constexpr size_t WS_PF = WS_PK + 16 * MiB;
constexpr size_t WS_PR = WS_PF + 4 * MiB;
constexpr size_t WS_END = WS_PR + 20 * MiB;
constexpr int CW_CNT0 = 1024, CW_CNT1 = 2048;
constexpr int CW_BAR = 4096;
constexpr int LDS_BARW = 155 * 1024, LDS_TS = LDS_BARW + 64, LDS_CN = LDS_BARW + 64 + 272, LDS_TE = LDS_BARW + 64 + 272 + 256, LDS_XS = LDS_BARW + 64 + 272 + 256 + 192, LDS_BYTES = 156 * 1024;

__device__ __forceinline__ float bf2f(unsigned b) { return __uint_as_float(b << 16); }
__device__ __forceinline__ unsigned f2bf(float f) { unsigned u = __float_as_uint(f); return (u + 0x7fffu + ((u >> 16) & 1u)) >> 16; }
__device__ __forceinline__ unsigned pk2(float lo, float hi) { unsigned r; asm("v_cvt_pk_bf16_f32 %0, %1, %2" : "=v"(r) : "v"(lo), "v"(hi)); return r; }
__device__ __forceinline__ float wave_sum(float v) {
#pragma unroll
    for (int o = 1; o < 64; o <<= 1) v += __shfl_xor(v, o);
    return v;
}
__device__ __forceinline__ float wave_max(float v) {
#pragma unroll
    for (int o = 1; o < 64; o <<= 1) v = fmaxf(v, __shfl_xor(v, o));
    return v;
}
__device__ __forceinline__ int otid() { int t = threadIdx.x; asm volatile("" : "+v"(t)); return t; }
__device__ __forceinline__ int obid() { int t = blockIdx.x; asm volatile("" : "+s"(t)); return t; }
__device__ __forceinline__ int ogrid() { int t = gridDim.x; asm volatile("" : "+s"(t)); return t; }
__device__ __forceinline__ float rsq(float x) { return 1.0f / sqrtf(x); }
__device__ __forceinline__ float rope64(float xn, int lane, float pos) {
    const float partner = __shfl_xor(xn, 32);
    const int i = lane & 31;
    const float freq = exp2f(-(float)i * (13.287712379549449f / 32.0f));
    const float ang = pos * freq;
    float rev = ang * 0.15915494309189535f; rev -= floorf(rev);
    const float s = __builtin_amdgcn_sinf(rev), c = __builtin_amdgcn_cosf(rev);
    return lane < 32 ? xn * c - partner * s : xn * c + partner * s;
}

enum { B_N_F32 = 0, B_N_BF16 = 1, B_T_BF16 = 2 };
template <int BMODE, class AP, class BP, class EP>
__device__ __forceinline__ void sg_tile(LAS unsigned char* lds, const AP& ap, const BP& bp, const EP& ep, int kbeg, int kend) {
    const int tid = otid(), wave = tid >> 6, lane = tid & 63, fr = lane & 15, fq = lane >> 4, wm = wave >> 2, wn = wave & 3;
    LAS bf16* sA = (LAS bf16*)lds; LAS bf16* sB = sA + 128 * 40;
    const bf16* pa = ap.row(tid >> 2) + (tid & 3) * 8;
    const int chunk = tid & 15, kk = tid >> 4;
    const bf16* pbt = nullptr; const float* pbf = nullptr; const bf16* pbh = nullptr; int ldb = 0;
    if constexpr (BMODE == B_T_BF16) { pbt = bp.row(tid >> 2); if (pbt) pbt += (tid & 3) * 8; }
    else if constexpr (BMODE == B_N_F32) { pbf = bp.col8(chunk, ldb); }
    else { pbh = bp.col8(chunk, ldb); }
    f32x4 acc[4][2];
#pragma unroll
    for (int mi = 0; mi < 4; ++mi)
#pragma unroll
        for (int ni = 0; ni < 2; ++ni) acc[mi][ni] = (f32x4){0.f, 0.f, 0.f, 0.f};
    for (int k0 = kbeg; k0 < kend; k0 += 32) {
        const u32x4 ra = *(const u32x4*)(pa + k0);
        u32x4 rb = (u32x4){0u, 0u, 0u, 0u};
        if constexpr (BMODE == B_T_BF16) { if (pbt) rb = *(const u32x4*)(pbt + k0); }
        else if constexpr (BMODE == B_N_F32) {
            if (pbf) { const float* p = pbf + (size_t)(k0 + kk) * ldb; const f32x4 x = *(const f32x4*)p, y = *(const f32x4*)(p + 4);
                rb = (u32x4){pk2(x[0], x[1]), pk2(x[2], x[3]), pk2(y[0], y[1]), pk2(y[2], y[3])}; }
        } else { if (pbh) rb = *(const u32x4*)(pbh + (size_t)(k0 + kk) * ldb); }
        __syncthreads();
        *(LAS u32x4*)(sA + (tid >> 2) * 40 + (tid & 3) * 8) = ra;
        if constexpr (BMODE == B_T_BF16) { *(LAS u32x4*)(sB + (tid >> 2) * 40 + (tid & 3) * 8) = rb; }
        else {
#pragma unroll
            for (int j = 0; j < 8; ++j) sB[(chunk * 8 + j) * 40 + kk] = (bf16)((rb[j >> 1] >> ((j & 1) * 16)) & 0xffffu);
        }
        __syncthreads();
        bf16x8 a[4], b[2];
#pragma unroll
        for (int mi = 0; mi < 4; ++mi) a[mi] = *(const LAS bf16x8*)(sA + (wm * 64 + mi * 16 + fr) * 40 + fq * 8);
#pragma unroll
        for (int ni = 0; ni < 2; ++ni) b[ni] = *(const LAS bf16x8*)(sB + (wn * 32 + ni * 16 + fr) * 40 + fq * 8);
#pragma unroll
        for (int mi = 0; mi < 4; ++mi)
#pragma unroll
            for (int ni = 0; ni < 2; ++ni) acc[mi][ni] = __builtin_amdgcn_mfma_f32_16x16x32_bf16(b[ni], a[mi], acc[mi][ni], 0, 0, 0);
    }
#pragma unroll
    for (int mi = 0; mi < 4; ++mi) ep(wm * 64 + mi * 16 + fr, wn * 32 + 4 * fq, acc[mi][0], acc[mi][1]);
}

struct APlain { const bf16* A; size_t lda; __device__ __forceinline__ const bf16* row(int r) const { return A + (size_t)r * lda; } };
struct BPlainF32 { const float* B; int ldb_, ncols; int n0;
    __device__ __forceinline__ const float* col8(int chunk, int& ldb) const { ldb = ldb_; const int c = n0 + chunk * 8; return c < ncols ? B + c : nullptr; } };
struct BPlainBf16 { const bf16* B; int ldb_;
    __device__ __forceinline__ const bf16* col8(int chunk, int& ldb) const { ldb = ldb_; return B + chunk * 8; } };
struct BRowsT { const bf16* Bt; size_t ld; __device__ __forceinline__ const bf16* row(int r) const { return Bt + (size_t)r * ld; } };

__device__ __forceinline__ void store4bf(bf16* p, f32x4 v) { *(u32x2*)p = (u32x2){pk2(v[0], v[1]), pk2(v[2], v[3])}; }
__device__ __forceinline__ void store8bf(bf16* p, f32x4 a, f32x4 b) { *(u32x4*)p = (u32x4){pk2(a[0], a[1]), pk2(a[2], a[3]), pk2(b[0], b[1]), pk2(b[2], b[3])}; }

struct EpBf16 { bf16* C; size_t ldc; int n0, N;
    __device__ __forceinline__ void operator()(int rl, int cl, f32x4 v0, f32x4 v1) const {
        bf16* p = C + (size_t)rl * ldc; const int c = n0 + cl;
        if (c < N) store4bf(p + c, v0);
        if (c + 16 < N) store4bf(p + c + 16, v1); } };
struct EpResF32 { const float* R; float* C; int n0;
    __device__ __forceinline__ void operator()(int rl, int cl, f32x4 v0, f32x4 v1) const {
        const size_t o = (size_t)rl * DM + n0 + cl;
        *(f32x4*)(C + o) = *(const f32x4*)(R + o) + v0; *(f32x4*)(C + o + 16) = *(const f32x4*)(R + o + 16) + v1; } };


#define XB_TMO      128
#define XB_XCNT(j)  (256  + 64 * (j))
#define XB_XSUB(j)  (1280 + 64 * (j))
#define XB_XGEN(j)  (2304 + 64 * (j))
#define XB_TOP      3328
#define XB_TOPGEN   3392
#define XCD_BAR_WORDS 3456
#define XB_SPIN_CAP (1u << 18)

__device__ __forceinline__ unsigned xb_ld(unsigned* p)              { return __hip_atomic_load(p, __ATOMIC_RELAXED, __HIP_MEMORY_SCOPE_AGENT); }
__device__ __forceinline__ unsigned xb_add(unsigned* p, unsigned v) { return __hip_atomic_fetch_add(p, v, __ATOMIC_RELAXED, __HIP_MEMORY_SCOPE_AGENT); }
__device__ __forceinline__ unsigned xb_xcc_id() { return (unsigned)__builtin_amdgcn_s_getreg((3 << 11) | 20) & 0xFu; }
#define XB_SPIN(cond, bar) do { unsigned _sp = 0; while (cond) { __builtin_amdgcn_s_sleep(1); \
    if ((++_sp & 255u) == 0u) { if (xb_ld(&(bar)[XB_TMO])) break; if (_sp > XB_SPIN_CAP) { atomicAdd(&(bar)[XB_TMO], 1u); break; } } } } while (0)

struct XcdBarrier {
    unsigned* bar; unsigned x;
    volatile LAS unsigned* st;
};

__device__ __forceinline__ XcdBarrier xcd_barrier_post(unsigned* bar, volatile LAS unsigned* st) {
    XcdBarrier b; b.bar = bar; b.x = xb_xcc_id(); b.st = st;
    if (threadIdx.x == 0) (void)xb_add(&bar[XB_XCNT(b.x)], 1u);
    return b;
}
__device__ __forceinline__ void xcd_barrier_complete(unsigned* bar, unsigned x, unsigned& nloc, unsigned& nx) {
    const unsigned G = gridDim.x * gridDim.y * gridDim.z;
    unsigned sum, cnt, mine, sp = 0u;
    for (;;) {
        sum = 0u; cnt = 0u; mine = 0u;
#pragma unroll
        for (unsigned j = 0; j < 16; ++j) { const unsigned c = xb_ld(&bar[XB_XCNT(j)]); sum += c; cnt += (c > 0u) ? 1u : 0u; mine = (j == x) ? c : mine; }
        if (sum == G) break;
        __builtin_amdgcn_s_sleep(1);
        if ((++sp & 255u) == 0u) { if (xb_ld(&bar[XB_TMO])) break; if (sp > XB_SPIN_CAP) { atomicAdd(&bar[XB_TMO], 1u); break; } }
    }
    nloc = mine > 0u ? mine : 1u; nx = cnt > 0u ? cnt : 1u;
}

__device__ __forceinline__ void xcd_barrier(const XcdBarrier& b) {
    asm volatile("s_waitcnt vmcnt(0)" ::: "memory");
    __syncthreads();
    if (threadIdx.x == 0) {
        unsigned* bar = b.bar;
        __builtin_amdgcn_s_waitcnt(0);
        unsigned nloc = b.st[0], nx = b.st[1];
        if (nloc == 0u) { xcd_barrier_complete(bar, b.x, nloc, nx); b.st[0] = nloc; b.st[1] = nx; }
        const unsigned old = xb_add(&bar[XB_XSUB(b.x)], 1u);
        const unsigned gen = old / nloc;
        if (old + 1u == (gen + 1u) * nloc) {
            __builtin_amdgcn_fence(__ATOMIC_RELEASE, "agent");
            asm volatile("s_waitcnt vmcnt(0)" ::: "memory");
            const unsigned og = xb_add(&bar[XB_TOP], 1u);
            const unsigned tg = og / nx;
            if (og + 1u == (tg + 1u) * nx) xb_add(&bar[XB_TOPGEN], 1u);
            else XB_SPIN(xb_ld(&bar[XB_TOPGEN]) == tg, bar);
            __builtin_amdgcn_fence(__ATOMIC_ACQUIRE, "agent");
            xb_add(&bar[XB_XGEN(b.x)], 1u);
            asm volatile("s_waitcnt vmcnt(0)" ::: "memory");
        } else {
            XB_SPIN(xb_ld(&bar[XB_XGEN(b.x)]) == gen, bar);
            __builtin_amdgcn_fence(__ATOMIC_ACQUIRE, "agent");
            asm volatile("s_waitcnt vmcnt(0)" ::: "memory");
        }
    }
    __syncthreads();
}

namespace fg {
constexpr int BM = 256, BK = 64, HALF = 128, HTB = HALF * BK * 2, STAGE_BYTES = 8 * HTB;
__host__ __device__ __forceinline__ int lds_byte(int r, int c) { const int st = (r >> 4) * 2 + (c >> 5), rr = r & 15, cc = c & 31, ob = rr * 64 + cc * 2; return st * 1024 + (ob ^ (((ob >> 9) & 1) << 5)); }
__host__ __device__ __forceinline__ void stage_rc(int b, int& R, int& C) { const int st = b / 1024, sb = b % 1024, swz = sb ^ (((sb >> 9) & 1) << 5); R = (st >> 1) * 16 + swz / 64; C = (st & 1) * 32 + (swz % 64) / 2; }

template <bool GATHER, class Unit, class Epi, class Sched>
__device__ __forceinline__ void gemm_phase(LAS unsigned char* lds, const int K, const Sched& S, const Epi& E) {
    const int tid = otid(), wid = __builtin_amdgcn_readfirstlane(tid >> 6), lane = tid & 63, wr = wid >> 2, wc = wid & 3, fr = lane & 15, fq = lane >> 4;
    const int nt = K / BK;
    int R0, C0, R1, C1; stage_rc(tid * 16, R0, C0); stage_rc(tid * 16 + 8192, R1, C1);
    const int Rb0 = (R0 & ~31) + 8 * ((R0 & 15) >> 2) + 4 * ((R0 >> 4) & 1) + (R0 & 3), Rb1 = (R1 & ~31) + 8 * ((R1 & 15) >> 2) + 4 * ((R1 >> 4) & 1) + (R1 & 3);
    const unsigned voffB0 = (unsigned)(Rb0 * K + C0) * 2u, voffB1 = (unsigned)(Rb1 * K + C1) * 2u;
    const size_t kstep = (size_t)(BK * 2);
    const size_t hstepB = (size_t)HALF * K * 2;
    const unsigned ldsw = (unsigned)wid * 1024u;
    const int aoff = lds_byte(wr * 64 + fr, fq * 8), boff = lds_byte(wc * 32 + fr, fq * 8);
#define FG_SA(b, h) (((b) * 2 + (h)) * HTB)
#define FG_SB(b, h) ((4 + (b) * 2 + (h)) * HTB)
#define FG_STAGE(bufoff, gbase, v0, v1) do { \
        __builtin_amdgcn_global_load_lds((const unsigned*)((const char*)(gbase) + (v0)), (LAS unsigned*)(lds + (bufoff) + ldsw), 16, 0, 0); \
        __builtin_amdgcn_global_load_lds((const unsigned*)((const char*)(gbase) + (v1)), (LAS unsigned*)(lds + (bufoff) + ldsw + 8192), 16, 0, 0); } while (0)
#define FG_LDA(dst, b, h) do { _Pragma("unroll") for (int m = 0; m < 4; ++m) _Pragma("unroll") for (int k = 0; k < 2; ++k) dst[m][k] = *(const LAS bf16x8*)(lds + FG_SA(b, h) + aoff + m * 2048 + k * 1024); } while (0)
#define FG_LDB(dst, b, h) do { _Pragma("unroll") for (int n = 0; n < 2; ++n) _Pragma("unroll") for (int k = 0; k < 2; ++k) dst[n][k] = *(const LAS bf16x8*)(lds + FG_SB(b, h) + boff + n * 2048 + k * 1024); } while (0)
#define FG_MMA(ai, bj, At, Bt) do { __builtin_amdgcn_s_setprio(1); _Pragma("unroll") for (int m = 0; m < 4; ++m) _Pragma("unroll") for (int n = 0; n < 2; ++n) _Pragma("unroll") for (int k = 0; k < 2; ++k) \
        acc[ai][bj][m][n] = __builtin_amdgcn_mfma_f32_16x16x32_bf16(Bt[n][k], At[m][k], acc[ai][bj][m][n], 0, 0, 0); __builtin_amdgcn_s_setprio(0); } while (0)
#define FG_WAIT_V(n) asm volatile("s_waitcnt vmcnt(" #n ")" ::: "memory")
#define FG_WAIT_L(n) asm volatile("s_waitcnt lgkmcnt(" #n ")" ::: "memory")
#define FG_BAR __builtin_amdgcn_s_barrier()
#define FG_SCHED __builtin_amdgcn_sched_barrier(0)
    Unit cur, nxt; int ui = 0;
    if (!S.next(0, cur)) return;
    f32x4 acc[2][2][4][2];
#pragma unroll
    for (int a = 0; a < 2; ++a)
#pragma unroll
        for (int b = 0; b < 2; ++b)
#pragma unroll
            for (int m = 0; m < 4; ++m)
#pragma unroll
                for (int n = 0; n < 2; ++n) acc[a][b][m][n] = (f32x4){0.f, 0.f, 0.f, 0.f};
    bf16x8 At[4][2], B0[2][2], B1[2][2];
    const char* cA = S.a_base(cur); const char* cB = S.b_base(cur);
    unsigned vA00 = S.a_voff(cur, R0, C0), vA01 = S.a_voff(cur, R1, C1), vA10 = S.a_voff(cur, HALF + R0, C0), vA11 = S.a_voff(cur, HALF + R1, C1);
    unsigned vN00 = vA00, vN01 = vA01, vN10 = vA10, vN11 = vA11;
    bool hi_on = !S.lo_only(cur);
    FG_STAGE(FG_SB(0, 0), cB, voffB0, voffB1); FG_STAGE(FG_SB(0, 1), cB + hstepB, voffB0, voffB1); FG_STAGE(FG_SA(0, 0), cA, vA00, vA01); FG_STAGE(FG_SA(0, 1), cA, vA10, vA11);
    if (wr == 1) FG_BAR;
    FG_WAIT_V(2); FG_BAR;
    FG_STAGE(FG_SB(1, 0), cB + kstep, voffB0, voffB1); FG_STAGE(FG_SA(1, 0), cA + kstep, vA00, vA01); FG_STAGE(FG_SB(1, 1), cB + hstepB + kstep, voffB0, voffB1);
    FG_WAIT_V(6); FG_BAR;
    for (;;) {
        const bool has_next = S.next(ui + 1, nxt);
        const char* nA = has_next ? S.a_base(nxt) : cA; const char* nB = has_next ? S.b_base(nxt) : cB;
        if (GATHER) { if (has_next) { vN00 = S.a_voff(nxt, R0, C0); vN01 = S.a_voff(nxt, R1, C1); vN10 = S.a_voff(nxt, HALF + R0, C0); vN11 = S.a_voff(nxt, HALF + R1, C1); }
                      else { vN00 = vA00; vN01 = vA01; vN10 = vA10; vN11 = vA11; } }
        for (int t = 0; t < nt; t += 2) {
            const bool last = (t == nt - 2);
            const char* a1 = cA + (size_t)(t + 1) * kstep;
            const char* a2 = last ? nA : cA + (size_t)(t + 2) * kstep; const char* b2 = last ? nB : cB + (size_t)(t + 2) * kstep;
            const char* a3 = a2 + kstep; const char* b3 = b2 + kstep;
            const unsigned x00 = (GATHER && last) ? vN00 : vA00, x01 = (GATHER && last) ? vN01 : vA01, x10 = (GATHER && last) ? vN10 : vA10, x11 = (GATHER && last) ? vN11 : vA11;
            FG_LDB(B0, 0, 0); FG_LDB(B1, 0, 1); FG_SCHED; FG_LDA(At, 0, 0); FG_STAGE(FG_SA(1, 1), a1, vA10, vA11);
            FG_WAIT_V(8); FG_WAIT_L(0); FG_BAR; FG_MMA(0, 0, At, B0); FG_MMA(0, 1, At, B1); FG_BAR; FG_SCHED;
            FG_LDA(At, 0, 1); FG_STAGE(FG_SB(0, 0), b2, voffB0, voffB1); FG_STAGE(FG_SB(0, 1), b2 + hstepB, voffB0, voffB1); FG_STAGE(FG_SA(0, 0), a2, x00, x01);
            FG_WAIT_V(8); FG_WAIT_L(0); FG_BAR; if (hi_on) { FG_MMA(1, 0, At, B0); FG_MMA(1, 1, At, B1); } FG_BAR; FG_SCHED;
            FG_LDB(B0, 1, 0); FG_LDB(B1, 1, 1); FG_SCHED; FG_LDA(At, 1, 0); FG_STAGE(FG_SA(0, 1), a2, x10, x11);
            FG_WAIT_V(8); FG_WAIT_L(0); FG_BAR; FG_MMA(0, 0, At, B0); FG_MMA(0, 1, At, B1); FG_BAR; FG_SCHED;
            FG_LDA(At, 1, 1); FG_STAGE(FG_SB(1, 0), b3, voffB0, voffB1); FG_STAGE(FG_SB(1, 1), b3 + hstepB, voffB0, voffB1); FG_STAGE(FG_SA(1, 0), a3, x00, x01);
            FG_WAIT_V(8); FG_WAIT_L(0); FG_BAR; if (hi_on) { FG_MMA(1, 0, At, B0); FG_MMA(1, 1, At, B1); } FG_BAR; FG_SCHED;
        }
        if (wr == 0) FG_BAR;
        { int tz = threadIdx.x; asm volatile("" : "+v"(tz));
          const int lz = tz & 63; E(acc, cur, (tz >> 6) >> 2, (tz >> 6) & 3, lz & 15, lz >> 4); }
        if (!has_next) break;
#pragma unroll
        for (int a = 0; a < 2; ++a)
#pragma unroll
            for (int b = 0; b < 2; ++b)
#pragma unroll
                for (int m = 0; m < 4; ++m)
#pragma unroll
                    for (int n = 0; n < 2; ++n) acc[a][b][m][n] = (f32x4){0.f, 0.f, 0.f, 0.f};
        cur = nxt; cA = nA; cB = nB; ++ui; hi_on = !S.lo_only(cur);
        if (GATHER) { vA00 = vN00; vA01 = vN01; vA10 = vN10; vA11 = vN11; }
        if (wr == 1) FG_BAR;
    }
    FG_WAIT_V(0);
    FG_BAR;
#undef FG_SA
#undef FG_SB
#undef FG_STAGE
#undef FG_LDA
#undef FG_LDB
#undef FG_MMA
#undef FG_WAIT_V
#undef FG_WAIT_L
#undef FG_BAR
#undef FG_SCHED
}

struct DUnit { int p, pm, pn, par; };
struct DenseSched {
    const bf16* A0; const bf16* B0; int nN0; const bf16* A1; const bf16* B1; int nN1; int K, G, c;
    static constexpr int nM = T / 256, NXCD = 8, WGM = 8;
    __device__ __forceinline__ bool next(int i, DUnit& u) const {
        long L = (long)i * G + c; const int nwg0 = nM * nN0, nwg1 = nM * nN1;
        int nN, nwg; if (L < nwg0) { u.p = 0; nN = nN0; nwg = nwg0; } else { L -= nwg0; if (L >= nwg1) return false; u.p = 1; nN = nN1; nwg = nwg1; }
        int wgid = (int)L; { const int q = nwg / NXCD, r = nwg % NXCD, xcd = wgid % NXCD, off = wgid / NXCD; wgid = (xcd < r ? xcd * (q + 1) : r * (q + 1) + (xcd - r) * q) + off; }
        const int nig = WGM * nN, gid = wgid / nig, fm = gid * WGM, gsz = (nM - fm) < WGM ? (nM - fm) : WGM;
        u.pm = fm + ((wgid % nig) % gsz); u.pn = (wgid % nig) / gsz; u.par = i & 1; return true;
    }
    __device__ __forceinline__ const char* a_base(const DUnit& u) const { return (const char*)(u.p ? A1 : A0) + (size_t)u.pm * 256 * K * 2; }
    __device__ __forceinline__ const char* b_base(const DUnit& u) const { return (const char*)(u.p ? B1 : B0) + (size_t)u.pn * 256 * K * 2; }
    __device__ __forceinline__ unsigned a_voff(const DUnit&, int row, int col) const { return (unsigned)(row * K + col) * 2u; }
    __device__ __forceinline__ bool lo_only(const DUnit&) const { return false; }
};
struct SkUnit { int pm, ks; };
struct SkinnySched {
    const char* A; const char* B; int G, c;
    __device__ __forceinline__ bool next(int i, SkUnit& u) const { const int L = i * G + c; if (L >= (T / 256) * 4) return false; u.pm = L >> 2; u.ks = L & 3; return true; }
    __device__ __forceinline__ const char* a_base(const SkUnit& u) const { return A + ((size_t)u.pm * 256 * DM + u.ks * 512) * 2; }
    __device__ __forceinline__ const char* b_base(const SkUnit& u) const { return B + (size_t)u.ks * 256 * 512 * 2; }
    __device__ __forceinline__ unsigned a_voff(const SkUnit&, int row, int col) const { return (unsigned)(row * DM + col) * 2u; }
    __device__ __forceinline__ bool lo_only(const SkUnit&) const { return false; }
};
#define FG_FOREACH(acc, BODY) do { _Pragma("unroll") for (int ai = 0; ai < 2; ++ai) _Pragma("unroll") for (int m = 0; m < 4; ++m) { const int row = ai * 128 + wr * 64 + m * 16 + fr; \
        _Pragma("unroll") for (int bj = 0; bj < 2; ++bj) { const int col = bj * 128 + wc * 32 + 8 * fq; const f32x4 v0 = acc[ai][bj][m][0], v1 = acc[ai][bj][m][1]; BODY } } } while (0)
}

template <class RowMap>
__device__ __forceinline__ void transpose_item(const float* W, int K, int N, bf16* WT, const RowMap& rowmap, LAS float* scr, int item, int lane) {
    const int nblk = (N + 31) / 32, kb = item / nblk, nb = item % nblk, k0 = 64 * kb, n0 = 32 * nb; const bool cv = n0 + (lane & 31) < N;
#pragma unroll 8
    for (int i = 0; i < 32; ++i) { const int kk = 2 * i + (lane >> 5); scr[kk * 33 + (lane & 31)] = cv ? W[(size_t)(k0 + kk) * N + n0 + (lane & 31)] : 0.f; }
    asm volatile("s_waitcnt lgkmcnt(0)" ::: "memory");
    const int c = lane & 7;
#pragma unroll
    for (int j = 0; j < 4; ++j) { const int n = (lane >> 3) + 8 * j; const LAS float* sp = scr + (8 * c) * 33 + n;
        u32x4 o; o.x = pk2(sp[0 * 33], sp[1 * 33]); o.y = pk2(sp[2 * 33], sp[3 * 33]); o.z = pk2(sp[4 * 33], sp[5 * 33]); o.w = pk2(sp[6 * 33], sp[7 * 33]);
        const int dr = rowmap(n0 + n);
        if (dr >= 0) *(u32x4*)(WT + (size_t)dr * K + k0 + 8 * c) = o; }
    asm volatile("s_waitcnt lgkmcnt(0)" ::: "memory");
}
template <class RowMap>
__device__ __forceinline__ void transpose_item16(const float* W, int K, int N, bf16* WT, const RowMap& rowmap, LAS unsigned char* scr, int item, int lane) {
    const int nblk = (N + 31) / 32, kb = item / nblk, nb = item % nblk, k0 = 64 * kb, n0 = 32 * nb, c = lane & 7, rr = lane >> 3; const bool cv = n0 + 4 * c < N;
    f32x4 v[8];
#pragma unroll
    for (int i = 0; i < 8; ++i) v[i] = cv ? __builtin_nontemporal_load((const f32x4*)(W + (size_t)(k0 + 8 * i + rr) * N + n0 + 4 * c)) : (f32x4){0.f, 0.f, 0.f, 0.f};
#pragma unroll
    for (int i = 0; i < 8; ++i) *(LAS f32x4*)(scr + (8 * i + rr) * 128 + ((c ^ i) << 4)) = v[i];
    asm volatile("s_waitcnt lgkmcnt(0)" ::: "memory");
    float t[4][8];
#pragma unroll
    for (int j = 0; j < 4; ++j) { const int n = rr + 8 * j; const LAS float* sp = (const LAS float*)scr + (8 * c) * 32 + (((n >> 2) ^ c) << 2) + (n & 3);
#pragma unroll
        for (int q = 0; q < 8; ++q) t[j][q] = sp[32 * q]; }
    asm volatile("s_waitcnt lgkmcnt(0)" ::: "memory");
#pragma unroll
    for (int j = 0; j < 4; ++j) { const int n = rr + 8 * j, dr = rowmap(n0 + n);
        if (dr >= 0) *(u32x4*)(WT + (size_t)dr * K + k0 + 8 * c) = (u32x4){pk2(t[j][0], t[j][1]), pk2(t[j][2], t[j][3]), pk2(t[j][4], t[j][5]), pk2(t[j][6], t[j][7])}; }
}
__device__ __forceinline__ void zero_rows(bf16* WT, int K, int r0, int r1, int gw, int ngw, int lane) {
    const size_t n8 = (size_t)(r1 - r0) * K / 8; u32x4* p = (u32x4*)(WT + (size_t)r0 * K);
    for (size_t i = (size_t)gw * 64 + lane; i < n8; i += (size_t)ngw * 64) p[i] = (u32x4){0u, 0u, 0u, 0u};
}

struct Args { const void* in[29]; float* out; unsigned char* ws; };
__device__ __forceinline__ int hide(int i) { asm volatile("" : "+s"(i)); return i; }
__device__ __forceinline__ const void* arg_ptr(int i) {
    typedef const void* cvp;
    const __attribute__((address_space(4))) cvp* ka = (const __attribute__((address_space(4))) cvp*)__builtin_amdgcn_kernarg_segment_ptr();
    return ka[hide(i)];
}
#define INF(i) ((const float*)arg_ptr(i))
#define PH_BEGIN unsigned char* ws = (unsigned char*)arg_ptr(30); \
    const int tid = otid(), lane = tid & 63, wave = tid >> 6, G = ogrid(), bx = obid(), gw = bx * NWAVES + wave, ngw = G * NWAVES; (void)lane; (void)gw; (void)ngw; (void)ws
#define WSP(TYPE, OFF) ((TYPE*)(ws + (OFF)))

__device__ __forceinline__ void unpack8(u32x4 w, float (&x)[8]) {
#pragma unroll
    for (int j = 0; j < 4; ++j) { x[2 * j] = bf2f(w[j] & 0xffffu); x[2 * j + 1] = bf2f(w[j] >> 16); }
}
__device__ __forceinline__ f32x4 bf4(u32x2 w) { return (f32x4){bf2f(w[0] & 0xffffu), bf2f(w[0] >> 16), bf2f(w[1] & 0xffffu), bf2f(w[1] >> 16)}; }

__device__ __forceinline__ void moe_prefix(LAS unsigned char* lds, const unsigned* cnt) {
    LAS int* s_ts = (LAS int*)(lds + LDS_TS); LAS int* s_cn = (LAS int*)(lds + LDS_CN);
    LAS unsigned char* s_te = lds + LDS_TE;
    LAS int* s_xs = (LAS int*)(lds + LDS_XS);
    const int tz_ = otid();
    if (tz_ < 64) { const int e = tz_; const int c = (int)cnt[e], nt = (c + 255) >> 8;
        int incl = nt;
#pragma unroll
        for (int o = 1; o < 64; o <<= 1) { const int up = __shfl_up(incl, o); if (e >= o) incl += up; }
        const int excl = incl - nt;
        s_ts[e] = excl; s_cn[e] = c;
        for (int i = 0; i < nt; ++i) s_te[excl + i] = (unsigned char)e;
        const int x = obid() & 7; int a2 = 0;
#pragma unroll
        for (int k = 0; k < 8; ++k) { const int tk = __shfl(nt, x + 8 * k); if (e == 0) s_xs[k] = a2; a2 += tk; }
        if (e == 0) s_xs[8] = a2; }
    __syncthreads();
}

__device__ __forceinline__ void ph_convert_dense(LAS unsigned char* lds) {
    PH_BEGIN;
    LAS unsigned char* scr = lds + wave * 8192;
    const float* w_in0 = INF(3); const float* w_uq = INF(6); const float* w_ukv = INF(7); const float* w_o0 = INF(9); const float* w_in1 = INF(18); const float* w_o1 = INF(21);
    bf16* W_IN0T = WSP(bf16, WS_W_IN0T); bf16* W_UQT = WSP(bf16, WS_W_UQT); bf16* W_UKVT = WSP(bf16, WS_W_UKVT); bf16* W_O0T = WSP(bf16, WS_W_O0T); bf16* W_IN1T = WSP(bf16, WS_W_IN1T); bf16* W_O1T = WSP(bf16, WS_W_O1T);
    constexpr int I0 = 32 * 34, I1 = 8 * 96, I2 = 8 * 128, I3 = 32 * 64, I4 = 32 * 257, I5 = 32 * 64;
    auto ident = [](int n) { return n; };
    auto map0 = [](int n) { return n < 1024 ? n : -1; };
    auto map1 = [](int n) { return n < 6144 ? n : (n < 6160 ? -1 : (n < 8208 ? n - 16 : -1)); };
    for (int it = gw; it < I0 + I1 + I2 + I3 + I4 + I5; it += ngw) {
        int r = it;
        if (r < I0) { transpose_item16(w_in0, DM, 1088, W_IN0T, map0, scr, r, lane); continue; } r -= I0;
        if (r < I1) { transpose_item16(w_uq, 512, 3072, W_UQT, ident, scr, r, lane); continue; } r -= I1;
        if (r < I2) { transpose_item16(w_ukv, 512, 4096, W_UKVT, ident, scr, r, lane); continue; } r -= I2;
        if (r < I3) { transpose_item16(w_o0, DM, DM, W_O0T, ident, scr, r, lane); continue; } r -= I3;
        if (r < I4) { transpose_item16(w_in1, DM, 8208, W_IN1T, map1, scr, r, lane); continue; } r -= I4;
        transpose_item16(w_o1, DM, DM, W_O1T, ident, scr, r, lane);
    }
    { bf16* SK = WSP(bf16, WS_SK); const float* w_rg0 = INF(11); const float* w_re0 = INF(13); const float* w_rg1 = INF(23); const float* w_re1 = INF(25);
      for (int idx = bx * NTHREADS + tid; idx < 4 * 256 * 256; idx += G * NTHREADS) {
          const int set = idx >> 16, n = (idx >> 8) & 255, k = (idx & 255) * 8, ks = k >> 9;
          float v[8];
#pragma unroll
          for (int i = 0; i < 8; ++i) { float x = 0.f;
              if (set == 0) { if (n < 64) x = w_in0[(size_t)(k + i) * 1088 + 1024 + n]; }
              else if (set == 1) { if (n < 16) x = w_in1[(size_t)(k + i) * 8208 + 6144 + n]; }
              else { const float* wg = set == 2 ? w_rg0 : w_rg1; const float* we = set == 2 ? w_re0 : w_re1; if (n < 8) x = wg[(k + i) * 8 + n]; else if (n < 72) x = we[(k + i) * 64 + n - 8]; }
              v[i] = x; }
          *(u32x4*)(SK + (size_t)set * (4 * 256 * 512) + ((size_t)ks * 256 + n) * 512 + (k & 511)) = (u32x4){pk2(v[0], v[1]), pk2(v[2], v[3]), pk2(v[4], v[5]), pk2(v[6], v[7])}; } }
}
template <int layer>
__device__ __forceinline__ void ph_convert_moe(LAS unsigned char* lds) {
    PH_BEGIN;
    LAS float* scr = (LAS float*)(lds + wave * 8448);
    const float* w_gu = INF(layer == 0 ? 15 : 27); const float* w_dn = INF(layer == 0 ? 16 : 28);
    bf16* W_GUT = WSP(bf16, WS_W_GUT); bf16* W_DT = WSP(bf16, WS_W_DT);
    auto gumap = [](int n) { const int which = n >> 9, f = n & 511; return (f >> 7) * 256 + ((f >> 6) & 1) * 128 + ((f >> 4) & 3) * 32 + ((f >> 2) & 3) * 8 + which * 4 + (f & 3); };
    auto ident = [](int n) { return n; };
    constexpr int IG = 32 * 32, ID = 8 * 64;
    for (int it = gw; it < NEXP * (IG + ID); it += ngw) {
        if (it < NEXP * IG) { const int e = it / IG, r = it % IG; transpose_item(w_gu + (size_t)e * DM * 1024, DM, 1024, W_GUT + (size_t)e * 1024 * DM, gumap, scr, r, lane); }
        else { const int v = it - NEXP * IG, e = v / ID, r = v % ID; transpose_item(w_dn + (size_t)e * DEXP * DM, DEXP, DM, W_DT + (size_t)e * DM * DEXP, ident, scr, r, lane); }
    }
}

template <int MODE>
__device__ __forceinline__ void norm_rows(LAS unsigned char* lds, float* in, const float* gain, const unsigned* cnt) {
    PH_BEGIN;
    bf16* HN = WSP(bf16, WS_HN); const bf16* YS = WSP(bf16, WS_YS); const int* TSLOT = WSP(int, WS_TSLOT); bf16* H1b = WSP(bf16, WS_H1);
    if (MODE != 0) moe_prefix(lds, cnt);
    const LAS int* s_ts = (const LAS int*)(lds + LDS_TS);
    for (int m = gw; m < T; m += ngw) {
        float* xr = in + (size_t)m * DM + 8 * lane; bf16* hb = H1b + (size_t)m * DM + 8 * lane;
        f32x4 v[8]; float ss = 0.f;
        const bf16* y0 = nullptr; const bf16* y1 = nullptr;
        if (MODE != 0) { const int s0 = TSLOT[2 * m], s1 = TSLOT[2 * m + 1];
            y0 = YS + ((size_t)s_ts[s0 >> 16] * 256 + (s0 & 0xffff)) * DM + 8 * lane; y1 = YS + ((size_t)s_ts[s1 >> 16] * 256 + (s1 & 0xffff)) * DM + 8 * lane; }
#pragma unroll
        for (int jj = 0; jj < 4; ++jj) {
            if (MODE == 0) { v[2 * jj] = *(const f32x4*)(xr + 512 * jj); v[2 * jj + 1] = *(const f32x4*)(xr + 512 * jj + 4); }
            else { const u32x4 wh = *(const u32x4*)(hb + 512 * jj), wa = *(const u32x4*)(y0 + 512 * jj), wb = *(const u32x4*)(y1 + 512 * jj);
                v[2 * jj] = bf4((u32x2){wh[0], wh[1]}) + bf4((u32x2){wa[0], wa[1]}) + bf4((u32x2){wb[0], wb[1]});
                v[2 * jj + 1] = bf4((u32x2){wh[2], wh[3]}) + bf4((u32x2){wa[2], wa[3]}) + bf4((u32x2){wb[2], wb[3]});
                if (MODE == 1) store8bf(hb + 512 * jj, v[2 * jj], v[2 * jj + 1]);
                else { *(f32x4*)(xr + 512 * jj) = v[2 * jj]; *(f32x4*)(xr + 512 * jj + 4) = v[2 * jj + 1]; } }
#pragma unroll
            for (int e = 0; e < 2; ++e) { const f32x4 w = v[2 * jj + e]; ss += (w[0] * w[0] + w[1] * w[1]) + (w[2] * w[2] + w[3] * w[3]); } }
        if (MODE != 2) {
            ss = wave_sum(ss);
            const float r = rsq(ss * (1.0f / DM) + EPS);
#pragma unroll
            for (int jj = 0; jj < 4; ++jj) { const f32x4 g0 = *(const f32x4*)(gain + 8 * lane + 512 * jj), g1 = *(const f32x4*)(gain + 8 * lane + 512 * jj + 4);
                store8bf(HN + (size_t)m * DM + 8 * lane + 512 * jj, v[2 * jj] * r * g0, v[2 * jj + 1] * r * g1); }
        }
    }
}

template <int NC>
__device__ __forceinline__ void skinny_gemm(LAS unsigned char* lds, const bf16* HN, const bf16* SKset, float* P, int G, int bx) {
    fg::SkinnySched S{(const char*)HN, (const char*)SKset, G, bx};
    auto E = [=](const f32x4 (&acc)[2][2][4][2], const fg::SkUnit& u, int wr, int wc, int fr, int fq) {
        float* Pt = P + ((size_t)u.ks * T + (size_t)u.pm * 256) * NC;
        FG_FOREACH(acc, { if (col < NC) { *(f32x4*)(Pt + (size_t)row * NC + col) = v0; *(f32x4*)(Pt + (size_t)row * NC + col + 4) = v1; } }); };
    fg::gemm_phase<false, fg::SkUnit>(lds, 512, S, E);
}
constexpr int LDS_EPI_TAB = 131072;
template <int HMASK>
__device__ __forceinline__ void epi_head_rstd(LAS unsigned char* lds, const f32x4 (&acc)[2][2][4][2], int par, int wr, int wc, int fr, int fq, float (&rstd)[2][4][2]) {
    LAS float* tab = (LAS float*)(lds + LDS_EPI_TAB) + par * 2048;
#pragma unroll
    for (int ai = 0; ai < 2; ++ai)
#pragma unroll
        for (int m = 0; m < 4; ++m) { const int row = ai * 128 + wr * 64 + m * 16 + fr;
#pragma unroll
            for (int bj = 0; bj < 2; ++bj) if (HMASK & (1 << bj)) { const f32x4 a = acc[ai][bj][m][0], b = acc[ai][bj][m][1];
                float ss = (a[0] * a[0] + a[1] * a[1]) + (a[2] * a[2] + a[3] * a[3]) + (b[0] * b[0] + b[1] * b[1]) + (b[2] * b[2] + b[3] * b[3]);
                ss += __shfl_xor(ss, 16); ss += __shfl_xor(ss, 32);
                if (fq == 0) tab[(row * 2 + bj) * 4 + wc] = ss; } }
    asm volatile("s_waitcnt lgkmcnt(0)" ::: "memory"); __builtin_amdgcn_s_barrier(); asm volatile("" ::: "memory");
#pragma unroll
    for (int ai = 0; ai < 2; ++ai)
#pragma unroll
        for (int m = 0; m < 4; ++m) { const int row = ai * 128 + wr * 64 + m * 16 + fr;
#pragma unroll
            for (int bj = 0; bj < 2; ++bj) { rstd[ai][m][bj] = 1.f;
                if (HMASK & (1 << bj)) { const f32x4 t = *(const LAS f32x4*)(tab + (row * 2 + bj) * 4); rstd[ai][m][bj] = rsq(((t[0] + t[1]) + (t[2] + t[3])) * (1.0f / 128) + EPS); } } }
}
template <int layer>
__device__ __forceinline__ void ph_gemm_z(LAS unsigned char* lds) {
    PH_BEGIN;
    bf16* HN = WSP(bf16, WS_HN); bf16* Z = WSP(bf16, WS_Z);
    if (layer == 0) {
        fg::DenseSched S{HN, WSP(bf16, WS_W_IN0T), 4, nullptr, nullptr, 0, DM, G, bx};
        auto E = [=](const f32x4 (&acc)[2][2][4][2], const fg::DUnit& u, int wr, int wc, int fr, int fq) {
            bf16* Zt = Z + (size_t)u.pm * 256 * 1024 + u.pn * 256;
            FG_FOREACH(acc, { store8bf(Zt + (size_t)row * 1024 + col, v0, v1); }); };
        fg::gemm_phase<false, fg::DUnit>(lds, DM, S, E);
        skinny_gemm<64>(lds, HN, WSP(bf16, WS_SK), WSP(float, WS_PK), G, bx);
    } else {
        fg::DenseSched S{HN, WSP(bf16, WS_W_IN1T), 32, nullptr, nullptr, 0, DM, G, bx};
        const float* gk = INF(20) + 128;
        auto E = [=](const f32x4 (&acc)[2][2][4][2], const fg::DUnit& u, int wr, int wc, int fr, int fq) {
            bf16* Zt = Z + (size_t)u.pm * 256 * 8192 + u.pn * 256;
            if (u.pn < 8 || u.pn >= 16) { FG_FOREACH(acc, { store8bf(Zt + (size_t)row * 8192 + col, v0, v1); }); }
            else {
                float rstd[2][4][2]; epi_head_rstd<3>(lds, acc, u.par, wr, wc, fr, fq, rstd);
                const f32x4 g0 = *(const f32x4*)(gk + wc * 32 + 8 * fq), g1 = *(const f32x4*)(gk + wc * 32 + 8 * fq + 4);
#pragma unroll
                for (int ai = 0; ai < 2; ++ai)
#pragma unroll
                    for (int m = 0; m < 4; ++m) { const int row = ai * 128 + wr * 64 + m * 16 + fr;
#pragma unroll
                        for (int bj = 0; bj < 2; ++bj) { const float r = rstd[ai][m][bj];
                            store8bf(Zt + (size_t)row * 8192 + bj * 128 + wc * 32 + 8 * fq, acc[ai][bj][m][0] * r * g0, acc[ai][bj][m][1] * r * g1); } } } };
        fg::gemm_phase<false, fg::DUnit>(lds, DM, S, E);
        skinny_gemm<16>(lds, HN, WSP(bf16, WS_SK) + (size_t)1 * 4 * 256 * 512, WSP(float, WS_PF), G, bx);
    }
}
__device__ __forceinline__ void ph_gemm_qkv(LAS unsigned char* lds) {
    PH_BEGIN;
    bf16* QL = WSP(bf16, WS_QL); bf16* KVL = WSP(bf16, WS_KVL);
    fg::DenseSched S{WSP(bf16, WS_CQN), WSP(bf16, WS_W_UQT), 12, WSP(bf16, WS_CKVN), WSP(bf16, WS_W_UKVT), 16, 512, G, bx};
    const float* gk = INF(8) + 192;
    auto E = [=](const f32x4 (&acc)[2][2][4][2], const fg::DUnit& u, int wr, int wc, int fr, int fq) {
        if (u.p == 0) { bf16* Ct = QL + (size_t)u.pm * 256 * 3072 + u.pn * 256;
            FG_FOREACH(acc, { store8bf(Ct + (size_t)row * 3072 + col, v0, v1); }); }
        else {
            float rstd[2][4][2]; epi_head_rstd<1>(lds, acc, u.par, wr, wc, fr, fq, rstd);
            const f32x4 g0 = *(const f32x4*)(gk + wc * 32 + 8 * fq), g1 = *(const f32x4*)(gk + wc * 32 + 8 * fq + 4);
            bf16* Ct = KVL + (size_t)u.pm * 256 * 4096 + u.pn * 256 + wc * 32 + 8 * fq;
#pragma unroll
            for (int ai = 0; ai < 2; ++ai)
#pragma unroll
                for (int m = 0; m < 4; ++m) { const int row = ai * 128 + wr * 64 + m * 16 + fr; const float r = rstd[ai][m][0];
                    store8bf(Ct + (size_t)row * 4096, acc[ai][0][m][0] * r * g0, acc[ai][0][m][1] * r * g1);
                    store8bf(Ct + (size_t)row * 4096 + 128, acc[ai][1][m][0], acc[ai][1][m][1]); } } };
    fg::gemm_phase<false, fg::DUnit>(lds, 512, S, E);
}
template <int layer>
__device__ __forceinline__ void ph_gemm_wo(LAS unsigned char* lds) {
    PH_BEGIN;
    const float* R = INF(0); bf16* H1b = WSP(bf16, WS_H1);
    const float* gff = INF(layer == 0 ? 10 : 22); bf16* HN = WSP(bf16, WS_HN); float* SSQ = WSP(float, WS_SSQ);
    fg::DenseSched S{WSP(bf16, WS_O), WSP(bf16, layer == 0 ? WS_W_O0T : WS_W_O1T), 8, nullptr, nullptr, 0, DM, G, bx};
    auto E = [=](const f32x4 (&acc)[2][2][4][2], const fg::DUnit& u, int wr, int wc, int fr, int fq) {
        const int colb = u.pn * 256 + wc * 32 + 8 * fq; const size_t o0 = (size_t)u.pm * 256 * DM + colb;
        f32x4 g[2][2];
#pragma unroll
        for (int bj = 0; bj < 2; ++bj) { g[bj][0] = *(const f32x4*)(gff + colb + bj * 128); g[bj][1] = *(const f32x4*)(gff + colb + bj * 128 + 4); }
#pragma unroll
        for (int ai = 0; ai < 2; ++ai) {
            f32x4 rr[4][2][2];
#pragma unroll
            for (int m = 0; m < 4; ++m)
#pragma unroll
                for (int bj = 0; bj < 2; ++bj) { const size_t o = o0 + (size_t)(ai * 128 + wr * 64 + m * 16 + fr) * DM + bj * 128;
                    if (layer == 0) { rr[m][bj][0] = *(const f32x4*)(R + o); rr[m][bj][1] = *(const f32x4*)(R + o + 4); }
                    else { const u32x4 w = *(const u32x4*)(H1b + o); rr[m][bj][0] = bf4((u32x2){w[0], w[1]}); rr[m][bj][1] = bf4((u32x2){w[2], w[3]}); } }
            asm volatile("" ::: "memory");
#pragma unroll
            for (int m = 0; m < 4; ++m) { const int row = ai * 128 + wr * 64 + m * 16 + fr; float ss = 0.f;
#pragma unroll
                for (int bj = 0; bj < 2; ++bj) { const size_t o = o0 + (size_t)row * DM + bj * 128;
                    const f32x4 h0 = rr[m][bj][0] + acc[ai][bj][m][0], h1 = rr[m][bj][1] + acc[ai][bj][m][1];
                    store8bf(H1b + o, h0, h1);
                    ss += (h0[0] * h0[0] + h0[1] * h0[1]) + (h0[2] * h0[2] + h0[3] * h0[3]) + (h1[0] * h1[0] + h1[1] * h1[1]) + (h1[2] * h1[2] + h1[3] * h1[3]);
                    store8bf(HN + o, h0 * g[bj][0], h1 * g[bj][1]); }
                ss += __shfl_xor(ss, 16); ss += __shfl_xor(ss, 32);
                if (fq == 0) SSQ[((size_t)u.pm * 256 + row) * 32 + u.pn * 4 + wc] = ss; } } };
    fg::gemm_phase<false, fg::DUnit>(lds, DM, S, E);
}

__device__ __forceinline__ void ph_mla_prep() {
    PH_BEGIN;
    const bf16* Z = WSP(bf16, WS_Z); bf16* CQN = WSP(bf16, WS_CQN); bf16* CKVN = WSP(bf16, WS_CKVN); bf16* KR = WSP(bf16, WS_KR); const float* PK = WSP(float, WS_PK);
    const float* gq = INF(4); const float* gkv = INF(5); const float* qkg = INF(8); const int* positions = (const int*)arg_ptr(1);
    for (int t = gw; t < T; t += ngw) {
        const bf16* zr = Z + (size_t)t * 1024;
        float xq[8], xk[8]; unpack8(*(const u32x4*)(zr + 8 * lane), xq); unpack8(*(const u32x4*)(zr + 512 + 8 * lane), xk);
        float sq = 0.f, sk = 0.f;
#pragma unroll
        for (int j = 0; j < 8; ++j) { sq += xq[j] * xq[j]; sk += xk[j] * xk[j]; }
        sq = wave_sum(sq); sk = wave_sum(sk);
        const float rq = rsq(sq * (1.0f / 512) + EPS), rk = rsq(sk * (1.0f / 512) + EPS);
        u32x4 oq, ok;
#pragma unroll
        for (int j = 0; j < 4; ++j) { oq[j] = pk2(xq[2 * j] * rq * gq[8 * lane + 2 * j], xq[2 * j + 1] * rq * gq[8 * lane + 2 * j + 1]);
                                      ok[j] = pk2(xk[2 * j] * rk * gkv[8 * lane + 2 * j], xk[2 * j + 1] * rk * gkv[8 * lane + 2 * j + 1]); }
        *(u32x4*)(CQN + (size_t)t * 512 + 8 * lane) = oq; *(u32x4*)(CKVN + (size_t)t * 512 + 8 * lane) = ok;
        const float* pk = PK + (size_t)t * 64 + lane;
        const float xr = (pk[0] + pk[(size_t)T * 64]) + (pk[(size_t)2 * T * 64] + pk[(size_t)3 * T * 64]);
        const float s2 = wave_sum(xr * xr);
        const float xn = xr * rsq(s2 * (1.0f / 64) + EPS) * qkg[192 + 128 + lane];
        KR[(size_t)t * 64 + lane] = (bf16)f2bf(rope64(xn, lane, (float)positions[t]));
    }
}
template <int LD, int COL0, int HSTRIDE>
__device__ __forceinline__ void knorm_rows(bf16* Kbase, const float* gain  , int gw, int ngw, int lane) {
    const int h = lane >> 2, part = lane & 3;
    f32x4 g[8];
#pragma unroll
    for (int i = 0; i < 8; ++i) g[i] = *(const f32x4*)(gain + part * 32 + 4 * i);
    for (int t = gw; t < T; t += ngw) {
        bf16* kp = Kbase + (size_t)t * LD + COL0 + h * HSTRIDE + part * 32;
        u32x4 w[4]; float x[32]; float ss = 0.f;
#pragma unroll
        for (int i = 0; i < 4; ++i) w[i] = *(const u32x4*)(kp + 8 * i);
#pragma unroll
        for (int i = 0; i < 4; ++i)
#pragma unroll
            for (int j = 0; j < 4; ++j) { x[8 * i + 2 * j] = bf2f(w[i][j] & 0xffffu); x[8 * i + 2 * j + 1] = bf2f(w[i][j] >> 16); }
#pragma unroll
        for (int i = 0; i < 32; ++i) ss += x[i] * x[i];
        ss += __shfl_xor(ss, 1); ss += __shfl_xor(ss, 2);
        const float r = rsq(ss * (1.0f / 128) + EPS);
#pragma unroll
        for (int i = 0; i < 4; ++i) { u32x4 o;
#pragma unroll
            for (int j = 0; j < 4; ++j) o[j] = pk2(x[8 * i + 2 * j] * r * g[2 * i + (j >> 1)][(2 * j) & 3], x[8 * i + 2 * j + 1] * r * g[2 * i + (j >> 1)][(2 * j + 1) & 3]);
            *(u32x4*)(kp + 8 * i) = o; }
    }
}
__device__ __forceinline__ void ph_mla_knorm() {
    PH_BEGIN;
    knorm_rows<4096, 0, 256>(WSP(bf16, WS_KVL), INF(8) + 192, gw, ngw, lane);
}
__device__ __forceinline__ void ph_fox_prep(LAS unsigned char* lds) {
    PH_BEGIN;
    const float* PF = WSP(float, WS_PF); float* CB = WSP(float, WS_C); const float* fb = INF(19);
    LAS float* wtot = (LAS float*)lds;
    for (int bh = bx; bh < NB * NH; bh += G) {
        const int b = bh >> 4, h = bh & 15; const float bias = fb[h];
        const float* pf = PF + ((size_t)b * SEQ + tid * 8) * 16 + h;
        float v[8]; float run = 0.f;
#pragma unroll
        for (int i = 0; i < 8; ++i) { const float* q = pf + i * 16;
            const float xx = ((q[0] + q[(size_t)T * 16]) + (q[(size_t)2 * T * 16] + q[(size_t)3 * T * 16])) + bias;
            run += fminf(xx, 0.f) - log1pf(expf(-fabsf(xx))); v[i] = run; }
        float incl = run;
#pragma unroll
        for (int o = 1; o < 64; o <<= 1) { const float up = __shfl_up(incl, o); if (lane >= o) incl += up; }
        if (lane == 63) wtot[wave] = incl;
        __syncthreads();
        float base = incl - run;
        for (int w = 0; w < wave; ++w) base += wtot[w];
        float* cb = CB + (size_t)bh * SEQ + tid * 8;
        *(f32x4*)cb = (f32x4){-(base + v[0]) * 1.4426950408889634f, -(base + v[1]) * 1.4426950408889634f, -(base + v[2]) * 1.4426950408889634f, -(base + v[3]) * 1.4426950408889634f};
        *(f32x4*)(cb + 4) = (f32x4){-(base + v[4]) * 1.4426950408889634f, -(base + v[5]) * 1.4426950408889634f, -(base + v[6]) * 1.4426950408889634f, -(base + v[7]) * 1.4426950408889634f};
        __syncthreads();
    }
}

namespace fa {
typedef short s16x4 __attribute__((ext_vector_type(4)));
typedef float f32x16 __attribute__((ext_vector_type(16)));
constexpr int KVB = 64, SHM_V = KVB * 128 * 2;
__device__ __forceinline__ int v_rd_base(int lane) { return ((lane & 3) << 3) | (((lane >> 2) & 3) << 6) | (((lane >> 4) & 1) << 5) | (((lane >> 5) & 1) << 8); }
constexpr int v_rd_off(int d0, int ks, int half) { return d0 * 512 + ks * 4096 + half * 2048; }
__device__ __forceinline__ int crow(int r, int hi) { return (r & 3) + 8 * (r >> 2) + 4 * hi; }
__device__ __forceinline__ unsigned cvtpk(float lo, float hi) { unsigned r; asm volatile("v_cvt_pk_bf16_f32 %0, %1, %2" : "=v"(r) : "v"(lo), "v"(hi)); return r; }

template <int layer>
__device__ __forceinline__ void attn_phase(LAS unsigned char* lds) {
    PH_BEGIN;
    constexpr int DK = layer == 0 ? 192 : 128, NQ = DK / 16, CPR = DK / 8, NKC = KVB * CPR / NTHREADS;
    constexpr int SHM_K = KVB * DK * 2;
    constexpr int OFF_V = 0, OFF_K = 2 * SHM_V, OFF_WS = OFF_K + 2 * SHM_K, OFF_CB = OFF_WS + NWAVES * 256, OFF_CV = 86016;
    static_assert(OFF_CB + 512 <= OFF_CV && OFF_CV + NWAVES * 8192 <= LDS_BARW, "attention LDS map");
    constexpr float C2 = (layer == 0 ? 0.07216878364870322f : 0.08838834764831845f) * 1.4426950408889634f;
    constexpr int QLD = layer == 0 ? 3072 : 8192, QHS = layer == 0 ? 192 : 128, KLD = layer == 0 ? 4096 : 8192, KC0 = layer == 0 ? 0 : 2048, KHS = layer == 0 ? 256 : 128, VC0 = layer == 0 ? 128 : 4096;
    const bf16* Qs = layer == 0 ? WSP(bf16, WS_QL) : WSP(bf16, WS_Z); const bf16* Ks = layer == 0 ? WSP(bf16, WS_KVL) : WSP(bf16, WS_Z); const bf16* KRs = WSP(bf16, WS_KR); bf16* Ob = WSP(bf16, WS_O);
    const float* qkg = INF(layer == 0 ? 8 : 20); const int* positions = (const int*)arg_ptr(1);
    const float* CBg = WSP(float, WS_C); const bf16* Zg = WSP(bf16, WS_Z);
    const int wid = __builtin_amdgcn_readfirstlane(tid >> 6), r32 = lane & 31, hi = lane >> 5;
    auto koff_n = [](int tk, int j) { const int ci = j * 256 + tk, row = ci >> 4, pc = ci & 15, lc = pc ^ (row & 7); return (unsigned)(row * KLD + lc * 8) * 2u; };
    auto koff_r = [](int tk, int j) { const int ci = j * 256 + tk, row = ci >> 3, pc = ci & 7, lc = pc ^ (row & 7); return (unsigned)(row * 64 + lc * 8) * 2u; };
    auto voff_f = [](int tk, int j) { const int ci = j * 256 + tk, st = ci >> 5, w = ci & 31, kk = (st >> 2) * 8 + (w >> 2), key = (kk & ~0xC) | ((kk & 4) << 1) | ((kk & 8) >> 1), c = (st & 3) * 32 + (w & 3) * 8;
        return (unsigned)(key * KLD + c) * 2u; };
    const int tkp = (tid - 256) & 255; const unsigned kof0 = koff_n(tkp, 0), vof0 = voff_f(tkp, 0), rof0 = koff_r(tkp, 0);
    const int kbn = r32 * 256 + ((hi * 16) ^ ((r32 & 7) << 4)), kbr0 = 16384 + r32 * 128 + ((hi * 16) ^ ((r32 & 7) << 4));
    const unsigned ldsb = (unsigned)(uintptr_t)lds;
    const int vb0 = (int)(unsigned)(uintptr_t)(lds + OFF_V) + v_rd_base(lane);
    LAS float* wsl = (LAS float*)(lds + OFF_WS) + wid * 64; LAS float* li_l = wsl; LAS float* al_l = wsl + 32;

    const float* cv_wgu = INF(layer == 0 ? 15 : 27); const float* cv_wdn = INF(layer == 0 ? 16 : 28); bf16* cv_gut = WSP(bf16, CV_MODE >= 2 ? WS_Q : WS_W_GUT); bf16* cv_dt = WSP(bf16, CV_MODE >= 2 ? WS_Q : WS_W_DT);
    constexpr int CV_IG = 32 * 32, CV_ID = 8 * 64, CV_NIT = NEXP * (CV_IG + CV_ID);
    int cv_it = (CV_MODE == 1) ? CV_NIT : bx * 4 + wid, cv_pend = -1; const int cv_stride = G * 4;
    const unsigned cv_lds = (unsigned)(uintptr_t)(lds + OFF_CV) + (unsigned)(wid & 3) * 16384u;
#define CV_DECODE(it_) const bool gu_ = (it_) < NEXP * CV_IG; const int v_ = gu_ ? (it_) : (it_) - NEXP * CV_IG, e_ = gu_ ? v_ >> 10 : v_ >> 9, r_ = gu_ ? v_ & 1023 : v_ & 511;     \
        const int lgN_ = gu_ ? 10 : 11, lgK_ = gu_ ? 11 : 9, N_ = 1 << lgN_, k0_ = (r_ >> (lgN_ - 5)) << 6, n0_ = (r_ & ((1 << (lgN_ - 5)) - 1)) << 5; \
        const float* W_ = (gu_ ? cv_wgu : cv_wdn) + ((size_t)e_ << (gu_ ? 21 : 20)); bf16* WT_ = (gu_ ? cv_gut : cv_dt) + (((size_t)e_ << (gu_ ? 21 : 20)) & (CV_MODE >= 2 ? (size_t)0x1ffffff : ~(size_t)0))
#define CV_ISSUE(it_, SLOT) do { { CV_DECODE(it_); const int lz_ = otid() & 63; \
        const unsigned vb_ = (unsigned)((lz_ >> 3) * N_) * 4u; const char* sb_ = (const char*)(W_ + (size_t)k0_ * N_ + n0_); \
        _Pragma("unroll") for (int i = 0; i < 8; ++i) { const char* si_ = sb_ + (size_t)i * 8 * N_ * 4; const unsigned vo_ = vb_ + ((unsigned)((lz_ & 7) ^ i) << 4); unsigned keep_; \
            asm volatile("s_mov_b32 %0, m0\n\ts_mov_b32 m0, %3\n\ts_nop 0\n\tglobal_load_lds_dwordx4 %1, %2 nt\n\ts_mov_b32 m0, %0" : "=&s"(keep_) : "v"(vo_), "s"(si_), "s"(cv_lds + (unsigned)(SLOT) * 8192u + (unsigned)i * 1024u) : "memory"); } } } while (0)
#define CV_FINISH(it_, SLOT) do { { CV_DECODE(it_); const int lz_ = otid() & 63, c_ = lz_ & 7; const LAS float* scr_ = (const LAS float*)(lds + OFF_CV) + (wid & 3) * 4096 + (SLOT) * 2048; \
        float cvr_[4][8];                                                                           \
        _Pragma("unroll") for (int j = 0; j < 4; ++j) { const int n_ = (lz_ >> 3) + 8 * j; const LAS float* sp_ = scr_ + (8 * c_) * 32 + (((n_ >> 2) ^ c_) << 2) + (n_ & 3); \
            _Pragma("unroll") for (int q = 0; q < 8; ++q) cvr_[j][q] = sp_[32 * q]; } \
        asm volatile("s_waitcnt lgkmcnt(0)" ::: "memory"); __builtin_amdgcn_sched_barrier(0); \
        _Pragma("unroll") for (int j = 0; j < 4; ++j) { const int n_ = (lz_ >> 3) + 8 * j; \
            u32x4 o_; o_.x = pk2(cvr_[j][0], cvr_[j][1]); o_.y = pk2(cvr_[j][2], cvr_[j][3]); o_.z = pk2(cvr_[j][4], cvr_[j][5]); o_.w = pk2(cvr_[j][6], cvr_[j][7]); \
            const int nn_ = n0_ + n_; const int f_ = nn_ & 511; \
            const int dr_ = gu_ ? ((f_ >> 7) * 256 + ((f_ >> 6) & 1) * 128 + ((f_ >> 4) & 3) * 32 + ((f_ >> 2) & 3) * 8 + (nn_ >> 9) * 4 + (f_ & 3)) : nn_;     \
            __builtin_nontemporal_store(o_, (u32x4*)(WT_ + ((size_t)dr_ << lgK_) + k0_ + 8 * c_)); } \
        } } while (0)
    for (int L = bx; L < NB * NH * 8; L += G) {
        const int bh = (L & 7) * 8 + (L >> 6), pair = (L >> 3) & 7, b = bh >> 4, h = bh & 15;
        const char* Kg = (const char*)(Ks + (size_t)b * SEQ * KLD + KC0 + h * KHS); const char* Vg = (const char*)(Ks + (size_t)b * SEQ * KLD + VC0 + h * KHS);
        const char* KRg = (const char*)(KRs + (size_t)b * SEQ * 64); const float* cbg = CBg + (size_t)bh * SEQ;
        for (int pass = 0; pass < 2; ++pass) {
            const int qb = pass ? pair : 15 - pair, P0 = qb * 256, NT = P0 / KVB + 4, qlo = P0 + wid * 32;
            bf16x8 qr[NQ];
            {
                const size_t tq = (size_t)b * SEQ + qlo + r32;
                const bf16* qp = Qs + tq * QLD + h * QHS + hi * 8;
                u32x4 raw[NQ];
#pragma unroll
                for (int d0 = 0; d0 < NQ; ++d0) raw[d0] = *(const u32x4*)(qp + d0 * 16);
                float ss = 0.f;
#pragma unroll
                for (int d0 = 0; d0 < 8; ++d0)
#pragma unroll
                    for (int j = 0; j < 4; ++j) { const float x0 = bf2f(raw[d0][j] & 0xffffu), x1 = bf2f(raw[d0][j] >> 16); ss += x0 * x0 + x1 * x1; }
                { auto rr = __builtin_amdgcn_permlane32_swap(__float_as_uint(ss), __float_as_uint(ss), false, false); ss = __uint_as_float(rr[0]) + __uint_as_float(rr[1]); }
                const float rn = rsq(ss * (1.0f / 128) + EPS) * C2;
#pragma unroll
                for (int d0 = 0; d0 < 8; ++d0) { const f32x4 g0 = *(const f32x4*)(qkg + d0 * 16 + hi * 8), g1 = *(const f32x4*)(qkg + d0 * 16 + hi * 8 + 4); u32x4 o;
#pragma unroll
                    for (int j = 0; j < 4; ++j) { const float x0 = bf2f(raw[d0][j] & 0xffffu), x1 = bf2f(raw[d0][j] >> 16); const f32x4 gg = j < 2 ? g0 : g1;
                        o[j] = cvtpk(x0 * rn * gg[(2 * j) & 3], x1 * rn * gg[(2 * j + 1) & 3]); }
                    qr[d0] = *reinterpret_cast<bf16x8*>(&o); }
                if constexpr (layer == 0) {
                    float xr[4][8]; float s2 = 0.f;
#pragma unroll
                    for (int c = 0; c < 4; ++c)
#pragma unroll
                        for (int j = 0; j < 4; ++j) { xr[c][2 * j] = bf2f(raw[8 + c][j] & 0xffffu); xr[c][2 * j + 1] = bf2f(raw[8 + c][j] >> 16); s2 += xr[c][2 * j] * xr[c][2 * j] + xr[c][2 * j + 1] * xr[c][2 * j + 1]; }
                    { auto rr = __builtin_amdgcn_permlane32_swap(__float_as_uint(s2), __float_as_uint(s2), false, false); s2 = __uint_as_float(rr[0]) + __uint_as_float(rr[1]); }
                    const float r2 = rsq(s2 * (1.0f / 64) + EPS); const float pos = (float)positions[tq];
#pragma unroll
                    for (int c = 0; c < 4; ++c) { const f32x4 g0 = *(const f32x4*)(qkg + 128 + c * 16 + hi * 8), g1 = *(const f32x4*)(qkg + 128 + c * 16 + hi * 8 + 4);
#pragma unroll
                        for (int j = 0; j < 8; ++j) xr[c][j] *= r2 * (j < 4 ? g0[j & 3] : g1[j & 3]); }
#pragma unroll
                    for (int c = 0; c < 2; ++c) { u32x4 o1, o2;
#pragma unroll
                        for (int jj = 0; jj < 4; ++jj) { float y1[2], y2[2];
#pragma unroll
                            for (int e = 0; e < 2; ++e) { const int j = 2 * jj + e; const int i = c * 16 + hi * 8 + j;
                                const float freq = exp2f(-(float)i * (13.287712379549449f / 32.0f)); float rev = pos * freq * 0.15915494309189535f; rev -= floorf(rev);
                                const float sn = __builtin_amdgcn_sinf(rev), cs = __builtin_amdgcn_cosf(rev);
                                y1[e] = (xr[c][j] * cs - xr[c + 2][j] * sn) * C2; y2[e] = (xr[c + 2][j] * cs + xr[c][j] * sn) * C2; }
                            o1[jj] = cvtpk(y1[0], y1[1]); o2[jj] = cvtpk(y2[0], y2[1]); }
                        qr[8 + c] = *reinterpret_cast<bf16x8*>(&o1); qr[10 + c] = *reinterpret_cast<bf16x8*>(&o2); }
                }
            }
            float m_reg = 0.f, l_reg = 0.f; f32x16 o[4];
#pragma unroll
            for (int d0 = 0; d0 < 4; ++d0)
#pragma unroll
                for (int r = 0; r < 16; ++r) o[d0][r] = 0.f;
#define FA_DMA16(sbase_, voff_, ldsaddr_) do { unsigned keep_; asm volatile("s_mov_b32 %0, m0\n\ts_mov_b32 m0, %3\n\ts_nop 0\n\tglobal_load_lds_dwordx4 %1, %2\n\ts_mov_b32 m0, %0" \
        : "=&s"(keep_) : "v"(voff_), "s"(sbase_), "s"(ldsaddr_) : "memory"); } while (0)
#define FA_DMA4(sbase_, voff_, ldsaddr_) do { unsigned keep_; asm volatile("s_mov_b32 %0, m0\n\ts_mov_b32 m0, %3\n\ts_nop 0\n\tglobal_load_lds_dword %1, %2\n\ts_mov_b32 m0, %0" \
        : "=&s"(keep_) : "v"(voff_), "s"(sbase_), "s"(ldsaddr_) : "memory"); } while (0)
#define FA_ISSUE(t_, BUF) do { if (wid >= 4) { const char* ks_ = Kg + (size_t)(t_) * (KVB * KLD * 2); const char* vs_ = Vg + (size_t)(t_) * (KVB * KLD * 2); const unsigned wl_ = (unsigned)(wid - 4) * 1024u; \
        _Pragma("unroll") for (int j = 0; j < 4; ++j) FA_DMA16(ks_, kof0 + (unsigned)(j * 16 * KLD * 2), ldsb + (unsigned)(OFF_K + (BUF) * SHM_K + j * 4096) + wl_); \
        if constexpr (layer == 0) { const char* kr_ = KRg + (size_t)(t_) * (KVB * 64 * 2); \
            _Pragma("unroll") for (int j = 0; j < 2; ++j) FA_DMA16(kr_, rof0 + (unsigned)(j * 32 * 64 * 2), ldsb + (unsigned)(OFF_K + (BUF) * SHM_K + 16384 + j * 4096) + wl_); } \
        _Pragma("unroll") for (int j = 0; j < 4; ++j) FA_DMA16(vs_, vof0 + (unsigned)(j * 16 * KLD * 2), ldsb + (unsigned)(OFF_V + (BUF) * SHM_V + j * 4096) + wl_); \
        if (layer == 1 && wid == 4) { const float* cs_ = cbg + (t_) * KVB; FA_DMA4(cs_, (unsigned)lane * 4u, ldsb + (unsigned)(OFF_CB + (BUF) * 256)); } } } while (0)
#define FA_TRRD(dst, off) asm volatile("ds_read_b64_tr_b16 %0, %1 offset:%2" : "=&v"(dst) : "v"(vb0), "i"(off) : "memory")
#define FA_PV_D0(BUF, d0) do { s16x4 l0, l1, l2, l3, h0, h1, h2, h3; constexpr int b_ = (BUF) * SHM_V + v_rd_off(d0, 0, 0); \
        FA_TRRD(l0, b_); FA_TRRD(h0, b_ + 2048); FA_TRRD(l1, b_ + 4096); FA_TRRD(h1, b_ + 6144); FA_TRRD(l2, b_ + 8192); FA_TRRD(h2, b_ + 10240); FA_TRRD(l3, b_ + 12288); FA_TRRD(h3, b_ + 14336); \
        asm volatile("s_waitcnt lgkmcnt(0)" ::: "memory"); __builtin_amdgcn_sched_barrier(0); \
        o[d0] = __builtin_amdgcn_mfma_f32_32x32x16_bf16((bf16x8){l0[0], l0[1], l0[2], l0[3], h0[0], h0[1], h0[2], h0[3]}, pa0, o[d0], 0, 0, 0); \
        o[d0] = __builtin_amdgcn_mfma_f32_32x32x16_bf16((bf16x8){l1[0], l1[1], l1[2], l1[3], h1[0], h1[1], h1[2], h1[3]}, pa1, o[d0], 0, 0, 0); \
        o[d0] = __builtin_amdgcn_mfma_f32_32x32x16_bf16((bf16x8){l2[0], l2[1], l2[2], l2[3], h2[0], h2[1], h2[2], h2[3]}, pa2, o[d0], 0, 0, 0); \
        o[d0] = __builtin_amdgcn_mfma_f32_32x32x16_bf16((bf16x8){l3[0], l3[1], l3[2], l3[3], h3[0], h3[1], h3[2], h3[3]}, pa3, o[d0], 0, 0, 0); } while (0)
#define FA_PK4(P, B_, OUT) do { const unsigned a0 = cvtpk(P[B_ + 0], P[B_ + 1]), a1 = cvtpk(P[B_ + 2], P[B_ + 3]), b0_ = cvtpk(P[B_ + 4], P[B_ + 5]), b1_ = cvtpk(P[B_ + 6], P[B_ + 7]); \
        auto r0 = __builtin_amdgcn_permlane32_swap(a0, b0_, false, false); auto r1 = __builtin_amdgcn_permlane32_swap(a1, b1_, false, false); \
        u32x4 w_ = {r0[0], r1[0], r0[1], r1[1]}; OUT = *reinterpret_cast<bf16x8*>(&w_); } while (0)
#define FA_STEP(t_, BUF) do { \
          \
        if (wid >= 4 || (t_) == 0) asm volatile("s_waitcnt vmcnt(0)" ::: "memory");                 \
        asm volatile("s_waitcnt lgkmcnt(0)" ::: "memory"); __builtin_amdgcn_s_barrier(); asm volatile("" ::: "memory");     \
        if ((t_) + 1 < NT) FA_ISSUE((t_) + 1, (BUF) ^ 1); \
        if (wid < 4) {                                                                             \
            if (cv_pend >= 0) { asm volatile("s_waitcnt vmcnt(0)" ::: "memory"); CV_FINISH(cv_pend, (BUF) ^ 1); cv_pend = -1; }     \
            if (cv_it < CV_NIT) { CV_ISSUE(cv_it, BUF); cv_pend = cv_it; cv_it += cv_stride; } }         \
        const int kbase = (t_) * KVB; \
        if (kbase <= qlo + 31) {                                                                   \
            f32x16 p0, p1; \
            _Pragma("unroll") for (int r = 0; r < 16; ++r) { p0[r] = 0.f; p1[r] = 0.f; } \
            const LAS unsigned char* kt = lds + OFF_K + (BUF) * SHM_K; \
            int kbn_ = kbn, kbr_ = kbr0; asm volatile("" : "+v"(kbn_), "+v"(kbr_));                 \
            if (wid < 4) __builtin_amdgcn_s_setprio(2); else __builtin_amdgcn_s_setprio(1);          \
            _Pragma("unroll") for (int d0 = 0; d0 < NQ; ++d0) { const LAS unsigned char* a_ = d0 < 8 ? kt + (kbn_ ^ ((d0 & 3) << 5)) + (d0 >> 2) * 128 : kt + (kbr_ ^ ((d0 & 3) << 5)); \
                const bf16x8 k0 = *(const LAS bf16x8*)a_, k1 = *(const LAS bf16x8*)(a_ + (d0 < 8 ? 32 * 256 : 32 * 128)); \
                p0 = __builtin_amdgcn_mfma_f32_32x32x16_bf16(k0, qr[d0], p0, 0, 0, 0); p1 = __builtin_amdgcn_mfma_f32_32x32x16_bf16(k1, qr[d0], p1, 0, 0, 0); \
                if ((d0 & 3) == 3) __builtin_amdgcn_sched_barrier(0); } \
            if (layer == 1) { const LAS f32x4* cb = (const LAS f32x4*)(lds + OFF_CB + (BUF) * 256); \
                _Pragma("unroll") for (int g = 0; g < 4; ++g) { const f32x4 c0 = cb[2 * g + hi], c1 = cb[8 + 2 * g + hi]; \
                    _Pragma("unroll") for (int j = 0; j < 4; ++j) { p0[4 * g + j] += c0[j]; p1[4 * g + j] += c1[j]; } \
                    __builtin_amdgcn_sched_barrier(0); } } \
            if (kbase + KVB - 1 > qlo) { const int dq = qlo + r32 - 4 * hi - kbase; const float NEG = -__builtin_inff();     \
                _Pragma("unroll") for (int r = 0; r < 16; ++r) { const int c = (r & 3) + 8 * (r >> 2); if (dq - c < 0) p0[r] = NEG; if (dq - c - 32 < 0) p1[r] = NEG; } } \
            float pmax = p0[0]; \
            _Pragma("unroll") for (int r = 1; r < 16; ++r) pmax = fmaxf(pmax, p0[r]); \
            _Pragma("unroll") for (int r = 0; r < 16; ++r) pmax = fmaxf(pmax, p1[r]); \
            { auto rr = __builtin_amdgcn_permlane32_swap(__float_as_uint(pmax), __float_as_uint(pmax), false, false); pmax = fmaxf(__uint_as_float(rr[0]), __uint_as_float(rr[1])); } \
              \
            if ((t_) == 0) m_reg = pmax < -64.0f ? pmax : 0.f; \
            float mn, alpha; \
            if (__all(pmax - m_reg <= 64.0f)) { mn = m_reg; alpha = 1.f; } else { mn = fmaxf(m_reg, pmax); alpha = __builtin_amdgcn_exp2f(m_reg - mn); m_reg = mn; } \
            float ps = 0.f; \
            if (__all(mn == 0.f)) { _Pragma("unroll") for (int r = 0; r < 16; ++r) { p0[r] = __builtin_amdgcn_exp2f(p0[r]); p1[r] = __builtin_amdgcn_exp2f(p1[r]); ps += p0[r] + p1[r]; } } \
            else { _Pragma("unroll") for (int r = 0; r < 16; ++r) { p0[r] = __builtin_amdgcn_exp2f(p0[r] - mn); p1[r] = __builtin_amdgcn_exp2f(p1[r] - mn); ps += p0[r] + p1[r]; } } \
            { auto rr = __builtin_amdgcn_permlane32_swap(__float_as_uint(ps), __float_as_uint(ps), false, false); ps = __uint_as_float(rr[0]) + __uint_as_float(rr[1]); } \
            l_reg = l_reg * alpha + ps; \
            bf16x8 pa0, pa1, pa2, pa3; FA_PK4(p0, 0, pa0); FA_PK4(p0, 8, pa1); FA_PK4(p1, 0, pa2); FA_PK4(p1, 8, pa3); \
            if (__any(alpha < 1.f)) {                                                              \
                _Pragma("unroll") for (int d_ = 0; d_ < 4; ++d_) _Pragma("unroll") for (int r = 0; r < 16; ++r) o[d_][r] *= alpha; } \
            FA_PV_D0(BUF, 0); FA_PV_D0(BUF, 1); FA_PV_D0(BUF, 2); FA_PV_D0(BUF, 3); __builtin_amdgcn_s_setprio(0); \
        } \
        } while (0)
            FA_ISSUE(0, 0);
            for (int t = 0; t < NT; t += 2) { FA_STEP(t, 0); FA_STEP(t + 1, 1); }
            { const int tz = otid(), hz = (tz >> 5) & 1, rz = tz & 31;
              const size_t trow = (size_t)b * SEQ + qlo + rz; const float rl = __builtin_amdgcn_rcpf(l_reg);
              u32x2 gts[4][4];
              if (layer == 1) { const bf16* gp = Zg + trow * 8192 + 6144 + h * 128 + 4 * hz;
#pragma unroll
                  for (int d0 = 0; d0 < 4; ++d0)
#pragma unroll
                      for (int g = 0; g < 4; ++g) gts[d0][g] = *(const u32x2*)(gp + d0 * 32 + 8 * g); }
              bf16* op = Ob + trow * DM + h * 128 + 8 * hz;
#pragma unroll
              for (int d0 = 0; d0 < 4; ++d0)
#pragma unroll
                  for (int gp2 = 0; gp2 < 2; ++gp2) { unsigned pk[2][2];
#pragma unroll
                      for (int e = 0; e < 2; ++e) { const int g = 2 * gp2 + e; float v[4];
#pragma unroll
                          for (int j = 0; j < 4; ++j) v[j] = o[d0][4 * g + j] * rl;
                          if (layer == 1) { const u32x2 gw = gts[d0][g]; const float g4[4] = {bf2f(gw[0] & 0xffffu), bf2f(gw[0] >> 16), bf2f(gw[1] & 0xffffu), bf2f(gw[1] >> 16)};
#pragma unroll
                              for (int j = 0; j < 4; ++j) v[j] *= 1.0f / (1.0f + __expf(-g4[j])); }
                          pk[e][0] = cvtpk(v[0], v[1]); pk[e][1] = cvtpk(v[2], v[3]); }
                      auto s0 = __builtin_amdgcn_permlane32_swap(pk[0][0], pk[1][0], false, false); auto s1 = __builtin_amdgcn_permlane32_swap(pk[0][1], pk[1][1], false, false);
                      *(u32x4*)(op + d0 * 32 + 16 * gp2) = (u32x4){s0[0], s1[0], s0[1], s1[1]}; } }
        }
    }
    asm volatile("s_waitcnt vmcnt(0)" ::: "memory");
    if (wid < 4) { if (cv_pend >= 0) CV_FINISH(cv_pend, 1);
        while (cv_it < CV_NIT) { CV_ISSUE(cv_it, 0); asm volatile("s_waitcnt vmcnt(0)" ::: "memory"); CV_FINISH(cv_it, 0); cv_it += cv_stride; } }
    __syncthreads();
#undef CV_DECODE
#undef CV_ISSUE
#undef CV_FINISH
#undef FA_ISSUE
#undef FA_DMA16
#undef FA_DMA4
#undef FA_TRRD
#undef FA_PV_D0
#undef FA_PK4
#undef FA_STEP
}
}

template <int layer>
__device__ __forceinline__ void ph_router(LAS unsigned char* lds) {
    PH_BEGIN;
    skinny_gemm<80>(lds, WSP(bf16, WS_HN), WSP(bf16, WS_SK) + (size_t)(2 + layer) * 4 * 256 * 512, WSP(float, WS_PR), G, bx);
}
template <int layer>
__device__ __forceinline__ void ph_route() {
    PH_BEGIN;
    const float* PR = WSP(float, WS_PR); int* TOK = WSP(int, WS_TOK); float* GATE = WSP(float, WS_GATE); int* TSLOT = WSP(int, WS_TSLOT); const float* SSQ = WSP(float, WS_SSQ); float* RSL = WSP(float, WS_RSL);
    unsigned* cnt = WSP(unsigned, WS_CTL) + (layer == 0 ? CW_CNT0 : CW_CNT1);
    const float* b_rg = INF(layer == 0 ? 12 : 24); const float* b_re = INF(layer == 0 ? 14 : 26);
    for (int t = bx * NTHREADS + tid; t < T; t += G * NTHREADS) {
        const float* pr = PR + (size_t)t * 80;
        float rstd; { f32x4 q = *(const f32x4*)(SSQ + (size_t)t * 32);
#pragma unroll
            for (int i = 1; i < 8; ++i) q += *(const f32x4*)(SSQ + (size_t)t * 32 + 4 * i);
            rstd = rsq(((q[0] + q[1]) + (q[2] + q[3])) * (1.0f / DM) + EPS); }
        auto sum4 = [=](int j) { const f32x4 a0 = *(const f32x4*)(pr + j), a1 = *(const f32x4*)(pr + (size_t)T * 80 + j), a2 = *(const f32x4*)(pr + (size_t)2 * T * 80 + j), a3 = *(const f32x4*)(pr + (size_t)3 * T * 80 + j);
            return (a0 + a1) + (a2 + a3); };
        float gl[8]; int g = 0; float gm = -3.0e38f;
        { const f32x4 x0 = sum4(0), x1 = sum4(4);
#pragma unroll
          for (int j = 0; j < 8; ++j) { gl[j] = (j < 4 ? x0[j & 3] : x1[j & 3]) * rstd + b_rg[j]; if (gl[j] > gm) { gm = gl[j]; g = j; } } }
        float se = 0.f;
#pragma unroll
        for (int j = 0; j < 8; ++j) se += expf(gl[j] - gm);
        const float pg = 1.0f / se;
        float el[8]; int i1 = 0; float m1 = -3.0e38f;
        { const f32x4 x0 = sum4(8 + g * 8), x1 = sum4(12 + g * 8);
#pragma unroll
          for (int j = 0; j < 8; ++j) { el[j] = (j < 4 ? x0[j & 3] : x1[j & 3]) * rstd + b_re[g * 8 + j]; if (el[j] > m1) { m1 = el[j]; i1 = j; } } }
        int i2 = 0; float m2 = -3.0e38f;
#pragma unroll
        for (int j = 0; j < 8; ++j) { if (j != i1 && el[j] > m2) { m2 = el[j]; i2 = j; } }
        const float w2 = expf(m2 - m1), g1 = pg / (1.0f + w2), g2 = pg * w2 / (1.0f + w2);
        const int e1 = g * 8 + i1, e2 = g * 8 + i2;
        const unsigned s1 = atomicAdd(&cnt[e1], 1u); TOK[(size_t)e1 * T + s1] = t; GATE[(size_t)e1 * T + s1] = g1; RSL[(size_t)e1 * T + s1] = rstd;
        const unsigned s2 = atomicAdd(&cnt[e2], 1u); TOK[(size_t)e2 * T + s2] = t; GATE[(size_t)e2 * T + s2] = g2; RSL[(size_t)e2 * T + s2] = rstd;
        TSLOT[2 * t] = (e1 << 16) | (int)s1; TSLOT[2 * t + 1] = (e2 << 16) | (int)s2;
    }
}
struct MUnit { int e, mt, mtg, pn, ce; };
template <bool GU>
struct MoeSched {
    const LAS int* ts; const LAS int* cn; const char* A; const char* B; const int* tok; int G, c;
    static constexpr int NPN = GU ? 4 : 8, K = GU ? DM : DEXP;
    __device__ __forceinline__ bool next(int i, MUnit& u) const {
        const LAS int* xs = (const LAS int*)((const LAS unsigned char*)ts + (LDS_XS - LDS_TS));
        const int x = c & 7, W = G >> 3, q = i * W + (c >> 3); if ((G & 7) != 0 || q >= xs[8] * NPN) return false;
        int k = 0; while (xs[k + 1] * NPN <= q) ++k;
        const int e = x + 8 * k, rq = q - xs[k] * NPN, nte = xs[k + 1] - xs[k]; u.pn = rq / nte; u.mt = rq - u.pn * nte;
        u.e = e; u.mtg = ts[e] + u.mt; u.ce = cn[e]; return true; }
    __device__ __forceinline__ const char* a_base(const MUnit& u) const { return GU ? A : A + (size_t)u.mtg * 256 * DEXP * 2; }
    __device__ __forceinline__ const char* b_base(const MUnit& u) const { return B + ((size_t)u.e * (GU ? 1024 : DM) + u.pn * 256) * K * 2; }
    __device__ __forceinline__ unsigned a_voff(const MUnit& u, int row, int col) const {
        if (GU) { const int s = u.mt * 256 + row; return (unsigned)tok[(size_t)u.e * T + (s < u.ce ? s : 0)] * (unsigned)(DM * 2) + (unsigned)col * 2u; }
        return (unsigned)(row * DEXP + col) * 2u; }
    __device__ __forceinline__ bool lo_only(const MUnit& u) const { return u.ce - u.mt * 256 <= 128; }
};
template <int layer>
__device__ __forceinline__ void ph_gateup(LAS unsigned char* lds) {
    PH_BEGIN;
    moe_prefix(lds, WSP(unsigned, WS_CTL) + (layer == 0 ? CW_CNT0 : CW_CNT1));
    bf16* ACT = WSP(bf16, WS_ACT); const float* RSL = WSP(float, WS_RSL);
    MoeSched<true> S{(const LAS int*)(lds + LDS_TS), (const LAS int*)(lds + LDS_CN), (const char*)WSP(bf16, WS_HN), (const char*)WSP(bf16, WS_W_GUT), WSP(int, WS_TOK), G, bx};
    auto E = [=](const f32x4 (&acc)[2][2][4][2], const MUnit& u, int wr, int wc, int fr, int fq) {
        bf16* At = ACT + (size_t)u.mtg * 256 * DEXP + u.pn * 128 + wc * 16 + 4 * fq;
        float rsv[2][4];
#pragma unroll
        for (int ai = 0; ai < 2; ++ai)
#pragma unroll
            for (int m = 0; m < 4; ++m) { const int row = ai * 128 + wr * 64 + m * 16 + fr; rsv[ai][m] = u.mt * 256 + row < u.ce ? RSL[(size_t)u.e * T + u.mt * 256 + row] : 0.f; }
        asm volatile("" ::: "memory");
#pragma unroll
        for (int ai = 0; ai < 2; ++ai)
#pragma unroll
            for (int m = 0; m < 4; ++m) { const int row = ai * 128 + wr * 64 + m * 16 + fr; if (ai == 1 && u.ce - u.mt * 256 <= 128) continue;
                const float rs = rsv[ai][m];
#pragma unroll
                for (int bj = 0; bj < 2; ++bj) { const f32x4 g = acc[ai][bj][m][0] * rs, up = acc[ai][bj][m][1] * rs; f32x4 o;
#pragma unroll
                    for (int j = 0; j < 4; ++j) o[j] = g[j] / (1.0f + __expf(-g[j])) * up[j];
                    store4bf(At + (size_t)row * DEXP + bj * 64, o); } } };
    fg::gemm_phase<true, MUnit>(lds, DM, S, E);
}
template <int layer>
__device__ __forceinline__ void ph_down(LAS unsigned char* lds) {
    PH_BEGIN;
    moe_prefix(lds, WSP(unsigned, WS_CTL) + (layer == 0 ? CW_CNT0 : CW_CNT1));
    bf16* YS = WSP(bf16, WS_YS); const float* GATE = WSP(float, WS_GATE);
    MoeSched<false> S{(const LAS int*)(lds + LDS_TS), (const LAS int*)(lds + LDS_CN), (const char*)WSP(bf16, WS_ACT), (const char*)WSP(bf16, WS_W_DT), nullptr, G, bx};
    auto E = [=](const f32x4 (&acc)[2][2][4][2], const MUnit& u, int wr, int wc, int fr, int fq) {
        const int rem = u.ce - u.mt * 256; const float* gt = GATE + (size_t)u.e * T + u.mt * 256;
        bf16* Yt = YS + (size_t)u.mtg * 256 * DM + u.pn * 256 + wc * 32 + 8 * fq;
        float gv[2][4];
#pragma unroll
        for (int ai = 0; ai < 2; ++ai)
#pragma unroll
            for (int m = 0; m < 4; ++m) { const int row = ai * 128 + wr * 64 + m * 16 + fr; gv[ai][m] = row < rem ? gt[row] : 0.f; }
        asm volatile("" ::: "memory");
#pragma unroll
        for (int ai = 0; ai < 2; ++ai)
#pragma unroll
            for (int m = 0; m < 4; ++m) { const int row = ai * 128 + wr * 64 + m * 16 + fr;
                if (row < rem) { const float g = gv[ai][m];
#pragma unroll
                    for (int bj = 0; bj < 2; ++bj) store8bf(Yt + (size_t)row * DM + bj * 128, acc[ai][bj][m][0] * g, acc[ai][bj][m][1] * g); } } };
    fg::gemm_phase<false, MUnit>(lds, DEXP, S, E);
}

#define GRID_BAR() xcd_barrier(bar)
__global__ void __launch_bounds__(NTHREADS, 2) fwd(Args a) {
    extern __shared__ __attribute__((aligned(16))) unsigned char lds_raw[];
    LAS unsigned char* lds = (LAS unsigned char*)lds_raw;
    (void)a;
    if (threadIdx.x < 4) ((LAS unsigned*)(lds + LDS_BARW))[threadIdx.x] = 0u;
    __syncthreads();
    unsigned* ctl0 = (unsigned*)arg_ptr(30);
    const XcdBarrier bar = xcd_barrier_post(ctl0 + CW_BAR, (volatile LAS unsigned*)(lds + LDS_BARW));
    ph_convert_dense(lds);
    if (CV_MODE >= 1) ph_convert_moe<0>(lds);
    norm_rows<0>(lds, const_cast<float*>(INF(0)), INF(2), nullptr); GRID_BAR();
    ph_gemm_z<0>(lds); GRID_BAR();
    ph_mla_prep(); GRID_BAR();
    ph_gemm_qkv(lds); GRID_BAR();
    fa::attn_phase<0>(lds); GRID_BAR();
    ph_gemm_wo<0>(lds); GRID_BAR();
    ph_router<0>(lds); GRID_BAR();
    ph_route<0>(); GRID_BAR();
    ph_gateup<0>(lds); GRID_BAR();
    ph_down<0>(lds); GRID_BAR();
    norm_rows<1>(lds, (float*)arg_ptr(29), INF(17), (const unsigned*)arg_ptr(30) + CW_CNT0); if (CV_MODE >= 1) ph_convert_moe<1>(lds); GRID_BAR();
    ph_gemm_z<1>(lds); GRID_BAR();
    ph_fox_prep(lds); GRID_BAR();
    fa::attn_phase<1>(lds); GRID_BAR();
    ph_gemm_wo<1>(lds); GRID_BAR();
    ph_router<1>(lds); GRID_BAR();
    ph_route<1>(); GRID_BAR();
    ph_gateup<1>(lds); GRID_BAR();
    ph_down<1>(lds); GRID_BAR();
    norm_rows<2>(lds, (float*)arg_ptr(29), nullptr, (const unsigned*)arg_ptr(30) + CW_CNT1);
}

extern "C" void kernel_launch(void* const* d_in, const int* in_sizes, int n_in, void* d_out, int out_size, void* d_ws, size_t ws_size, hipStream_t stream) {
    static int grid = 0;
    if (grid == 0) {
        if (n_in != 29 || out_size != T * DM || ws_size < WS_END) { fprintf(stderr, "kernel_launch: unexpected shapes (n_in %d out %d ws %zu, need %zu)\n", n_in, out_size, ws_size, (size_t)WS_END); grid = -1; return; }
        int dev = 0, cus = 0;
        if (hipGetDevice(&dev) != hipSuccess || hipDeviceGetAttribute(&cus, hipDeviceAttributeMultiprocessorCount, dev) != hipSuccess || cus <= 0) cus = 256;
        if (hipFuncSetAttribute((const void*)fwd, hipFuncAttributeMaxDynamicSharedMemorySize, LDS_BYTES) != hipSuccess) fprintf(stderr, "kernel_launch: hipFuncSetAttribute failed\n");
        grid = cus & ~7;
        if (grid < 8) grid = 8;
    }
    if (grid < 0) return;
    (void)in_sizes;
    (void)hipMemsetAsync((char*)d_ws + WS_CTL, 0, CTL_BYTES, stream);
    Args a{};
    for (int i = 0; i < 29; ++i) a.in[i] = d_in[i];
    a.out = (float*)d_out; a.ws = (unsigned char*)d_ws;
    hipLaunchKernelGGL(fwd, dim3(grid), dim3(NTHREADS), LDS_BYTES, stream, a);
}
```

```cpp
#include <hip/hip_runtime.h>
#include <cstdio>
#include <cstdint>
#ifndef CV_MODE
#define CV_MODE 0
#endif

#define LAS __attribute__((address_space(3)))
typedef unsigned short bf16;
typedef short bf16x8 __attribute__((ext_vector_type(8)));
typedef float f32x4 __attribute__((ext_vector_type(4)));
typedef unsigned u32x4 __attribute__((ext_vector_type(4)));
typedef unsigned u32x2 __attribute__((ext_vector_type(2)));

constexpr int T = 16384, DM = 2048, NB = 4, SEQ = 4096, NH = 16;
constexpr int NEXP = 64, DEXP = 512;
constexpr float EPS = 1e-6f;
constexpr int NTHREADS = 512, NWAVES = 8;

constexpr size_t MiB = 1u << 20;
constexpr size_t WS_CTL = 0, CTL_BYTES = 1 * MiB;
constexpr size_t WS_W_IN0T = 1 * MiB;
constexpr size_t WS_W_UQT = WS_W_IN0T + 5 * MiB;
constexpr size_t WS_W_UKVT = WS_W_UQT + 3 * MiB;
constexpr size_t WS_W_O0T = WS_W_UKVT + 4 * MiB;
constexpr size_t WS_W_IN1T = WS_W_O0T + 8 * MiB;
constexpr size_t WS_W_O1T = WS_W_IN1T + 33 * MiB;
constexpr size_t WS_W_GUT = WS_W_O1T + 8 * MiB;
constexpr size_t WS_W_DT = WS_W_GUT + 256 * MiB;
constexpr size_t WS_HN = WS_W_DT + 128 * MiB;
constexpr size_t WS_Z = WS_HN + 64 * MiB;
constexpr size_t WS_CQN = WS_Z + 256 * MiB;
constexpr size_t WS_CKVN = WS_CQN + 16 * MiB;
constexpr size_t WS_KR = WS_CKVN + 16 * MiB;
constexpr size_t WS_Q = WS_KR + 2 * MiB;
constexpr size_t WS_K = WS_Q + 96 * MiB;
constexpr size_t WS_V = WS_K + 96 * MiB;
constexpr size_t WS_O = WS_V + 64 * MiB;
constexpr size_t WS_H1 = WS_O + 64 * MiB;
constexpr size_t WS_RL = WS_H1 + 128 * MiB;
constexpr size_t WS_SSQ = WS_RL, WS_RSL = WS_RL + 2 * MiB;
constexpr size_t WS_TOK = WS_RL + 8 * MiB;
constexpr size_t WS_GATE = WS_TOK + 4 * MiB;
constexpr size_t WS_TSLOT = WS_GATE + 4 * MiB;
constexpr size_t WS_ACT = WS_TSLOT + 1 * MiB;
constexpr size_t WS_YS = WS_ACT + 48 * MiB;
constexpr size_t WS_FLOG = WS_YS + 192 * MiB;
constexpr size_t WS_C = WS_FLOG + 1 * MiB;
constexpr size_t WS_QL = WS_C + 1 * MiB;
constexpr size_t WS_KVL = WS_QL + 96 * MiB;
constexpr size_t WS_SK = WS_KVL + 128 * MiB;
constexpr size_t WS_PK = WS_SK + 4 * MiB;
constexpr size_t WS_PF = WS_PK + 16 * MiB;
constexpr size_t WS_PR = WS_PF + 4 * MiB;
constexpr size_t WS_END = WS_PR + 20 * MiB;
constexpr int CW_CNT0 = 1024, CW_CNT1 = 2048;
constexpr int CW_BAR = 4096;
constexpr int LDS_BARW = 155 * 1024, LDS_TS = LDS_BARW + 64, LDS_CN = LDS_BARW + 64 + 272, LDS_TE = LDS_BARW + 64 + 272 + 256, LDS_XS = LDS_BARW + 64 + 272 + 256 + 192, LDS_BYTES = 156 * 1024;

__device__ __forceinline__ float bf2f(unsigned b) { return __uint_as_float(b << 16); }
__device__ __forceinline__ unsigned f2bf(float f) { unsigned u = __float_as_uint(f); return (u + 0x7fffu + ((u >> 16) & 1u)) >> 16; }
__device__ __forceinline__ unsigned pk2(float lo, float hi) { unsigned r; asm("v_cvt_pk_bf16_f32 %0, %1, %2" : "=v"(r) : "v"(lo), "v"(hi)); return r; }
__device__ __forceinline__ float wave_sum(float v) {
#pragma unroll
    for (int o = 1; o < 64; o <<= 1) v += __shfl_xor(v, o);
    return v;
}
__device__ __forceinline__ float wave_max(float v) {
#pragma unroll
    for (int o = 1; o < 64; o <<= 1) v = fmaxf(v, __shfl_xor(v, o));
    return v;
}
__device__ __forceinline__ int otid() { int t = threadIdx.x; asm volatile("" : "+v"(t)); return t; }
__device__ __forceinline__ int obid() { int t = blockIdx.x; asm volatile("" : "+s"(t)); return t; }
__device__ __forceinline__ int ogrid() { int t = gridDim.x; asm volatile("" : "+s"(t)); return t; }
__device__ __forceinline__ float rsq(float x) { return __builtin_amdgcn_rsqf(x); }
__device__ __forceinline__ float rope64(float xn, int lane, float pos) {
    const float partner = __shfl_xor(xn, 32);
    const int i = lane & 31;
    const float freq = exp2f(-(float)i * (13.287712379549449f / 32.0f));
    const float ang = pos * freq;
    float rev = ang * 0.15915494309189535f; rev -= floorf(rev);
    const float s = __builtin_amdgcn_sinf(rev), c = __builtin_amdgcn_cosf(rev);
    return lane < 32 ? xn * c - partner * s : xn * c + partner * s;
}

enum { B_N_F32 = 0, B_N_BF16 = 1, B_T_BF16 = 2 };
template <int BMODE, class AP, class BP, class EP>
__device__ __forceinline__ void sg_tile(LAS unsigned char* lds, const AP& ap, const BP& bp, const EP& ep, int kbeg, int kend) {
    const int tid = otid(), wave = tid >> 6, lane = tid & 63, fr = lane & 15, fq = lane >> 4, wm = wave >> 2, wn = wave & 3;
    LAS bf16* sA = (LAS bf16*)lds; LAS bf16* sB = sA + 128 * 40;
    const bf16* pa = ap.row(tid >> 2) + (tid & 3) * 8;
    const int chunk = tid & 15, kk = tid >> 4;
    const bf16* pbt = nullptr; const float* pbf = nullptr; const bf16* pbh = nullptr; int ldb = 0;
    if constexpr (BMODE == B_T_BF16) { pbt = bp.row(tid >> 2); if (pbt) pbt += (tid & 3) * 8; }
    else if constexpr (BMODE == B_N_F32) { pbf = bp.col8(chunk, ldb); }
    else { pbh = bp.col8(chunk, ldb); }
    f32x4 acc[4][2];
#pragma unroll
    for (int mi = 0; mi < 4; ++mi)
#pragma unroll
        for (int ni = 0; ni < 2; ++ni) acc[mi][ni] = (f32x4){0.f, 0.f, 0.f, 0.f};
    for (int k0 = kbeg; k0 < kend; k0 += 32) {
        const u32x4 ra = *(const u32x4*)(pa + k0);
        u32x4 rb = (u32x4){0u, 0u, 0u, 0u};
        if constexpr (BMODE == B_T_BF16) { if (pbt) rb = *(const u32x4*)(pbt + k0); }
        else if constexpr (BMODE == B_N_F32) {
            if (pbf) { const float* p = pbf + (size_t)(k0 + kk) * ldb; const f32x4 x = *(const f32x4*)p, y = *(const f32x4*)(p + 4);
                rb = (u32x4){pk2(x[0], x[1]), pk2(x[2], x[3]), pk2(y[0], y[1]), pk2(y[2], y[3])}; }
        } else { if (pbh) rb = *(const u32x4*)(pbh + (size_t)(k0 + kk) * ldb); }
        __syncthreads();
        *(LAS u32x4*)(sA + (tid >> 2) * 40 + (tid & 3) * 8) = ra;
        if constexpr (BMODE == B_T_BF16) { *(LAS u32x4*)(sB + (tid >> 2) * 40 + (tid & 3) * 8) = rb; }
        else {
#pragma unroll
            for (int j = 0; j < 8; ++j) sB[(chunk * 8 + j) * 40 + kk] = (bf16)((rb[j >> 1] >> ((j & 1) * 16)) & 0xffffu);
        }
        __syncthreads();
        bf16x8 a[4], b[2];
#pragma unroll
        for (int mi = 0; mi < 4; ++mi) a[mi] = *(const LAS bf16x8*)(sA + (wm * 64 + mi * 16 + fr) * 40 + fq * 8);
#pragma unroll
        for (int ni = 0; ni < 2; ++ni) b[ni] = *(const LAS bf16x8*)(sB + (wn * 32 + ni * 16 + fr) * 40 + fq * 8);
#pragma unroll
        for (int mi = 0; mi < 4; ++mi)
#pragma unroll
            for (int ni = 0; ni < 2; ++ni) acc[mi][ni] = __builtin_amdgcn_mfma_f32_16x16x32_bf16(b[ni], a[mi], acc[mi][ni], 0, 0, 0);
    }
#pragma unroll
    for (int mi = 0; mi < 4; ++mi) ep(wm * 64 + mi * 16 + fr, wn * 32 + 4 * fq, acc[mi][0], acc[mi][1]);
}

struct APlain { const bf16* A; size_t lda; __device__ __forceinline__ const bf16* row(int r) const { return A + (size_t)r * lda; } };
struct BPlainF32 { const float* B; int ldb_, ncols; int n0;
    __device__ __forceinline__ const float* col8(int chunk, int& ldb) const { ldb = ldb_; const int c = n0 + chunk * 8; return c < ncols ? B + c : nullptr; } };
struct BPlainBf16 { const bf16* B; int ldb_;
    __device__ __forceinline__ const bf16* col8(int chunk, int& ldb) const { ldb = ldb_; return B + chunk * 8; } };
struct BRowsT { const bf16* Bt; size_t ld; __device__ __forceinline__ const bf16* row(int r) const { return Bt + (size_t)r * ld; } };

__device__ __forceinline__ void store4bf(bf16* p, f32x4 v) { *(u32x2*)p = (u32x2){pk2(v[0], v[1]), pk2(v[2], v[3])}; }
__device__ __forceinline__ void store8bf(bf16* p, f32x4 a, f32x4 b) { *(u32x4*)p = (u32x4){pk2(a[0], a[1]), pk2(a[2], a[3]), pk2(b[0], b[1]), pk2(b[2], b[3])}; }

struct EpBf16 { bf16* C; size_t ldc; int n0, N;
    __device__ __forceinline__ void operator()(int rl, int cl, f32x4 v0, f32x4 v1) const {
        bf16* p = C + (size_t)rl * ldc; const int c = n0 + cl;
        if (c < N) store4bf(p + c, v0);
        if (c + 16 < N) store4bf(p + c + 16, v1); } };
struct EpResF32 { const float* R; float* C; int n0;
    __device__ __forceinline__ void operator()(int rl, int cl, f32x4 v0, f32x4 v1) const {
        const size_t o = (size_t)rl * DM + n0 + cl;
        *(f32x4*)(C + o) = *(const f32x4*)(R + o) + v0; *(f32x4*)(C + o + 16) = *(const f32x4*)(R + o + 16) + v1; } };


#define XB_TMO      128
#define XB_XCNT(j)  (256  + 64 * (j))
#define XB_XSUB(j)  (1280 + 64 * (j))
#define XB_XGEN(j)  (2304 + 64 * (j))
#define XB_TOP      3328
#define XB_TOPGEN   3392
#define XCD_BAR_WORDS 3456
#define XB_SPIN_CAP (1u << 18)

__device__ __forceinline__ unsigned xb_ld(unsigned* p)              { return __hip_atomic_load(p, __ATOMIC_RELAXED, __HIP_MEMORY_SCOPE_AGENT); }
__device__ __forceinline__ unsigned xb_add(unsigned* p, unsigned v) { return __hip_atomic_fetch_add(p, v, __ATOMIC_RELAXED, __HIP_MEMORY_SCOPE_AGENT); }
__device__ __forceinline__ unsigned xb_xcc_id() { return (unsigned)__builtin_amdgcn_s_getreg((3 << 11) | 20) & 0xFu; }
#define XB_SPIN(cond, bar) do { unsigned _sp = 0; while (cond) { __builtin_amdgcn_s_sleep(1); \
    if ((++_sp & 255u) == 0u) { if (xb_ld(&(bar)[XB_TMO])) break; if (_sp > XB_SPIN_CAP) { atomicAdd(&(bar)[XB_TMO], 1u); break; } } } } while (0)

struct XcdBarrier {
    unsigned* bar; unsigned x;
    volatile LAS unsigned* st;
};

__device__ __forceinline__ XcdBarrier xcd_barrier_post(unsigned* bar, volatile LAS unsigned* st) {
    XcdBarrier b; b.bar = bar; b.x = xb_xcc_id(); b.st = st;
    if (threadIdx.x == 0) (void)xb_add(&bar[XB_XCNT(b.x)], 1u);
    return b;
}
__device__ __forceinline__ void xcd_barrier_complete(unsigned* bar, unsigned x, unsigned& nloc, unsigned& nx) {
    const unsigned G = gridDim.x * gridDim.y * gridDim.z;
    unsigned sum, cnt, mine, sp = 0u;
    for (;;) {
        sum = 0u; cnt = 0u; mine = 0u;
#pragma unroll
        for (unsigned j = 0; j < 16; ++j) { const unsigned c = xb_ld(&bar[XB_XCNT(j)]); sum += c; cnt += (c > 0u) ? 1u : 0u; mine = (j == x) ? c : mine; }
        if (sum == G) break;
        __builtin_amdgcn_s_sleep(1);
        if ((++sp & 255u) == 0u) { if (xb_ld(&bar[XB_TMO])) break; if (sp > XB_SPIN_CAP) { atomicAdd(&bar[XB_TMO], 1u); break; } }
    }
    nloc = mine > 0u ? mine : 1u; nx = cnt > 0u ? cnt : 1u;
}

__device__ __forceinline__ void xcd_barrier(const XcdBarrier& b) {
    asm volatile("s_waitcnt vmcnt(0)" ::: "memory");
    __syncthreads();
    if (threadIdx.x == 0) {
        unsigned* bar = b.bar;
        __builtin_amdgcn_s_waitcnt(0);
        unsigned nloc = b.st[0], nx = b.st[1];
        if (nloc == 0u) { xcd_barrier_complete(bar, b.x, nloc, nx); b.st[0] = nloc; b.st[1] = nx; }
        const unsigned old = xb_add(&bar[XB_XSUB(b.x)], 1u);
        const unsigned gen = old / nloc;
        if (old + 1u == (gen + 1u) * nloc) {
            __builtin_amdgcn_fence(__ATOMIC_RELEASE, "agent");
            asm volatile("s_waitcnt vmcnt(0)" ::: "memory");
            const unsigned og = xb_add(&bar[XB_TOP], 1u);
            const unsigned tg = og / nx;
            if (og + 1u == (tg + 1u) * nx) xb_add(&bar[XB_TOPGEN], 1u);
            else XB_SPIN(xb_ld(&bar[XB_TOPGEN]) == tg, bar);
            __builtin_amdgcn_fence(__ATOMIC_ACQUIRE, "agent");
            xb_add(&bar[XB_XGEN(b.x)], 1u);
            asm volatile("s_waitcnt vmcnt(0)" ::: "memory");
        } else {
            XB_SPIN(xb_ld(&bar[XB_XGEN(b.x)]) == gen, bar);
            __builtin_amdgcn_fence(__ATOMIC_ACQUIRE, "agent");
            asm volatile("s_waitcnt vmcnt(0)" ::: "memory");
        }
    }
    __syncthreads();
}

namespace fg {
constexpr int BM = 256, BK = 64, HALF = 128, HTB = HALF * BK * 2, STAGE_BYTES = 8 * HTB;
__host__ __device__ __forceinline__ int lds_byte(int r, int c) { const int st = (r >> 4) * 2 + (c >> 5), rr = r & 15, cc = c & 31, ob = rr * 64 + cc * 2; return st * 1024 + (ob ^ (((ob >> 9) & 1) << 5)); }
__host__ __device__ __forceinline__ void stage_rc(int b, int& R, int& C) { const int st = b / 1024, sb = b % 1024, swz = sb ^ (((sb >> 9) & 1) << 5); R = (st >> 1) * 16 + swz / 64; C = (st & 1) * 32 + (swz % 64) / 2; }

template <bool GATHER, class Unit, class Epi, class Sched>
__device__ __forceinline__ void gemm_phase(LAS unsigned char* lds, const int K, const Sched& S, const Epi& E) {
    const int tid = otid(), wid = __builtin_amdgcn_readfirstlane(tid >> 6), lane = tid & 63, wr = wid >> 2, wc = wid & 3, fr = lane & 15, fq = lane >> 4;
    const int nt = K / BK;
    int R0, C0, R1, C1; stage_rc(tid * 16, R0, C0); stage_rc(tid * 16 + 8192, R1, C1);
    const int Rb0 = (R0 & ~31) + 8 * ((R0 & 15) >> 2) + 4 * ((R0 >> 4) & 1) + (R0 & 3), Rb1 = (R1 & ~31) + 8 * ((R1 & 15) >> 2) + 4 * ((R1 >> 4) & 1) + (R1 & 3);
    const unsigned voffB0 = (unsigned)(Rb0 * K + C0) * 2u, voffB1 = (unsigned)(Rb1 * K + C1) * 2u;
    const size_t kstep = (size_t)(BK * 2);
    const size_t hstepB = (size_t)HALF * K * 2;
    const unsigned ldsw = (unsigned)wid * 1024u;
    const int aoff = lds_byte(wr * 64 + fr, fq * 8), boff = lds_byte(wc * 32 + fr, fq * 8);
#define FG_SA(b, h) (((b) * 2 + (h)) * HTB)
#define FG_SB(b, h) ((4 + (b) * 2 + (h)) * HTB)
#define FG_STAGE(bufoff, gbase, v0, v1) do { \
        __builtin_amdgcn_global_load_lds((const unsigned*)((const char*)(gbase) + (v0)), (LAS unsigned*)(lds + (bufoff) + ldsw), 16, 0, 0); \
        __builtin_amdgcn_global_load_lds((const unsigned*)((const char*)(gbase) + (v1)), (LAS unsigned*)(lds + (bufoff) + ldsw + 8192), 16, 0, 0); } while (0)
#define FG_LDA(dst, b, h) do { _Pragma("unroll") for (int m = 0; m < 4; ++m) _Pragma("unroll") for (int k = 0; k < 2; ++k) dst[m][k] = *(const LAS bf16x8*)(lds + FG_SA(b, h) + aoff + m * 2048 + k * 1024); } while (0)
#define FG_LDB(dst, b, h) do { _Pragma("unroll") for (int n = 0; n < 2; ++n) _Pragma("unroll") for (int k = 0; k < 2; ++k) dst[n][k] = *(const LAS bf16x8*)(lds + FG_SB(b, h) + boff + n * 2048 + k * 1024); } while (0)
#define FG_MMA(ai, bj, At, Bt) do { __builtin_amdgcn_s_setprio(1); _Pragma("unroll") for (int m = 0; m < 4; ++m) _Pragma("unroll") for (int n = 0; n < 2; ++n) _Pragma("unroll") for (int k = 0; k < 2; ++k) \
        acc[ai][bj][m][n] = __builtin_amdgcn_mfma_f32_16x16x32_bf16(Bt[n][k], At[m][k], acc[ai][bj][m][n], 0, 0, 0); __builtin_amdgcn_s_setprio(0); } while (0)
#define FG_WAIT_V(n) asm volatile("s_waitcnt vmcnt(" #n ")" ::: "memory")
#define FG_WAIT_L(n) asm volatile("s_waitcnt lgkmcnt(" #n ")" ::: "memory")
#define FG_BAR __builtin_amdgcn_s_barrier()
#define FG_SCHED __builtin_amdgcn_sched_barrier(0)
    Unit cur, nxt; int ui = 0;
    if (!S.next(0, cur)) return;
    f32x4 acc[2][2][4][2];
#pragma unroll
    for (int a = 0; a < 2; ++a)
#pragma unroll
        for (int b = 0; b < 2; ++b)
#pragma unroll
            for (int m = 0; m < 4; ++m)
#pragma unroll
                for (int n = 0; n < 2; ++n) acc[a][b][m][n] = (f32x4){0.f, 0.f, 0.f, 0.f};
    bf16x8 At[4][2], B0[2][2], B1[2][2];
    const char* cA = S.a_base(cur); const char* cB = S.b_base(cur);
    unsigned vA00 = S.a_voff(cur, R0, C0), vA01 = S.a_voff(cur, R1, C1), vA10 = S.a_voff(cur, HALF + R0, C0), vA11 = S.a_voff(cur, HALF + R1, C1);
    unsigned vN00 = vA00, vN01 = vA01, vN10 = vA10, vN11 = vA11;
    bool hi_on = !S.lo_only(cur);
    FG_STAGE(FG_SB(0, 0), cB, voffB0, voffB1); FG_STAGE(FG_SB(0, 1), cB + hstepB, voffB0, voffB1); FG_STAGE(FG_SA(0, 0), cA, vA00, vA01); FG_STAGE(FG_SA(0, 1), cA, vA10, vA11);
    if (wr == 1) FG_BAR;
    FG_WAIT_V(2); FG_BAR;
    FG_STAGE(FG_SB(1, 0), cB + kstep, voffB0, voffB1); FG_STAGE(FG_SA(1, 0), cA + kstep, vA00, vA01); FG_STAGE(FG_SB(1, 1), cB + hstepB + kstep, voffB0, voffB1);
    FG_WAIT_V(6); FG_BAR;
    for (;;) {
        const bool has_next = S.next(ui + 1, nxt);
        const char* nA = has_next ? S.a_base(nxt) : cA; const char* nB = has_next ? S.b_base(nxt) : cB;
        if (GATHER) { if (has_next) { vN00 = S.a_voff(nxt, R0, C0); vN01 = S.a_voff(nxt, R1, C1); vN10 = S.a_voff(nxt, HALF + R0, C0); vN11 = S.a_voff(nxt, HALF + R1, C1); }
                      else { vN00 = vA00; vN01 = vA01; vN10 = vA10; vN11 = vA11; } }
        for (int t = 0; t < nt; t += 2) {
            const bool last = (t == nt - 2);
            const char* a1 = cA + (size_t)(t + 1) * kstep;
            const char* a2 = last ? nA : cA + (size_t)(t + 2) * kstep; const char* b2 = last ? nB : cB + (size_t)(t + 2) * kstep;
            const char* a3 = a2 + kstep; const char* b3 = b2 + kstep;
            const unsigned x00 = (GATHER && last) ? vN00 : vA00, x01 = (GATHER && last) ? vN01 : vA01, x10 = (GATHER && last) ? vN10 : vA10, x11 = (GATHER && last) ? vN11 : vA11;
            FG_LDB(B0, 0, 0); FG_LDB(B1, 0, 1); FG_SCHED; FG_LDA(At, 0, 0); FG_STAGE(FG_SA(1, 1), a1, vA10, vA11);
            FG_WAIT_V(8); FG_WAIT_L(0); FG_BAR; FG_MMA(0, 0, At, B0); FG_MMA(0, 1, At, B1); FG_BAR; FG_SCHED;
            FG_LDA(At, 0, 1); FG_STAGE(FG_SB(0, 0), b2, voffB0, voffB1); FG_STAGE(FG_SB(0, 1), b2 + hstepB, voffB0, voffB1); FG_STAGE(FG_SA(0, 0), a2, x00, x01);
            FG_WAIT_V(8); FG_WAIT_L(0); FG_BAR; if (hi_on) { FG_MMA(1, 0, At, B0); FG_MMA(1, 1, At, B1); } FG_BAR; FG_SCHED;
            FG_LDB(B0, 1, 0); FG_LDB(B1, 1, 1); FG_SCHED; FG_LDA(At, 1, 0); FG_STAGE(FG_SA(0, 1), a2, x10, x11);
            FG_WAIT_V(8); FG_WAIT_L(0); FG_BAR; FG_MMA(0, 0, At, B0); FG_MMA(0, 1, At, B1); FG_BAR; FG_SCHED;
            FG_LDA(At, 1, 1); FG_STAGE(FG_SB(1, 0), b3, voffB0, voffB1); FG_STAGE(FG_SB(1, 1), b3 + hstepB, voffB0, voffB1); FG_STAGE(FG_SA(1, 0), a3, x00, x01);
            FG_WAIT_V(8); FG_WAIT_L(0); FG_BAR; if (hi_on) { FG_MMA(1, 0, At, B0); FG_MMA(1, 1, At, B1); } FG_BAR; FG_SCHED;
        }
        if (wr == 0) FG_BAR;
        { int tz = threadIdx.x; asm volatile("" : "+v"(tz));
          const int lz = tz & 63; E(acc, cur, (tz >> 6) >> 2, (tz >> 6) & 3, lz & 15, lz >> 4); }
        if (!has_next) break;
#pragma unroll
        for (int a = 0; a < 2; ++a)
#pragma unroll
            for (int b = 0; b < 2; ++b)
#pragma unroll
                for (int m = 0; m < 4; ++m)
#pragma unroll
                    for (int n = 0; n < 2; ++n) acc[a][b][m][n] = (f32x4){0.f, 0.f, 0.f, 0.f};
        cur = nxt; cA = nA; cB = nB; ++ui; hi_on = !S.lo_only(cur);
        if (GATHER) { vA00 = vN00; vA01 = vN01; vA10 = vN10; vA11 = vN11; }
        if (wr == 1) FG_BAR;
    }
    FG_WAIT_V(0);
    FG_BAR;
#undef FG_SA
#undef FG_SB
#undef FG_STAGE
#undef FG_LDA
#undef FG_LDB
#undef FG_MMA
#undef FG_WAIT_V
#undef FG_WAIT_L
#undef FG_BAR
#undef FG_SCHED
}

struct DUnit { int p, pm, pn, par; };
struct DenseSched {
    const bf16* A0; const bf16* B0; int nN0; const bf16* A1; const bf16* B1; int nN1; int K, G, c;
    static constexpr int nM = T / 256, NXCD = 8, WGM = 8;
    __device__ __forceinline__ bool next(int i, DUnit& u) const {
        long L = (long)i * G + c; const int nwg0 = nM * nN0, nwg1 = nM * nN1;
        int nN, nwg; if (L < nwg0) { u.p = 0; nN = nN0; nwg = nwg0; } else { L -= nwg0; if (L >= nwg1) return false; u.p = 1; nN = nN1; nwg = nwg1; }
        int wgid = (int)L; { const int q = nwg / NXCD, r = nwg % NXCD, xcd = wgid % NXCD, off = wgid / NXCD; wgid = (xcd < r ? xcd * (q + 1) : r * (q + 1) + (xcd - r) * q) + off; }
        const int nig = WGM * nN, gid = wgid / nig, fm = gid * WGM, gsz = (nM - fm) < WGM ? (nM - fm) : WGM;
        u.pm = fm + ((wgid % nig) % gsz); u.pn = (wgid % nig) / gsz; u.par = i & 1; return true;
    }
    __device__ __forceinline__ const char* a_base(const DUnit& u) const { return (const char*)(u.p ? A1 : A0) + (size_t)u.pm * 256 * K * 2; }
    __device__ __forceinline__ const char* b_base(const DUnit& u) const { return (const char*)(u.p ? B1 : B0) + (size_t)u.pn * 256 * K * 2; }
    __device__ __forceinline__ unsigned a_voff(const DUnit&, int row, int col) const { return (unsigned)(row * K + col) * 2u; }
    __device__ __forceinline__ bool lo_only(const DUnit&) const { return false; }
};
struct SkUnit { int pm, ks; };
struct SkinnySched {
    const char* A; const char* B; int G, c;
    __device__ __forceinline__ bool next(int i, SkUnit& u) const { const int L = i * G + c; if (L >= (T / 256) * 4) return false; u.pm = L >> 2; u.ks = L & 3; return true; }
    __device__ __forceinline__ const char* a_base(const SkUnit& u) const { return A + ((size_t)u.pm * 256 * DM + u.ks * 512) * 2; }
    __device__ __forceinline__ const char* b_base(const SkUnit& u) const { return B + (size_t)u.ks * 256 * 512 * 2; }
    __device__ __forceinline__ unsigned a_voff(const SkUnit&, int row, int col) const { return (unsigned)(row * DM + col) * 2u; }
    __device__ __forceinline__ bool lo_only(const SkUnit&) const { return false; }
};
#define FG_FOREACH(acc, BODY) do { _Pragma("unroll") for (int ai = 0; ai < 2; ++ai) _Pragma("unroll") for (int m = 0; m < 4; ++m) { const int row = ai * 128 + wr * 64 + m * 16 + fr; \
        _Pragma("unroll") for (int bj = 0; bj < 2; ++bj) { const int col = bj * 128 + wc * 32 + 8 * fq; const f32x4 v0 = acc[ai][bj][m][0], v1 = acc[ai][bj][m][1]; BODY } } } while (0)
}

template <class RowMap>
__device__ __forceinline__ void transpose_item(const float* W, int K, int N, bf16* WT, const RowMap& rowmap, LAS float* scr, int item, int lane) {
    const int nblk = (N + 31) / 32, kb = item / nblk, nb = item % nblk, k0 = 64 * kb, n0 = 32 * nb; const bool cv = n0 + (lane & 31) < N;
#pragma unroll 8
    for (int i = 0; i < 32; ++i) { const int kk = 2 * i + (lane >> 5); scr[kk * 33 + (lane & 31)] = cv ? W[(size_t)(k0 + kk) * N + n0 + (lane & 31)] : 0.f; }
    asm volatile("s_waitcnt lgkmcnt(0)" ::: "memory");
    const int c = lane & 7;
#pragma unroll
    for (int j = 0; j < 4; ++j) { const int n = (lane >> 3) + 8 * j; const LAS float* sp = scr + (8 * c) * 33 + n;
        u32x4 o; o.x = pk2(sp[0 * 33], sp[1 * 33]); o.y = pk2(sp[2 * 33], sp[3 * 33]); o.z = pk2(sp[4 * 33], sp[5 * 33]); o.w = pk2(sp[6 * 33], sp[7 * 33]);
        const int dr = rowmap(n0 + n);
        if (dr >= 0) *(u32x4*)(WT + (size_t)dr * K + k0 + 8 * c) = o; }
    asm volatile("s_waitcnt lgkmcnt(0)" ::: "memory");
}
template <class RowMap>
__device__ __forceinline__ void transpose_item16(const float* W, int K, int N, bf16* WT, const RowMap& rowmap, LAS unsigned char* scr, int item, int lane) {
    const int nblk = (N + 31) / 32, kb = item / nblk, nb = item % nblk, k0 = 64 * kb, n0 = 32 * nb, c = lane & 7, rr = lane >> 3; const bool cv = n0 + 4 * c < N;
    f32x4 v[8];
#pragma unroll
    for (int i = 0; i < 8; ++i) v[i] = cv ? __builtin_nontemporal_load((const f32x4*)(W + (size_t)(k0 + 8 * i + rr) * N + n0 + 4 * c)) : (f32x4){0.f, 0.f, 0.f, 0.f};
#pragma unroll
    for (int i = 0; i < 8; ++i) *(LAS f32x4*)(scr + (8 * i + rr) * 128 + ((c ^ i) << 4)) = v[i];
    asm volatile("s_waitcnt lgkmcnt(0)" ::: "memory");
    float t[4][8];
#pragma unroll
    for (int j = 0; j < 4; ++j) { const int n = rr + 8 * j; const LAS float* sp = (const LAS float*)scr + (8 * c) * 32 + (((n >> 2) ^ c) << 2) + (n & 3);
#pragma unroll
        for (int q = 0; q < 8; ++q) t[j][q] = sp[32 * q]; }
    asm volatile("s_waitcnt lgkmcnt(0)" ::: "memory");
#pragma unroll
    for (int j = 0; j < 4; ++j) { const int n = rr + 8 * j, dr = rowmap(n0 + n);
        if (dr >= 0) *(u32x4*)(WT + (size_t)dr * K + k0 + 8 * c) = (u32x4){pk2(t[j][0], t[j][1]), pk2(t[j][2], t[j][3]), pk2(t[j][4], t[j][5]), pk2(t[j][6], t[j][7])}; }
}
__device__ __forceinline__ void zero_rows(bf16* WT, int K, int r0, int r1, int gw, int ngw, int lane) {
    const size_t n8 = (size_t)(r1 - r0) * K / 8; u32x4* p = (u32x4*)(WT + (size_t)r0 * K);
    for (size_t i = (size_t)gw * 64 + lane; i < n8; i += (size_t)ngw * 64) p[i] = (u32x4){0u, 0u, 0u, 0u};
}

struct Args { const void* in[29]; float* out; unsigned char* ws; };
__device__ __forceinline__ int hide(int i) { asm volatile("" : "+s"(i)); return i; }
__device__ __forceinline__ const void* arg_ptr(int i) {
    typedef const void* cvp;
    const __attribute__((address_space(4))) cvp* ka = (const __attribute__((address_space(4))) cvp*)__builtin_amdgcn_kernarg_segment_ptr();
    return ka[hide(i)];
}
#define INF(i) ((const float*)arg_ptr(i))
#define PH_BEGIN unsigned char* ws = (unsigned char*)arg_ptr(30); \
    const int tid = otid(), lane = tid & 63, wave = tid >> 6, G = ogrid(), bx = obid(), gw = bx * NWAVES + wave, ngw = G * NWAVES; (void)lane; (void)gw; (void)ngw; (void)ws
#define WSP(TYPE, OFF) ((TYPE*)(ws + (OFF)))

__device__ __forceinline__ void unpack8(u32x4 w, float (&x)[8]) {
#pragma unroll
    for (int j = 0; j < 4; ++j) { x[2 * j] = bf2f(w[j] & 0xffffu); x[2 * j + 1] = bf2f(w[j] >> 16); }
}
__device__ __forceinline__ f32x4 bf4(u32x2 w) { return (f32x4){bf2f(w[0] & 0xffffu), bf2f(w[0] >> 16), bf2f(w[1] & 0xffffu), bf2f(w[1] >> 16)}; }

__device__ __forceinline__ void moe_prefix(LAS unsigned char* lds, const unsigned* cnt) {
    LAS int* s_ts = (LAS int*)(lds + LDS_TS); LAS int* s_cn = (LAS int*)(lds + LDS_CN);
    LAS unsigned char* s_te = lds + LDS_TE;
    LAS int* s_xs = (LAS int*)(lds + LDS_XS);
    const int tz_ = otid();
    if (tz_ < 64) { const int e = tz_; const int c = (int)cnt[e], nt = (c + 255) >> 8;
        int incl = nt;
#pragma unroll
        for (int o = 1; o < 64; o <<= 1) { const int up = __shfl_up(incl, o); if (e >= o) incl += up; }
        const int excl = incl - nt;
        s_ts[e] = excl; s_cn[e] = c;
        for (int i = 0; i < nt; ++i) s_te[excl + i] = (unsigned char)e;
        const int x = obid() & 7; int a2 = 0;
#pragma unroll
        for (int k = 0; k < 8; ++k) { const int tk = __shfl(nt, x + 8 * k); if (e == 0) s_xs[k] = a2; a2 += tk; }
        if (e == 0) s_xs[8] = a2; }
    __syncthreads();
}

__device__ __forceinline__ void ph_convert_dense(LAS unsigned char* lds) {
    PH_BEGIN;
    LAS unsigned char* scr = lds + wave * 8192;
    const float* w_in0 = INF(3); const float* w_uq = INF(6); const float* w_ukv = INF(7); const float* w_o0 = INF(9); const float* w_in1 = INF(18); const float* w_o1 = INF(21);
    bf16* W_IN0T = WSP(bf16, WS_W_IN0T); bf16* W_UQT = WSP(bf16, WS_W_UQT); bf16* W_UKVT = WSP(bf16, WS_W_UKVT); bf16* W_O0T = WSP(bf16, WS_W_O0T); bf16* W_IN1T = WSP(bf16, WS_W_IN1T); bf16* W_O1T = WSP(bf16, WS_W_O1T);
    constexpr int I0 = 32 * 34, I1 = 8 * 96, I2 = 8 * 128, I3 = 32 * 64, I4 = 32 * 257, I5 = 32 * 64;
    auto ident = [](int n) { return n; };
    auto map0 = [](int n) { return n < 1024 ? n : -1; };
    auto map1 = [](int n) { return n < 6144 ? n : (n < 6160 ? -1 : (n < 8208 ? n - 16 : -1)); };
    for (int it = gw; it < I0 + I1 + I2 + I3 + I4 + I5; it += ngw) {
        int r = it;
        if (r < I0) { transpose_item16(w_in0, DM, 1088, W_IN0T, map0, scr, r, lane); continue; } r -= I0;
        if (r < I1) { transpose_item16(w_uq, 512, 3072, W_UQT, ident, scr, r, lane); continue; } r -= I1;
        if (r < I2) { transpose_item16(w_ukv, 512, 4096, W_UKVT, ident, scr, r, lane); continue; } r -= I2;
        if (r < I3) { transpose_item16(w_o0, DM, DM, W_O0T, ident, scr, r, lane); continue; } r -= I3;
        if (r < I4) { transpose_item16(w_in1, DM, 8208, W_IN1T, map1, scr, r, lane); continue; } r -= I4;
        transpose_item16(w_o1, DM, DM, W_O1T, ident, scr, r, lane);
    }
    { bf16* SK = WSP(bf16, WS_SK); const float* w_rg0 = INF(11); const float* w_re0 = INF(13); const float* w_rg1 = INF(23); const float* w_re1 = INF(25);
      for (int idx = bx * NTHREADS + tid; idx < 4 * 256 * 256; idx += G * NTHREADS) {
          const int set = idx >> 16, n = (idx >> 8) & 255, k = (idx & 255) * 8, ks = k >> 9;
          float v[8];
#pragma unroll
          for (int i = 0; i < 8; ++i) { float x = 0.f;
              if (set == 0) { if (n < 64) x = w_in0[(size_t)(k + i) * 1088 + 1024 + n]; }
              else if (set == 1) { if (n < 16) x = w_in1[(size_t)(k + i) * 8208 + 6144 + n]; }
              else { const float* wg = set == 2 ? w_rg0 : w_rg1; const float* we = set == 2 ? w_re0 : w_re1; if (n < 8) x = wg[(k + i) * 8 + n]; else if (n < 72) x = we[(k + i) * 64 + n - 8]; }
              v[i] = x; }
          *(u32x4*)(SK + (size_t)set * (4 * 256 * 512) + ((size_t)ks * 256 + n) * 512 + (k & 511)) = (u32x4){pk2(v[0], v[1]), pk2(v[2], v[3]), pk2(v[4], v[5]), pk2(v[6], v[7])}; } }
}
template <int layer>
__device__ __forceinline__ void ph_convert_moe(LAS unsigned char* lds) {
    PH_BEGIN;
    LAS float* scr = (LAS float*)(lds + wave * 8448);
    const float* w_gu = INF(layer == 0 ? 15 : 27); const float* w_dn = INF(layer == 0 ? 16 : 28);
    bf16* W_GUT = WSP(bf16, WS_W_GUT); bf16* W_DT = WSP(bf16, WS_W_DT);
    auto gumap = [](int n) { const int which = n >> 9, f = n & 511; return (f >> 7) * 256 + ((f >> 6) & 1) * 128 + ((f >> 4) & 3) * 32 + ((f >> 2) & 3) * 8 + which * 4 + (f & 3); };
    auto ident = [](int n) { return n; };
    constexpr int IG = 32 * 32, ID = 8 * 64;
    for (int it = gw; it < NEXP * (IG + ID); it += ngw) {
        if (it < NEXP * IG) { const int e = it / IG, r = it % IG; transpose_item(w_gu + (size_t)e * DM * 1024, DM, 1024, W_GUT + (size_t)e * 1024 * DM, gumap, scr, r, lane); }
        else { const int v = it - NEXP * IG, e = v / ID, r = v % ID; transpose_item(w_dn + (size_t)e * DEXP * DM, DEXP, DM, W_DT + (size_t)e * DM * DEXP, ident, scr, r, lane); }
    }
}

template <int MODE>
__device__ __forceinline__ void norm_rows(LAS unsigned char* lds, float* in, const float* gain, const unsigned* cnt) {
    PH_BEGIN;
    bf16* HN = WSP(bf16, WS_HN); const bf16* YS = WSP(bf16, WS_YS); const int* TSLOT = WSP(int, WS_TSLOT); bf16* H1b = WSP(bf16, WS_H1);
    if (MODE != 0) moe_prefix(lds, cnt);
    const LAS int* s_ts = (const LAS int*)(lds + LDS_TS);
    f32x4 gv[8];
    if (MODE != 2) {
#pragma unroll
        for (int jj = 0; jj < 4; ++jj) { gv[2 * jj] = *(const f32x4*)(gain + 8 * lane + 512 * jj); gv[2 * jj + 1] = *(const f32x4*)(gain + 8 * lane + 512 * jj + 4); } }
    for (int m0 = gw; m0 < T; m0 += 2 * ngw) {
        const int m1 = m0 + ngw; const bool has1 = m1 < T;
        float* xr[2] = {in + (size_t)m0 * DM + 8 * lane, in + (size_t)(has1 ? m1 : m0) * DM + 8 * lane};
        bf16* hb[2] = {H1b + (size_t)m0 * DM + 8 * lane, H1b + (size_t)(has1 ? m1 : m0) * DM + 8 * lane};
        const bf16* y0[2] = {nullptr, nullptr}; const bf16* y1[2] = {nullptr, nullptr};
        if (MODE != 0) {
#pragma unroll
            for (int r = 0; r < 2; ++r) { const int m = r ? (has1 ? m1 : m0) : m0; const int s0 = TSLOT[2 * m], s1 = TSLOT[2 * m + 1];
                y0[r] = YS + ((size_t)s_ts[s0 >> 16] * 256 + (s0 & 0xffff)) * DM + 8 * lane; y1[r] = YS + ((size_t)s_ts[s1 >> 16] * 256 + (s1 & 0xffff)) * DM + 8 * lane; } }
        f32x4 v[2][8]; u32x4 wh[2][4], wa[2][4], wb[2][4];
#pragma unroll
        for (int r = 0; r < 2; ++r)
#pragma unroll
            for (int jj = 0; jj < 4; ++jj) {
                if (MODE == 0) { v[r][2 * jj] = *(const f32x4*)(xr[r] + 512 * jj); v[r][2 * jj + 1] = *(const f32x4*)(xr[r] + 512 * jj + 4); }
                else { wh[r][jj] = *(const u32x4*)(hb[r] + 512 * jj); wa[r][jj] = *(const u32x4*)(y0[r] + 512 * jj); wb[r][jj] = *(const u32x4*)(y1[r] + 512 * jj); } }
#pragma unroll
        for (int r = 0; r < 2; ++r) { if (r == 1 && !has1) break;
            const int m = r ? m1 : m0; float ss = 0.f;
#pragma unroll
            for (int jj = 0; jj < 4; ++jj) {
                if (MODE != 0) {
                    v[r][2 * jj] = bf4((u32x2){wh[r][jj][0], wh[r][jj][1]}) + bf4((u32x2){wa[r][jj][0], wa[r][jj][1]}) + bf4((u32x2){wb[r][jj][0], wb[r][jj][1]});
                    v[r][2 * jj + 1] = bf4((u32x2){wh[r][jj][2], wh[r][jj][3]}) + bf4((u32x2){wa[r][jj][2], wa[r][jj][3]}) + bf4((u32x2){wb[r][jj][2], wb[r][jj][3]});
                    if (MODE == 1) store8bf(hb[r] + 512 * jj, v[r][2 * jj], v[r][2 * jj + 1]);
                    else { *(f32x4*)(xr[r] + 512 * jj) = v[r][2 * jj]; *(f32x4*)(xr[r] + 512 * jj + 4) = v[r][2 * jj + 1]; } }
#pragma unroll
                for (int e = 0; e < 2; ++e) { const f32x4 w = v[r][2 * jj + e]; ss += (w[0] * w[0] + w[1] * w[1]) + (w[2] * w[2] + w[3] * w[3]); } }
            if (MODE != 2) {
                ss = wave_sum(ss);
                const float rr = rsq(ss * (1.0f / DM) + EPS);
#pragma unroll
                for (int jj = 0; jj < 4; ++jj) store8bf(HN + (size_t)m * DM + 8 * lane + 512 * jj, v[r][2 * jj] * rr * gv[2 * jj], v[r][2 * jj + 1] * rr * gv[2 * jj + 1]);
            } }
    }
}

template <int NC>
__device__ __forceinline__ void skinny_gemm(LAS unsigned char* lds, const bf16* HN, const bf16* SKset, float* P, int G, int bx) {
    fg::SkinnySched S{(const char*)HN, (const char*)SKset, G, bx};
    auto E = [=](const f32x4 (&acc)[2][2][4][2], const fg::SkUnit& u, int wr, int wc, int fr, int fq) {
        if (NC == 16) {
            float* Pt = P + (size_t)u.ks * 16 * T + (size_t)u.pm * 256;
            FG_FOREACH(acc, { if (col < NC) { _Pragma("unroll") for (int j = 0; j < 4; ++j) { Pt[(size_t)(col + j) * T + row] = v0[j]; Pt[(size_t)(col + 4 + j) * T + row] = v1[j]; } } }); }
        else { float* Pt = P + ((size_t)u.ks * T + (size_t)u.pm * 256) * NC;
            FG_FOREACH(acc, { if (col < NC) { *(f32x4*)(Pt + (size_t)row * NC + col) = v0; *(f32x4*)(Pt + (size_t)row * NC + col + 4) = v1; } }); } };
    fg::gemm_phase<false, fg::SkUnit>(lds, 512, S, E);
}
constexpr int LDS_EPI_TAB = 131072;
template <int HMASK>
__device__ __forceinline__ void epi_head_rstd(LAS unsigned char* lds, const f32x4 (&acc)[2][2][4][2], int par, int wr, int wc, int fr, int fq, float (&rstd)[2][4][2]) {
    LAS float* tab = (LAS float*)(lds + LDS_EPI_TAB) + par * 2048;
#pragma unroll
    for (int ai = 0; ai < 2; ++ai)
#pragma unroll
        for (int m = 0; m < 4; ++m) { const int row = ai * 128 + wr * 64 + m * 16 + fr;
#pragma unroll
            for (int bj = 0; bj < 2; ++bj) if (HMASK & (1 << bj)) { const f32x4 a = acc[ai][bj][m][0], b = acc[ai][bj][m][1];
                float ss = (a[0] * a[0] + a[1] * a[1]) + (a[2] * a[2] + a[3] * a[3]) + (b[0] * b[0] + b[1] * b[1]) + (b[2] * b[2] + b[3] * b[3]);
                ss += __shfl_xor(ss, 16); ss += __shfl_xor(ss, 32);
                if (fq == 0) tab[(row * 2 + bj) * 4 + wc] = ss; } }
    asm volatile("s_waitcnt lgkmcnt(0)" ::: "memory"); __builtin_amdgcn_s_barrier(); asm volatile("" ::: "memory");
#pragma unroll
    for (int ai = 0; ai < 2; ++ai)
#pragma unroll
        for (int m = 0; m < 4; ++m) { const int row = ai * 128 + wr * 64 + m * 16 + fr;
#pragma unroll
            for (int bj = 0; bj < 2; ++bj) { rstd[ai][m][bj] = 1.f;
                if (HMASK & (1 << bj)) { const f32x4 t = *(const LAS f32x4*)(tab + (row * 2 + bj) * 4); rstd[ai][m][bj] = rsq(((t[0] + t[1]) + (t[2] + t[3])) * (1.0f / 128) + EPS); } } }
}
template <int layer>
__device__ __forceinline__ void ph_gemm_z(LAS unsigned char* lds) {
    PH_BEGIN;
    bf16* HN = WSP(bf16, WS_HN); bf16* Z = WSP(bf16, WS_Z);
    if (layer == 0) {
        fg::DenseSched S{HN, WSP(bf16, WS_W_IN0T), 4, nullptr, nullptr, 0, DM, G, bx};
        auto E = [=](const f32x4 (&acc)[2][2][4][2], const fg::DUnit& u, int wr, int wc, int fr, int fq) {
            bf16* Zt = Z + (size_t)u.pm * 256 * 1024 + u.pn * 256;
            FG_FOREACH(acc, { store8bf(Zt + (size_t)row * 1024 + col, v0, v1); }); };
        fg::gemm_phase<false, fg::DUnit>(lds, DM, S, E);
        skinny_gemm<64>(lds, HN, WSP(bf16, WS_SK), WSP(float, WS_PK), G, bx);
    } else {
        fg::DenseSched S{HN, WSP(bf16, WS_W_IN1T), 32, nullptr, nullptr, 0, DM, G, bx};
        const float* gk = INF(20) + 128;
        auto E = [=](const f32x4 (&acc)[2][2][4][2], const fg::DUnit& u, int wr, int wc, int fr, int fq) {
            bf16* Zt = Z + (size_t)u.pm * 256 * 8192 + u.pn * 256;
            if (u.pn < 8 || u.pn >= 16) { FG_FOREACH(acc, { store8bf(Zt + (size_t)row * 8192 + col, v0, v1); }); }
            else {
                float rstd[2][4][2]; epi_head_rstd<3>(lds, acc, u.par, wr, wc, fr, fq, rstd);
                const f32x4 g0 = *(const f32x4*)(gk + wc * 32 + 8 * fq), g1 = *(const f32x4*)(gk + wc * 32 + 8 * fq + 4);
#pragma unroll
                for (int ai = 0; ai < 2; ++ai)
#pragma unroll
                    for (int m = 0; m < 4; ++m) { const int row = ai * 128 + wr * 64 + m * 16 + fr;
#pragma unroll
                        for (int bj = 0; bj < 2; ++bj) { const float r = rstd[ai][m][bj];
                            store8bf(Zt + (size_t)row * 8192 + bj * 128 + wc * 32 + 8 * fq, acc[ai][bj][m][0] * r * g0, acc[ai][bj][m][1] * r * g1); } } } };
        fg::gemm_phase<false, fg::DUnit>(lds, DM, S, E);
        skinny_gemm<16>(lds, HN, WSP(bf16, WS_SK) + (size_t)1 * 4 * 256 * 512, WSP(float, WS_PF), G, bx);
    }
}
__device__ __forceinline__ void ph_gemm_qkv(LAS unsigned char* lds) {
    PH_BEGIN;
    bf16* QL = WSP(bf16, WS_QL); bf16* KVL = WSP(bf16, WS_KVL);
    fg::DenseSched S{WSP(bf16, WS_CQN), WSP(bf16, WS_W_UQT), 12, WSP(bf16, WS_CKVN), WSP(bf16, WS_W_UKVT), 16, 512, G, bx};
    const float* gk = INF(8) + 192;
    auto E = [=](const f32x4 (&acc)[2][2][4][2], const fg::DUnit& u, int wr, int wc, int fr, int fq) {
        if (u.p == 0) { bf16* Ct = QL + (size_t)u.pm * 256 * 3072 + u.pn * 256;
            FG_FOREACH(acc, { store8bf(Ct + (size_t)row * 3072 + col, v0, v1); }); }
        else {
            float rstd[2][4][2]; epi_head_rstd<1>(lds, acc, u.par, wr, wc, fr, fq, rstd);
            const f32x4 g0 = *(const f32x4*)(gk + wc * 32 + 8 * fq), g1 = *(const f32x4*)(gk + wc * 32 + 8 * fq + 4);
            bf16* Ct = KVL + (size_t)u.pm * 256 * 4096 + u.pn * 256 + wc * 32 + 8 * fq;
#pragma unroll
            for (int ai = 0; ai < 2; ++ai)
#pragma unroll
                for (int m = 0; m < 4; ++m) { const int row = ai * 128 + wr * 64 + m * 16 + fr; const float r = rstd[ai][m][0];
                    store8bf(Ct + (size_t)row * 4096, acc[ai][0][m][0] * r * g0, acc[ai][0][m][1] * r * g1);
                    store8bf(Ct + (size_t)row * 4096 + 128, acc[ai][1][m][0], acc[ai][1][m][1]); } } };
    fg::gemm_phase<false, fg::DUnit>(lds, 512, S, E);
}
template <int layer>
__device__ __forceinline__ void ph_gemm_wo(LAS unsigned char* lds) {
    PH_BEGIN;
    const float* R = INF(0); bf16* H1b = WSP(bf16, WS_H1);
    const float* gff = INF(layer == 0 ? 10 : 22); bf16* HN = WSP(bf16, WS_HN); float* SSQ = WSP(float, WS_SSQ);
    fg::DenseSched S{WSP(bf16, WS_O), WSP(bf16, layer == 0 ? WS_W_O0T : WS_W_O1T), 8, nullptr, nullptr, 0, DM, G, bx};
    auto E = [=](const f32x4 (&acc)[2][2][4][2], const fg::DUnit& u, int wr, int wc, int fr, int fq) {
        const int colb = u.pn * 256 + wc * 32 + 8 * fq; const size_t o0 = (size_t)u.pm * 256 * DM + colb;
        f32x4 g[2][2];
#pragma unroll
        for (int bj = 0; bj < 2; ++bj) { g[bj][0] = *(const f32x4*)(gff + colb + bj * 128); g[bj][1] = *(const f32x4*)(gff + colb + bj * 128 + 4); }
#pragma unroll
        for (int ai = 0; ai < 2; ++ai) {
            f32x4 rr[4][2][2];
#pragma unroll
            for (int m = 0; m < 4; ++m)
#pragma unroll
                for (int bj = 0; bj < 2; ++bj) { const size_t o = o0 + (size_t)(ai * 128 + wr * 64 + m * 16 + fr) * DM + bj * 128;
                    if (layer == 0) { rr[m][bj][0] = *(const f32x4*)(R + o); rr[m][bj][1] = *(const f32x4*)(R + o + 4); }
                    else { const u32x4 w = *(const u32x4*)(H1b + o); rr[m][bj][0] = bf4((u32x2){w[0], w[1]}); rr[m][bj][1] = bf4((u32x2){w[2], w[3]}); } }
            asm volatile("" ::: "memory");
#pragma unroll
            for (int m = 0; m < 4; ++m) { const int row = ai * 128 + wr * 64 + m * 16 + fr; float ss = 0.f;
#pragma unroll
                for (int bj = 0; bj < 2; ++bj) { const size_t o = o0 + (size_t)row * DM + bj * 128;
                    const f32x4 h0 = rr[m][bj][0] + acc[ai][bj][m][0], h1 = rr[m][bj][1] + acc[ai][bj][m][1];
                    store8bf(H1b + o, h0, h1);
                    ss += (h0[0] * h0[0] + h0[1] * h0[1]) + (h0[2] * h0[2] + h0[3] * h0[3]) + (h1[0] * h1[0] + h1[1] * h1[1]) + (h1[2] * h1[2] + h1[3] * h1[3]);
                    store8bf(HN + o, h0 * g[bj][0], h1 * g[bj][1]); }
                ss += __shfl_xor(ss, 16); ss += __shfl_xor(ss, 32);
                if (fq == 0) SSQ[((size_t)u.pm * 256 + row) * 32 + u.pn * 4 + wc] = ss; } } };
    fg::gemm_phase<false, fg::DUnit>(lds, DM, S, E);
}

__device__ __forceinline__ void ph_mla_prep() {
    PH_BEGIN;
    const bf16* Z = WSP(bf16, WS_Z); bf16* CQN = WSP(bf16, WS_CQN); bf16* CKVN = WSP(bf16, WS_CKVN); bf16* KR = WSP(bf16, WS_KR); const float* PK = WSP(float, WS_PK);
    const float* gq = INF(4); const float* gkv = INF(5); const float* qkg = INF(8); const int* positions = (const int*)arg_ptr(1);
    const f32x4 gq0 = *(const f32x4*)(gq + 8 * lane), gq1 = *(const f32x4*)(gq + 8 * lane + 4), gk0 = *(const f32x4*)(gkv + 8 * lane), gk1 = *(const f32x4*)(gkv + 8 * lane + 4); const float gr = qkg[192 + 128 + lane];
    for (int t0 = gw; t0 < T; t0 += 8 * ngw) {
        u32x4 rq_[8], rk_[8]; float pk_[8][4]; int pos_[8];
#pragma unroll
        for (int i = 0; i < 8; ++i) { const int t = t0 + i * ngw; if (t < T) { const bf16* zr = Z + (size_t)t * 1024;
            rq_[i] = *(const u32x4*)(zr + 8 * lane); rk_[i] = *(const u32x4*)(zr + 512 + 8 * lane);
            const float* pk = PK + (size_t)t * 64 + lane;
            pk_[i][0] = pk[0]; pk_[i][1] = pk[(size_t)T * 64]; pk_[i][2] = pk[(size_t)2 * T * 64]; pk_[i][3] = pk[(size_t)3 * T * 64]; pos_[i] = positions[t]; } }
#pragma unroll
        for (int i = 0; i < 8; ++i) { const int t = t0 + i * ngw; if (t < T) {
            float xq[8], xk[8]; unpack8(rq_[i], xq); unpack8(rk_[i], xk);
            float sq = 0.f, sk = 0.f;
#pragma unroll
            for (int j = 0; j < 8; ++j) { sq += xq[j] * xq[j]; sk += xk[j] * xk[j]; }
            sq = wave_sum(sq); sk = wave_sum(sk);
            const float rq = rsq(sq * (1.0f / 512) + EPS), rk = rsq(sk * (1.0f / 512) + EPS);
            u32x4 oq, ok;
#pragma unroll
            for (int j = 0; j < 4; ++j) { const f32x4 ga = j < 2 ? gq0 : gq1, gb = j < 2 ? gk0 : gk1;
                                          oq[j] = pk2(xq[2 * j] * rq * ga[(2 * j) & 3], xq[2 * j + 1] * rq * ga[(2 * j + 1) & 3]);
                                          ok[j] = pk2(xk[2 * j] * rk * gb[(2 * j) & 3], xk[2 * j + 1] * rk * gb[(2 * j + 1) & 3]); }
            *(u32x4*)(CQN + (size_t)t * 512 + 8 * lane) = oq; *(u32x4*)(CKVN + (size_t)t * 512 + 8 * lane) = ok;
            const float xr = (pk_[i][0] + pk_[i][1]) + (pk_[i][2] + pk_[i][3]);
            const float s2 = wave_sum(xr * xr);
            const float xn = xr * rsq(s2 * (1.0f / 64) + EPS) * gr;
            KR[(size_t)t * 64 + lane] = (bf16)f2bf(rope64(xn, lane, (float)pos_[i])); } }
    }
}
template <int LD, int COL0, int HSTRIDE>
__device__ __forceinline__ void knorm_rows(bf16* Kbase, const float* gain  , int gw, int ngw, int lane) {
    const int h = lane >> 2, part = lane & 3;
    f32x4 g[8];
#pragma unroll
    for (int i = 0; i < 8; ++i) g[i] = *(const f32x4*)(gain + part * 32 + 4 * i);
    for (int t = gw; t < T; t += ngw) {
        bf16* kp = Kbase + (size_t)t * LD + COL0 + h * HSTRIDE + part * 32;
        u32x4 w[4]; float x[32]; float ss = 0.f;
#pragma unroll
        for (int i = 0; i < 4; ++i) w[i] = *(const u32x4*)(kp + 8 * i);
#pragma unroll
        for (int i = 0; i < 4; ++i)
#pragma unroll
            for (int j = 0; j < 4; ++j) { x[8 * i + 2 * j] = bf2f(w[i][j] & 0xffffu); x[8 * i + 2 * j + 1] = bf2f(w[i][j] >> 16); }
#pragma unroll
        for (int i = 0; i < 32; ++i) ss += x[i] * x[i];
        ss += __shfl_xor(ss, 1); ss += __shfl_xor(ss, 2);
        const float r = rsq(ss * (1.0f / 128) + EPS);
#pragma unroll
        for (int i = 0; i < 4; ++i) { u32x4 o;
#pragma unroll
            for (int j = 0; j < 4; ++j) o[j] = pk2(x[8 * i + 2 * j] * r * g[2 * i + (j >> 1)][(2 * j) & 3], x[8 * i + 2 * j + 1] * r * g[2 * i + (j >> 1)][(2 * j + 1) & 3]);
            *(u32x4*)(kp + 8 * i) = o; }
    }
}
__device__ __forceinline__ void ph_mla_knorm() {
    PH_BEGIN;
    knorm_rows<4096, 0, 256>(WSP(bf16, WS_KVL), INF(8) + 192, gw, ngw, lane);
}
__device__ __forceinline__ void ph_fox_prep(LAS unsigned char* lds) {
    PH_BEGIN;
    const float* PF = WSP(float, WS_PF); float* CB = WSP(float, WS_C); const float* fb = INF(19);
    LAS float* wtot = (LAS float*)lds;
    for (int bh = bx; bh < NB * NH; bh += G) {
        const int b = bh >> 4, h = bh & 15; const float bias = fb[h];
        const float* pf = PF + (size_t)h * T + (size_t)b * SEQ + tid * 8;
        f32x4 pq[4][2];
#pragma unroll
        for (int ks = 0; ks < 4; ++ks) { pq[ks][0] = *(const f32x4*)(pf + (size_t)ks * 16 * T); pq[ks][1] = *(const f32x4*)(pf + (size_t)ks * 16 * T + 4); }
        float v[8]; float run = 0.f;
#pragma unroll
        for (int i = 0; i < 8; ++i) {
            const float xx = ((pq[0][i >> 2][i & 3] + pq[1][i >> 2][i & 3]) + (pq[2][i >> 2][i & 3] + pq[3][i >> 2][i & 3])) + bias;
            run += fminf(xx, 0.f) - log1pf(expf(-fabsf(xx))); v[i] = run; }
        float incl = run;
#pragma unroll
        for (int o = 1; o < 64; o <<= 1) { const float up = __shfl_up(incl, o); if (lane >= o) incl += up; }
        if (lane == 63) wtot[wave] = incl;
        __syncthreads();
        float base = incl - run;
        for (int w = 0; w < wave; ++w) base += wtot[w];
        float* cb = CB + (size_t)bh * SEQ + tid * 8;
        *(f32x4*)cb = (f32x4){-(base + v[0]) * 1.4426950408889634f, -(base + v[1]) * 1.4426950408889634f, -(base + v[2]) * 1.4426950408889634f, -(base + v[3]) * 1.4426950408889634f};
        *(f32x4*)(cb + 4) = (f32x4){-(base + v[4]) * 1.4426950408889634f, -(base + v[5]) * 1.4426950408889634f, -(base + v[6]) * 1.4426950408889634f, -(base + v[7]) * 1.4426950408889634f};
        __syncthreads();
    }
}

namespace fa {
typedef short s16x4 __attribute__((ext_vector_type(4)));
typedef float f32x16 __attribute__((ext_vector_type(16)));
constexpr int KVB = 64, SHM_V = KVB * 128 * 2;
__device__ __forceinline__ int v_rd_base(int lane) { return ((lane & 3) << 3) | (((lane >> 2) & 3) << 6) | (((lane >> 4) & 1) << 5) | (((lane >> 5) & 1) << 8); }
constexpr int v_rd_off(int d0, int ks, int half) { return d0 * 512 + ks * 4096 + half * 2048; }
__device__ __forceinline__ int crow(int r, int hi) { return (r & 3) + 8 * (r >> 2) + 4 * hi; }
__device__ __forceinline__ unsigned cvtpk(float lo, float hi) { unsigned r; asm volatile("v_cvt_pk_bf16_f32 %0, %1, %2" : "=v"(r) : "v"(lo), "v"(hi)); return r; }

template <int layer>
__device__ __forceinline__ void attn_phase(LAS unsigned char* lds) {
    PH_BEGIN;
    constexpr int DK = layer == 0 ? 192 : 128, NQ = DK / 16, CPR = DK / 8, NKC = KVB * CPR / NTHREADS;
    constexpr int SHM_K = KVB * DK * 2;
    constexpr int OFF_V = 0, OFF_K = 2 * SHM_V, OFF_WS = OFF_K + 2 * SHM_K, OFF_CB = OFF_WS + NWAVES * 256, OFF_CV = 86016;
    static_assert(OFF_CB + 512 <= OFF_CV && OFF_CV + NWAVES * 8192 <= LDS_BARW, "attention LDS map");
    constexpr float C2 = (layer == 0 ? 0.07216878364870322f : 0.08838834764831845f) * 1.4426950408889634f;
    constexpr int QLD = layer == 0 ? 3072 : 8192, QHS = layer == 0 ? 192 : 128, KLD = layer == 0 ? 4096 : 8192, KC0 = layer == 0 ? 0 : 2048, KHS = layer == 0 ? 256 : 128, VC0 = layer == 0 ? 128 : 4096;
    const bf16* Qs = layer == 0 ? WSP(bf16, WS_QL) : WSP(bf16, WS_Z); const bf16* Ks = layer == 0 ? WSP(bf16, WS_KVL) : WSP(bf16, WS_Z); const bf16* KRs = WSP(bf16, WS_KR); bf16* Ob = WSP(bf16, WS_O);
    const float* qkg = INF(layer == 0 ? 8 : 20); const int* positions = (const int*)arg_ptr(1);
    const float* CBg = WSP(float, WS_C); const bf16* Zg = WSP(bf16, WS_Z);
    const int wid = __builtin_amdgcn_readfirstlane(tid >> 6), r32 = lane & 31, hi = lane >> 5;
    auto koff_n = [](int tk, int j) { const int ci = j * 256 + tk, row = ci >> 4, pc = ci & 15, lc = pc ^ (row & 7); return (unsigned)(row * KLD + lc * 8) * 2u; };
    auto koff_r = [](int tk, int j) { const int ci = j * 256 + tk, row = ci >> 3, pc = ci & 7, lc = pc ^ (row & 7); return (unsigned)(row * 64 + lc * 8) * 2u; };
    auto voff_f = [](int tk, int j) { const int ci = j * 256 + tk, st = ci >> 5, w = ci & 31, kk = (st >> 2) * 8 + (w >> 2), key = (kk & ~0xC) | ((kk & 4) << 1) | ((kk & 8) >> 1), c = (st & 3) * 32 + (w & 3) * 8;
        return (unsigned)(key * KLD + c) * 2u; };
    const int tkp = (tid - 256) & 255; const unsigned kof0 = koff_n(tkp, 0), vof0 = voff_f(tkp, 0), rof0 = koff_r(tkp, 0);
    const int kbn = r32 * 256 + ((hi * 16) ^ ((r32 & 7) << 4)), kbr0 = 16384 + r32 * 128 + ((hi * 16) ^ ((r32 & 7) << 4));
    const unsigned ldsb = (unsigned)(uintptr_t)lds;
    const int vb0 = (int)(unsigned)(uintptr_t)(lds + OFF_V) + v_rd_base(lane);
    LAS float* wsl = (LAS float*)(lds + OFF_WS) + wid * 64; LAS float* li_l = wsl; LAS float* al_l = wsl + 32;

    const float* cv_wgu = INF(layer == 0 ? 15 : 27); const float* cv_wdn = INF(layer == 0 ? 16 : 28); bf16* cv_gut = WSP(bf16, CV_MODE >= 2 ? WS_Q : WS_W_GUT); bf16* cv_dt = WSP(bf16, CV_MODE >= 2 ? WS_Q : WS_W_DT);
    constexpr int CV_IG = 32 * 32, CV_ID = 8 * 64, CV_NIT = NEXP * (CV_IG + CV_ID);
    int cv_it = (CV_MODE == 1) ? CV_NIT : bx * 4 + wid, cv_pend = -1; const int cv_stride = G * 4;
    const unsigned cv_lds = (unsigned)(uintptr_t)(lds + OFF_CV) + (unsigned)(wid & 3) * 16384u;
#define CV_DECODE(it_) const bool gu_ = (it_) < NEXP * CV_IG; const int v_ = gu_ ? (it_) : (it_) - NEXP * CV_IG, e_ = gu_ ? v_ >> 10 : v_ >> 9, r_ = gu_ ? v_ & 1023 : v_ & 511;     \
        const int lgN_ = gu_ ? 10 : 11, lgK_ = gu_ ? 11 : 9, N_ = 1 << lgN_, k0_ = (r_ >> (lgN_ - 5)) << 6, n0_ = (r_ & ((1 << (lgN_ - 5)) - 1)) << 5; \
        const float* W_ = (gu_ ? cv_wgu : cv_wdn) + ((size_t)e_ << (gu_ ? 21 : 20)); bf16* WT_ = (gu_ ? cv_gut : cv_dt) + (((size_t)e_ << (gu_ ? 21 : 20)) & (CV_MODE >= 2 ? (size_t)0x1ffffff : ~(size_t)0))
#define CV_ISSUE(it_, SLOT) do { { CV_DECODE(it_); const int lz_ = otid() & 63; \
        const unsigned vb_ = (unsigned)((lz_ >> 3) * N_) * 4u; const char* sb_ = (const char*)(W_ + (size_t)k0_ * N_ + n0_); \
        _Pragma("unroll") for (int i = 0; i < 8; ++i) { const char* si_ = sb_ + (size_t)i * 8 * N_ * 4; const unsigned vo_ = vb_ + ((unsigned)((lz_ & 7) ^ i) << 4); unsigned keep_; \
            asm volatile("s_mov_b32 %0, m0\n\ts_mov_b32 m0, %3\n\ts_nop 0\n\tglobal_load_lds_dwordx4 %1, %2 nt\n\ts_mov_b32 m0, %0" : "=&s"(keep_) : "v"(vo_), "s"(si_), "s"(cv_lds + (unsigned)(SLOT) * 8192u + (unsigned)i * 1024u) : "memory"); } } } while (0)
#define CV_FINISH(it_, SLOT) do { { CV_DECODE(it_); const int lz_ = otid() & 63, c_ = lz_ & 7; const LAS float* scr_ = (const LAS float*)(lds + OFF_CV) + (wid & 3) * 4096 + (SLOT) * 2048; \
        float cvr_[4][8];                                                                           \
        _Pragma("unroll") for (int j = 0; j < 4; ++j) { const int n_ = (lz_ >> 3) + 8 * j; const LAS float* sp_ = scr_ + (8 * c_) * 32 + (((n_ >> 2) ^ c_) << 2) + (n_ & 3); \
            _Pragma("unroll") for (int q = 0; q < 8; ++q) cvr_[j][q] = sp_[32 * q]; } \
        asm volatile("s_waitcnt lgkmcnt(0)" ::: "memory"); __builtin_amdgcn_sched_barrier(0); \
        _Pragma("unroll") for (int j = 0; j < 4; ++j) { const int n_ = (lz_ >> 3) + 8 * j; \
            u32x4 o_; o_.x = pk2(cvr_[j][0], cvr_[j][1]); o_.y = pk2(cvr_[j][2], cvr_[j][3]); o_.z = pk2(cvr_[j][4], cvr_[j][5]); o_.w = pk2(cvr_[j][6], cvr_[j][7]); \
            const int nn_ = n0_ + n_; const int f_ = nn_ & 511; \
            const int dr_ = gu_ ? ((f_ >> 7) * 256 + ((f_ >> 6) & 1) * 128 + ((f_ >> 4) & 3) * 32 + ((f_ >> 2) & 3) * 8 + (nn_ >> 9) * 4 + (f_ & 3)) : nn_;     \
            __builtin_nontemporal_store(o_, (u32x4*)(WT_ + ((size_t)dr_ << lgK_) + k0_ + 8 * c_)); } \
        } } while (0)
    for (int L = bx; L < NB * NH * 8; L += G) {
        const int bh = (L & 7) * 8 + (L >> 6), pair = (L >> 3) & 7, b = bh >> 4, h = bh & 15;
        const char* Kg = (const char*)(Ks + (size_t)b * SEQ * KLD + KC0 + h * KHS); const char* Vg = (const char*)(Ks + (size_t)b * SEQ * KLD + VC0 + h * KHS);
        const char* KRg = (const char*)(KRs + (size_t)b * SEQ * 64); const float* cbg = CBg + (size_t)bh * SEQ;
        for (int pass = 0; pass < 2; ++pass) {
            const int qb = pass ? pair : 15 - pair, P0 = qb * 256, NT = P0 / KVB + 4, qlo = P0 + wid * 32;
            bf16x8 qr[NQ];
            {
                const size_t tq = (size_t)b * SEQ + qlo + r32;
                const bf16* qp = Qs + tq * QLD + h * QHS + hi * 8;
                u32x4 raw[NQ];
#pragma unroll
                for (int d0 = 0; d0 < NQ; ++d0) raw[d0] = *(const u32x4*)(qp + d0 * 16);
                float ss = 0.f;
#pragma unroll
                for (int d0 = 0; d0 < 8; ++d0)
#pragma unroll
                    for (int j = 0; j < 4; ++j) { const float x0 = bf2f(raw[d0][j] & 0xffffu), x1 = bf2f(raw[d0][j] >> 16); ss += x0 * x0 + x1 * x1; }
                { auto rr = __builtin_amdgcn_permlane32_swap(__float_as_uint(ss), __float_as_uint(ss), false, false); ss = __uint_as_float(rr[0]) + __uint_as_float(rr[1]); }
                const float rn = rsq(ss * (1.0f / 128) + EPS) * C2;
#pragma unroll
                for (int d0 = 0; d0 < 8; ++d0) { const f32x4 g0 = *(const f32x4*)(qkg + d0 * 16 + hi * 8), g1 = *(const f32x4*)(qkg + d0 * 16 + hi * 8 + 4); u32x4 o;
#pragma unroll
                    for (int j = 0; j < 4; ++j) { const float x0 = bf2f(raw[d0][j] & 0xffffu), x1 = bf2f(raw[d0][j] >> 16); const f32x4 gg = j < 2 ? g0 : g1;
                        o[j] = cvtpk(x0 * rn * gg[(2 * j) & 3], x1 * rn * gg[(2 * j + 1) & 3]); }
                    qr[d0] = *reinterpret_cast<bf16x8*>(&o); }
                if constexpr (layer == 0) {
                    float xr[4][8]; float s2 = 0.f;
#pragma unroll
                    for (int c = 0; c < 4; ++c)
#pragma unroll
                        for (int j = 0; j < 4; ++j) { xr[c][2 * j] = bf2f(raw[8 + c][j] & 0xffffu); xr[c][2 * j + 1] = bf2f(raw[8 + c][j] >> 16); s2 += xr[c][2 * j] * xr[c][2 * j] + xr[c][2 * j + 1] * xr[c][2 * j + 1]; }
                    { auto rr = __builtin_amdgcn_permlane32_swap(__float_as_uint(s2), __float_as_uint(s2), false, false); s2 = __uint_as_float(rr[0]) + __uint_as_float(rr[1]); }
                    const float r2 = rsq(s2 * (1.0f / 64) + EPS); const float pos = (float)positions[tq];
#pragma unroll
                    for (int c = 0; c < 4; ++c) { const f32x4 g0 = *(const f32x4*)(qkg + 128 + c * 16 + hi * 8), g1 = *(const f32x4*)(qkg + 128 + c * 16 + hi * 8 + 4);
#pragma unroll
                        for (int j = 0; j < 8; ++j) xr[c][j] *= r2 * (j < 4 ? g0[j & 3] : g1[j & 3]); }
#pragma unroll
                    for (int c = 0; c < 2; ++c) { u32x4 o1, o2;
#pragma unroll
                        for (int jj = 0; jj < 4; ++jj) { float y1[2], y2[2];
#pragma unroll
                            for (int e = 0; e < 2; ++e) { const int j = 2 * jj + e; const int i = c * 16 + hi * 8 + j;
                                const float freq = exp2f(-(float)i * (13.287712379549449f / 32.0f)); float rev = pos * freq * 0.15915494309189535f; rev -= floorf(rev);
                                const float sn = __builtin_amdgcn_sinf(rev), cs = __builtin_amdgcn_cosf(rev);
                                y1[e] = (xr[c][j] * cs - xr[c + 2][j] * sn) * C2; y2[e] = (xr[c + 2][j] * cs + xr[c][j] * sn) * C2; }
                            o1[jj] = cvtpk(y1[0], y1[1]); o2[jj] = cvtpk(y2[0], y2[1]); }
                        qr[8 + c] = *reinterpret_cast<bf16x8*>(&o1); qr[10 + c] = *reinterpret_cast<bf16x8*>(&o2); }
                }
            }
            float m_reg = 0.f, l_reg = 0.f; f32x16 o[4];
#pragma unroll
            for (int d0 = 0; d0 < 4; ++d0)
#pragma unroll
                for (int r = 0; r < 16; ++r) o[d0][r] = 0.f;
#define FA_DMA16(sbase_, voff_, ldsaddr_) do { unsigned keep_; asm volatile("s_mov_b32 %0, m0\n\ts_mov_b32 m0, %3\n\ts_nop 0\n\tglobal_load_lds_dwordx4 %1, %2\n\ts_mov_b32 m0, %0" \
        : "=&s"(keep_) : "v"(voff_), "s"(sbase_), "s"(ldsaddr_) : "memory"); } while (0)
#define FA_DMA4(sbase_, voff_, ldsaddr_) do { unsigned keep_; asm volatile("s_mov_b32 %0, m0\n\ts_mov_b32 m0, %3\n\ts_nop 0\n\tglobal_load_lds_dword %1, %2\n\ts_mov_b32 m0, %0" \
        : "=&s"(keep_) : "v"(voff_), "s"(sbase_), "s"(ldsaddr_) : "memory"); } while (0)
#define FA_ISSUE(t_, BUF) do { if (wid >= 4) { const char* ks_ = Kg + (size_t)(t_) * (KVB * KLD * 2); const char* vs_ = Vg + (size_t)(t_) * (KVB * KLD * 2); const unsigned wl_ = (unsigned)(wid - 4) * 1024u; \
        _Pragma("unroll") for (int j = 0; j < 4; ++j) FA_DMA16(ks_, kof0 + (unsigned)(j * 16 * KLD * 2), ldsb + (unsigned)(OFF_K + (BUF) * SHM_K + j * 4096) + wl_); \
        if constexpr (layer == 0) { const char* kr_ = KRg + (size_t)(t_) * (KVB * 64 * 2); \
            _Pragma("unroll") for (int j = 0; j < 2; ++j) FA_DMA16(kr_, rof0 + (unsigned)(j * 32 * 64 * 2), ldsb + (unsigned)(OFF_K + (BUF) * SHM_K + 16384 + j * 4096) + wl_); } \
        _Pragma("unroll") for (int j = 0; j < 4; ++j) FA_DMA16(vs_, vof0 + (unsigned)(j * 16 * KLD * 2), ldsb + (unsigned)(OFF_V + (BUF) * SHM_V + j * 4096) + wl_); \
        if (layer == 1 && wid == 4) { const float* cs_ = cbg + (t_) * KVB; FA_DMA4(cs_, (unsigned)lane * 4u, ldsb + (unsigned)(OFF_CB + (BUF) * 256)); } } } while (0)
#define FA_TRRD(dst, off) asm volatile("ds_read_b64_tr_b16 %0, %1 offset:%2" : "=&v"(dst) : "v"(vb0), "i"(off) : "memory")
#define FA_PV_D0(BUF, d0) do { s16x4 l0, l1, l2, l3, h0, h1, h2, h3; constexpr int b_ = (BUF) * SHM_V + v_rd_off(d0, 0, 0); \
        FA_TRRD(l0, b_); FA_TRRD(h0, b_ + 2048); FA_TRRD(l1, b_ + 4096); FA_TRRD(h1, b_ + 6144); FA_TRRD(l2, b_ + 8192); FA_TRRD(h2, b_ + 10240); FA_TRRD(l3, b_ + 12288); FA_TRRD(h3, b_ + 14336); \
        asm volatile("s_waitcnt lgkmcnt(0)" ::: "memory"); __builtin_amdgcn_sched_barrier(0); \
        o[d0] = __builtin_amdgcn_mfma_f32_32x32x16_bf16((bf16x8){l0[0], l0[1], l0[2], l0[3], h0[0], h0[1], h0[2], h0[3]}, pa0, o[d0], 0, 0, 0); \
        o[d0] = __builtin_amdgcn_mfma_f32_32x32x16_bf16((bf16x8){l1[0], l1[1], l1[2], l1[3], h1[0], h1[1], h1[2], h1[3]}, pa1, o[d0], 0, 0, 0); \
        o[d0] = __builtin_amdgcn_mfma_f32_32x32x16_bf16((bf16x8){l2[0], l2[1], l2[2], l2[3], h2[0], h2[1], h2[2], h2[3]}, pa2, o[d0], 0, 0, 0); \
        o[d0] = __builtin_amdgcn_mfma_f32_32x32x16_bf16((bf16x8){l3[0], l3[1], l3[2], l3[3], h3[0], h3[1], h3[2], h3[3]}, pa3, o[d0], 0, 0, 0); } while (0)
#define FA_PK4(P, B_, OUT) do { const unsigned a0 = cvtpk(P[B_ + 0], P[B_ + 1]), a1 = cvtpk(P[B_ + 2], P[B_ + 3]), b0_ = cvtpk(P[B_ + 4], P[B_ + 5]), b1_ = cvtpk(P[B_ + 6], P[B_ + 7]); \
        auto r0 = __builtin_amdgcn_permlane32_swap(a0, b0_, false, false); auto r1 = __builtin_amdgcn_permlane32_swap(a1, b1_, false, false); \
        u32x4 w_ = {r0[0], r1[0], r0[1], r1[1]}; OUT = *reinterpret_cast<bf16x8*>(&w_); } while (0)
#define FA_STEP(t_, BUF) do { \
          \
        if (wid >= 4 || (t_) == 0) asm volatile("s_waitcnt vmcnt(0)" ::: "memory");                 \
        asm volatile("s_waitcnt lgkmcnt(0)" ::: "memory"); __builtin_amdgcn_s_barrier(); asm volatile("" ::: "memory");     \
        if ((t_) + 1 < NT) FA_ISSUE((t_) + 1, (BUF) ^ 1); \
        if (wid < 4) {                                                                             \
            if (cv_pend >= 0) { asm volatile("s_waitcnt vmcnt(0)" ::: "memory"); CV_FINISH(cv_pend, (BUF) ^ 1); cv_pend = -1; }     \
            if (cv_it < CV_NIT) { CV_ISSUE(cv_it, BUF); cv_pend = cv_it; cv_it += cv_stride; } }         \
        const int kbase = (t_) * KVB; \
        if (kbase <= qlo + 31) {                                                                   \
            f32x16 p0, p1; \
            _Pragma("unroll") for (int r = 0; r < 16; ++r) { p0[r] = 0.f; p1[r] = 0.f; } \
            const LAS unsigned char* kt = lds + OFF_K + (BUF) * SHM_K; \
            int kbn_ = kbn, kbr_ = kbr0; asm volatile("" : "+v"(kbn_), "+v"(kbr_));                 \
            if (wid < 4) __builtin_amdgcn_s_setprio(2); else __builtin_amdgcn_s_setprio(1);          \
            _Pragma("unroll") for (int d0 = 0; d0 < NQ; ++d0) { const LAS unsigned char* a_ = d0 < 8 ? kt + (kbn_ ^ ((d0 & 3) << 5)) + (d0 >> 2) * 128 : kt + (kbr_ ^ ((d0 & 3) << 5)); \
                const bf16x8 k0 = *(const LAS bf16x8*)a_, k1 = *(const LAS bf16x8*)(a_ + (d0 < 8 ? 32 * 256 : 32 * 128)); \
                p0 = __builtin_amdgcn_mfma_f32_32x32x16_bf16(k0, qr[d0], p0, 0, 0, 0); p1 = __builtin_amdgcn_mfma_f32_32x32x16_bf16(k1, qr[d0], p1, 0, 0, 0); \
                if ((d0 & 3) == 3) __builtin_amdgcn_sched_barrier(0); } \
            if (layer == 1) { const LAS f32x4* cb = (const LAS f32x4*)(lds + OFF_CB + (BUF) * 256); \
                _Pragma("unroll") for (int g = 0; g < 4; ++g) { const f32x4 c0 = cb[2 * g + hi], c1 = cb[8 + 2 * g + hi]; \
                    _Pragma("unroll") for (int j = 0; j < 4; ++j) { p0[4 * g + j] += c0[j]; p1[4 * g + j] += c1[j]; } \
                    __builtin_amdgcn_sched_barrier(0); } } \
            if (kbase + KVB - 1 > qlo) { const int dq = qlo + r32 - 4 * hi - kbase; const float NEG = -__builtin_inff();     \
                _Pragma("unroll") for (int r = 0; r < 16; ++r) { const int c = (r & 3) + 8 * (r >> 2); if (dq - c < 0) p0[r] = NEG; if (dq - c - 32 < 0) p1[r] = NEG; } } \
            float pmax = p0[0]; \
            _Pragma("unroll") for (int r = 1; r < 16; ++r) pmax = fmaxf(pmax, p0[r]); \
            _Pragma("unroll") for (int r = 0; r < 16; ++r) pmax = fmaxf(pmax, p1[r]); \
            { auto rr = __builtin_amdgcn_permlane32_swap(__float_as_uint(pmax), __float_as_uint(pmax), false, false); pmax = fmaxf(__uint_as_float(rr[0]), __uint_as_float(rr[1])); } \
              \
            if ((t_) == 0) m_reg = pmax < -64.0f ? pmax : 0.f; \
            float mn, alpha; \
            if (__all(pmax - m_reg <= 64.0f)) { mn = m_reg; alpha = 1.f; } else { mn = fmaxf(m_reg, pmax); alpha = __builtin_amdgcn_exp2f(m_reg - mn); m_reg = mn; } \
            float ps = 0.f; \
            if (__all(mn == 0.f)) { _Pragma("unroll") for (int r = 0; r < 16; ++r) { p0[r] = __builtin_amdgcn_exp2f(p0[r]); p1[r] = __builtin_amdgcn_exp2f(p1[r]); ps += p0[r] + p1[r]; } } \
            else { _Pragma("unroll") for (int r = 0; r < 16; ++r) { p0[r] = __builtin_amdgcn_exp2f(p0[r] - mn); p1[r] = __builtin_amdgcn_exp2f(p1[r] - mn); ps += p0[r] + p1[r]; } } \
            { auto rr = __builtin_amdgcn_permlane32_swap(__float_as_uint(ps), __float_as_uint(ps), false, false); ps = __uint_as_float(rr[0]) + __uint_as_float(rr[1]); } \
            l_reg = l_reg * alpha + ps; \
            bf16x8 pa0, pa1, pa2, pa3; FA_PK4(p0, 0, pa0); FA_PK4(p0, 8, pa1); FA_PK4(p1, 0, pa2); FA_PK4(p1, 8, pa3); \
            if (__any(alpha < 1.f)) {                                                              \
                _Pragma("unroll") for (int d_ = 0; d_ < 4; ++d_) _Pragma("unroll") for (int r = 0; r < 16; ++r) o[d_][r] *= alpha; } \
            FA_PV_D0(BUF, 0); FA_PV_D0(BUF, 1); FA_PV_D0(BUF, 2); FA_PV_D0(BUF, 3); __builtin_amdgcn_s_setprio(0); \
        } \
        } while (0)
            FA_ISSUE(0, 0);
            for (int t = 0; t < NT; t += 2) { FA_STEP(t, 0); FA_STEP(t + 1, 1); }
            { const int tz = otid(), hz = (tz >> 5) & 1, rz = tz & 31;
              const size_t trow = (size_t)b * SEQ + qlo + rz; const float rl = __builtin_amdgcn_rcpf(l_reg);
              u32x2 gts[4][4];
              if (layer == 1) { const bf16* gp = Zg + trow * 8192 + 6144 + h * 128 + 4 * hz;
#pragma unroll
                  for (int d0 = 0; d0 < 4; ++d0)
#pragma unroll
                      for (int g = 0; g < 4; ++g) gts[d0][g] = *(const u32x2*)(gp + d0 * 32 + 8 * g); }
              bf16* op = Ob + trow * DM + h * 128 + 8 * hz;
#pragma unroll
              for (int d0 = 0; d0 < 4; ++d0)
#pragma unroll
                  for (int gp2 = 0; gp2 < 2; ++gp2) { unsigned pk[2][2];
#pragma unroll
                      for (int e = 0; e < 2; ++e) { const int g = 2 * gp2 + e; float v[4];
#pragma unroll
                          for (int j = 0; j < 4; ++j) v[j] = o[d0][4 * g + j] * rl;
                          if (layer == 1) { const u32x2 gw = gts[d0][g]; const float g4[4] = {bf2f(gw[0] & 0xffffu), bf2f(gw[0] >> 16), bf2f(gw[1] & 0xffffu), bf2f(gw[1] >> 16)};
#pragma unroll
                              for (int j = 0; j < 4; ++j) v[j] *= __builtin_amdgcn_rcpf(1.0f + __expf(-g4[j])); }
                          pk[e][0] = cvtpk(v[0], v[1]); pk[e][1] = cvtpk(v[2], v[3]); }
                      auto s0 = __builtin_amdgcn_permlane32_swap(pk[0][0], pk[1][0], false, false); auto s1 = __builtin_amdgcn_permlane32_swap(pk[0][1], pk[1][1], false, false);
                      *(u32x4*)(op + d0 * 32 + 16 * gp2) = (u32x4){s0[0], s1[0], s0[1], s1[1]}; } }
        }
    }
    asm volatile("s_waitcnt vmcnt(0)" ::: "memory");
    if (wid < 4) { if (cv_pend >= 0) CV_FINISH(cv_pend, 1);
        while (cv_it < CV_NIT) { CV_ISSUE(cv_it, 0); asm volatile("s_waitcnt vmcnt(0)" ::: "memory"); CV_FINISH(cv_it, 0); cv_it += cv_stride; } }
    __syncthreads();
#undef CV_DECODE
#undef CV_ISSUE
#undef CV_FINISH
#undef FA_ISSUE
#undef FA_DMA16
#undef FA_DMA4
#undef FA_TRRD
#undef FA_PV_D0
#undef FA_PK4
#undef FA_STEP
}
}

template <int layer>
__device__ __forceinline__ void ph_router(LAS unsigned char* lds) {
    PH_BEGIN;
    skinny_gemm<80>(lds, WSP(bf16, WS_HN), WSP(bf16, WS_SK) + (size_t)(2 + layer) * 4 * 256 * 512, WSP(float, WS_PR), G, bx);
}
template <int layer>
__device__ __forceinline__ void ph_route(LAS unsigned char* lds) {
    PH_BEGIN;
    LAS unsigned* lcnt = (LAS unsigned*)lds; LAS unsigned* lbase = lcnt + 64;
    const float* PR = WSP(float, WS_PR); int* TOK = WSP(int, WS_TOK); float* GATE = WSP(float, WS_GATE); int* TSLOT = WSP(int, WS_TSLOT); const float* SSQ = WSP(float, WS_SSQ); float* RSL = WSP(float, WS_RSL);
    unsigned* cnt = WSP(unsigned, WS_CTL) + (layer == 0 ? CW_CNT0 : CW_CNT1);
    const float* b_rg = INF(layer == 0 ? 12 : 24); const float* b_re = INF(layer == 0 ? 14 : 26);
    constexpr int TPW = 128;
    static_assert(T % TPW == 0 && T / TPW <= 248, "whole workgroups of tokens, one trip");
    if (bx * TPW < T) {
        if (tid < 64) lcnt[tid] = 0u;
        __syncthreads();
        const int t = bx * TPW + tid; int e1o = 0, e2o = 0; float g1o = 0.f, g2o = 0.f, rso = 0.f; unsigned r1 = 0u, r2 = 0u;
        if (tid < TPW) {
        const float* pr = PR + (size_t)t * 80;
        float rstd; { f32x4 q = *(const f32x4*)(SSQ + (size_t)t * 32);
#pragma unroll
            for (int i = 1; i < 8; ++i) q += *(const f32x4*)(SSQ + (size_t)t * 32 + 4 * i);
            rstd = rsq(((q[0] + q[1]) + (q[2] + q[3])) * (1.0f / DM) + EPS); }
        auto sum4 = [=](int j) { const f32x4 a0 = *(const f32x4*)(pr + j), a1 = *(const f32x4*)(pr + (size_t)T * 80 + j), a2 = *(const f32x4*)(pr + (size_t)2 * T * 80 + j), a3 = *(const f32x4*)(pr + (size_t)3 * T * 80 + j);
            return (a0 + a1) + (a2 + a3); };
        float gl[8]; int g = 0; float gm = -3.0e38f;
        { const f32x4 x0 = sum4(0), x1 = sum4(4);
#pragma unroll
          for (int j = 0; j < 8; ++j) { gl[j] = (j < 4 ? x0[j & 3] : x1[j & 3]) * rstd + b_rg[j]; if (gl[j] > gm) { gm = gl[j]; g = j; } } }
        float se = 0.f;
#pragma unroll
        for (int j = 0; j < 8; ++j) se += expf(gl[j] - gm);
        const float pg = 1.0f / se;
        float el[8]; int i1 = 0; float m1 = -3.0e38f;
        { const f32x4 x0 = sum4(8 + g * 8), x1 = sum4(12 + g * 8);
#pragma unroll
          for (int j = 0; j < 8; ++j) { el[j] = (j < 4 ? x0[j & 3] : x1[j & 3]) * rstd + b_re[g * 8 + j]; if (el[j] > m1) { m1 = el[j]; i1 = j; } } }
        int i2 = 0; float m2 = -3.0e38f;
#pragma unroll
        for (int j = 0; j < 8; ++j) { if (j != i1 && el[j] > m2) { m2 = el[j]; i2 = j; } }
        const float w2 = expf(m2 - m1), g1 = pg / (1.0f + w2), g2 = pg * w2 / (1.0f + w2);
        const int e1 = g * 8 + i1, e2 = g * 8 + i2;
        r1 = __hip_atomic_fetch_add(&lcnt[e1], 1u, __ATOMIC_RELAXED, __HIP_MEMORY_SCOPE_WORKGROUP); r2 = __hip_atomic_fetch_add(&lcnt[e2], 1u, __ATOMIC_RELAXED, __HIP_MEMORY_SCOPE_WORKGROUP);
        e1o = e1; e2o = e2; g1o = g1; g2o = g2; rso = rstd; }
        __syncthreads();
        if (tid < 64) { const unsigned c = lcnt[tid]; lbase[tid] = c ? atomicAdd(&cnt[tid], c) : 0u; }
        __syncthreads();
        if (tid < TPW) { const int e1 = e1o, e2 = e2o; const unsigned s1 = lbase[e1] + r1, s2 = lbase[e2] + r2;
            TOK[(size_t)e1 * T + s1] = t; GATE[(size_t)e1 * T + s1] = g1o; RSL[(size_t)e1 * T + s1] = rso;
            TOK[(size_t)e2 * T + s2] = t; GATE[(size_t)e2 * T + s2] = g2o; RSL[(size_t)e2 * T + s2] = rso;
            TSLOT[2 * t] = (e1 << 16) | (int)s1; TSLOT[2 * t + 1] = (e2 << 16) | (int)s2; }
    }
}
struct MUnit { int e, mt, mtg, pn, ce; };
template <bool GU>
struct MoeSched {
    const LAS int* ts; const LAS int* cn; const char* A; const char* B; const int* tok; int G, c;
    static constexpr int NPN = GU ? 4 : 8, K = GU ? DM : DEXP;
    __device__ __forceinline__ bool next(int i, MUnit& u) const {
        const LAS int* xs = (const LAS int*)((const LAS unsigned char*)ts + (LDS_XS - LDS_TS));
        const int x = c & 7, W = G >> 3, q = i * W + (c >> 3); if ((G & 7) != 0 || q >= xs[8] * NPN) return false;
        int k = 0; while (xs[k + 1] * NPN <= q) ++k;
        const int e = x + 8 * k, rq = q - xs[k] * NPN, nte = xs[k + 1] - xs[k]; u.pn = rq / nte; u.mt = rq - u.pn * nte;
        u.e = e; u.mtg = ts[e] + u.mt; u.ce = cn[e]; return true; }
    __device__ __forceinline__ const char* a_base(const MUnit& u) const { return GU ? A : A + (size_t)u.mtg * 256 * DEXP * 2; }
    __device__ __forceinline__ const char* b_base(const MUnit& u) const { return B + ((size_t)u.e * (GU ? 1024 : DM) + u.pn * 256) * K * 2; }
    __device__ __forceinline__ unsigned a_voff(const MUnit& u, int row, int col) const {
        if (GU) { const int s = u.mt * 256 + row; return (unsigned)tok[(size_t)u.e * T + (s < u.ce ? s : 0)] * (unsigned)(DM * 2) + (unsigned)col * 2u; }
        return (unsigned)(row * DEXP + col) * 2u; }
    __device__ __forceinline__ bool lo_only(const MUnit& u) const { return u.ce - u.mt * 256 <= 128; }
};
template <int layer>
__device__ __forceinline__ void ph_gateup(LAS unsigned char* lds) {
    PH_BEGIN;
    moe_prefix(lds, WSP(unsigned, WS_CTL) + (layer == 0 ? CW_CNT0 : CW_CNT1));
    bf16* ACT = WSP(bf16, WS_ACT); const float* RSL = WSP(float, WS_RSL);
    MoeSched<true> S{(const LAS int*)(lds + LDS_TS), (const LAS int*)(lds + LDS_CN), (const char*)WSP(bf16, WS_HN), (const char*)WSP(bf16, WS_W_GUT), WSP(int, WS_TOK), G, bx};
    auto E = [=](const f32x4 (&acc)[2][2][4][2], const MUnit& u, int wr, int wc, int fr, int fq) {
        bf16* At = ACT + (size_t)u.mtg * 256 * DEXP + u.pn * 128 + wc * 16 + 4 * fq;
        float rsv[2][4];
#pragma unroll
        for (int ai = 0; ai < 2; ++ai)
#pragma unroll
            for (int m = 0; m < 4; ++m) { const int row = ai * 128 + wr * 64 + m * 16 + fr; rsv[ai][m] = u.mt * 256 + row < u.ce ? RSL[(size_t)u.e * T + u.mt * 256 + row] : 0.f; }
        asm volatile("" ::: "memory");
#pragma unroll
        for (int ai = 0; ai < 2; ++ai)
#pragma unroll
            for (int m = 0; m < 4; ++m) { const int row = ai * 128 + wr * 64 + m * 16 + fr; if (ai == 1 && u.ce - u.mt * 256 <= 128) continue;
                const float rs = rsv[ai][m];
#pragma unroll
                for (int bj = 0; bj < 2; ++bj) { const f32x4 g = acc[ai][bj][m][0] * rs, up = acc[ai][bj][m][1] * rs; f32x4 o;
#pragma unroll
                    for (int j = 0; j < 4; ++j) o[j] = g[j] * __builtin_amdgcn_rcpf(1.0f + __expf(-g[j])) * up[j];
                    store4bf(At + (size_t)row * DEXP + bj * 64, o); } } };
    fg::gemm_phase<true, MUnit>(lds, DM, S, E);
}
template <int layer>
__device__ __forceinline__ void ph_down(LAS unsigned char* lds) {
    PH_BEGIN;
    moe_prefix(lds, WSP(unsigned, WS_CTL) + (layer == 0 ? CW_CNT0 : CW_CNT1));
    bf16* YS = WSP(bf16, WS_YS); const float* GATE = WSP(float, WS_GATE);
    MoeSched<false> S{(const LAS int*)(lds + LDS_TS), (const LAS int*)(lds + LDS_CN), (const char*)WSP(bf16, WS_ACT), (const char*)WSP(bf16, WS_W_DT), nullptr, G, bx};
    auto E = [=](const f32x4 (&acc)[2][2][4][2], const MUnit& u, int wr, int wc, int fr, int fq) {
        const int rem = u.ce - u.mt * 256; const float* gt = GATE + (size_t)u.e * T + u.mt * 256;
        bf16* Yt = YS + (size_t)u.mtg * 256 * DM + u.pn * 256 + wc * 32 + 8 * fq;
        float gv[2][4];
#pragma unroll
        for (int ai = 0; ai < 2; ++ai)
#pragma unroll
            for (int m = 0; m < 4; ++m) { const int row = ai * 128 + wr * 64 + m * 16 + fr; gv[ai][m] = row < rem ? gt[row] : 0.f; }
        asm volatile("" ::: "memory");
#pragma unroll
        for (int ai = 0; ai < 2; ++ai)
#pragma unroll
            for (int m = 0; m < 4; ++m) { const int row = ai * 128 + wr * 64 + m * 16 + fr;
                if (row < rem) { const float g = gv[ai][m];
#pragma unroll
                    for (int bj = 0; bj < 2; ++bj) store8bf(Yt + (size_t)row * DM + bj * 128, acc[ai][bj][m][0] * g, acc[ai][bj][m][1] * g); } } };
    fg::gemm_phase<false, MUnit>(lds, DEXP, S, E);
}

#define GRID_BAR() xcd_barrier(bar)
__global__ void __launch_bounds__(NTHREADS, 2) fwd(Args a) {
    extern __shared__ __attribute__((aligned(16))) unsigned char lds_raw[];
    LAS unsigned char* lds = (LAS unsigned char*)lds_raw;
    (void)a;
    if (threadIdx.x < 4) ((LAS unsigned*)(lds + LDS_BARW))[threadIdx.x] = 0u;
    __syncthreads();
    unsigned* ctl0 = (unsigned*)arg_ptr(30);
    const XcdBarrier bar = xcd_barrier_post(ctl0 + CW_BAR, (volatile LAS unsigned*)(lds + LDS_BARW));
    ph_convert_dense(lds);
    if (CV_MODE >= 1) ph_convert_moe<0>(lds);
    norm_rows<0>(lds, const_cast<float*>(INF(0)), INF(2), nullptr); GRID_BAR();
    ph_gemm_z<0>(lds); GRID_BAR();
    ph_mla_prep(); GRID_BAR();
    ph_gemm_qkv(lds); GRID_BAR();
    fa::attn_phase<0>(lds); GRID_BAR();
    ph_gemm_wo<0>(lds); GRID_BAR();
    ph_router<0>(lds); GRID_BAR();
    ph_route<0>(lds); GRID_BAR();
    ph_gateup<0>(lds); GRID_BAR();
    ph_down<0>(lds); GRID_BAR();
    norm_rows<1>(lds, (float*)arg_ptr(29), INF(17), (const unsigned*)arg_ptr(30) + CW_CNT0); if (CV_MODE >= 1) ph_convert_moe<1>(lds); GRID_BAR();
    ph_gemm_z<1>(lds); GRID_BAR();
    ph_fox_prep(lds); GRID_BAR();
    fa::attn_phase<1>(lds); GRID_BAR();
    ph_gemm_wo<1>(lds); GRID_BAR();
    ph_router<1>(lds); GRID_BAR();
    ph_route<1>(lds); GRID_BAR();
    ph_gateup<1>(lds); GRID_BAR();
    ph_down<1>(lds); GRID_BAR();
    norm_rows<2>(lds, (float*)arg_ptr(29), nullptr, (const unsigned*)arg_ptr(30) + CW_CNT1);
}

extern "C" void kernel_launch(void* const* d_in, const int* in_sizes, int n_in, void* d_out, int out_size, void* d_ws, size_t ws_size, hipStream_t stream) {
    static int grid = 0;
    if (grid == 0) {
        if (n_in != 29 || out_size != T * DM || ws_size < WS_END) { fprintf(stderr, "kernel_launch: unexpected shapes (n_in %d out %d ws %zu, need %zu)\n", n_in, out_size, ws_size, (size_t)WS_END); grid = -1; return; }
        int dev = 0, cus = 0;
        if (hipGetDevice(&dev) != hipSuccess || hipDeviceGetAttribute(&cus, hipDeviceAttributeMultiprocessorCount, dev) != hipSuccess || cus <= 0) cus = 256;
        if (hipFuncSetAttribute((const void*)fwd, hipFuncAttributeMaxDynamicSharedMemorySize, LDS_BYTES) != hipSuccess) fprintf(stderr, "kernel_launch: hipFuncSetAttribute failed\n");
        grid = cus & ~7;
        if (grid < 8) grid = 8;
    }
    if (grid < 0) return;
    (void)in_sizes;
    (void)hipMemsetAsync((char*)d_ws + WS_CTL, 0, CTL_BYTES, stream);
    Args a{};
    for (int i = 0; i < 29; ++i) a.in[i] = d_in[i];
    a.out = (float*)d_out; a.ws = (unsigned char*)d_ws;
    hipLaunchKernelGGL(fwd, dim3(grid), dim3(NTHREADS), LDS_BYTES, stream, a);
}
```
